# Optimizing an MI355X kernel written in HIP

```python
import jax, jax.numpy as jnp
from jax import lax
import numpy as np

D_MODEL = 1024
BATCH = 4
SEQ = 4096
DEPTH = 4
DEC_BATCH = 8
DEC_SEQ = 2048
PAST_LEN = 128

GRID_W = 64
EPS = 1e-6
GLA_HEADS = 4
GLA_KEY_DIM = D_MODEL // 2
GLA_VALUE_DIM = D_MODEL
GLA_DK = GLA_KEY_DIM // GLA_HEADS
GLA_DV = GLA_VALUE_DIM // GLA_HEADS
GATE_RANK = 16
GATE_NORMALIZER = 16.0
GLA_CHUNK = 64
ATT_HEAD_DIM = 64
ATT_Q_HEADS = D_MODEL // ATT_HEAD_DIM
ATT_KV_HEADS = 4
ATT_GROUP = ATT_Q_HEADS // ATT_KV_HEADS
ATT_Q_DIM = ATT_Q_HEADS * ATT_HEAD_DIM
ATT_KV_DIM = ATT_KV_HEADS * ATT_HEAD_DIM
ROPE_AXIS_DIM = ATT_HEAD_DIM // 2
ROPE_THETA = 10000.0
Q_BLOCK = 128
IN_SIZES = (GLA_KEY_DIM, GLA_KEY_DIM, GLA_VALUE_DIM, GATE_RANK, GATE_RANK, GLA_VALUE_DIM,
            ATT_Q_DIM, ATT_KV_DIM, ATT_KV_DIM, ATT_Q_DIM, D_MODEL, D_MODEL)
IN_DIM = sum(IN_SIZES)

kernel_name = 'hybrid_gla_axial_gqa_encoder'


def rmsnorm(x, g):
    xf = x.astype(jnp.float32)
    y = xf * lax.rsqrt(jnp.mean(xf * xf, axis=-1, keepdims=True) + EPS)
    return (y * g.astype(jnp.float32)).astype(x.dtype)


def split_points():
    pts, acc = [], 0
    for s in IN_SIZES[:-1]:
        acc += s
        pts.append(acc)
    return pts


def gla_scan(q, k, v, g, strict):
    B, H, T, dk = q.shape
    dv = v.shape[-1]
    n = T // GLA_CHUNK

    def to_chunks(a):
        return jnp.moveaxis(a.reshape(B, H, n, GLA_CHUNK, a.shape[-1]), 2, 0)

    idx = jnp.arange(GLA_CHUNK)
    mask = (idx[:, None] > idx[None, :]) if strict else (idx[:, None] >= idx[None, :])

    def step(S, inp):
        qi, ki, vi, gi = inp
        b = jnp.cumsum(gi, axis=2)
        diff = b[:, :, :, None, :] - b[:, :, None, :, :]
        decay = jnp.exp(jnp.where(mask[None, None, :, :, None], diff, -jnp.inf))
        A = jnp.einsum('bhic,bhjc,bhijc->bhij', qi, ki, decay)
        o = (jnp.einsum('bhij,bhjv->bhiv', A, vi)
             + jnp.einsum('bhic,bhcv->bhiv', qi * jnp.exp(b), S))
        b_last = b[:, :, -1:, :]
        S = (jnp.exp(b_last[:, :, 0, :])[..., None] * S
             + jnp.einsum('bhjc,bhjv->bhcv', ki * jnp.exp(b_last - b), vi))
        return S, o

    S0 = jnp.zeros((B, H, dk, dv), jnp.float32)
    _, o = lax.scan(step, S0, (to_chunks(q), to_chunks(k), to_chunks(v), to_chunks(g)))
    return jnp.moveaxis(o, 0, 2).reshape(B, H, T, dv)


def gla_branch(qa, ka, va, gfl, gbl, za, w_gate_f, b_gate_f, w_gate_b, b_gate_b,
               gla_norm_g, w_branch_a):
    B, T, _ = qa.shape

    def heads(a, d):
        return a.reshape(B, T, GLA_HEADS, d).transpose(0, 2, 1, 3).astype(jnp.float32)

    q = heads(qa, GLA_DK) * (GLA_DK ** -0.5)
    k = heads(ka, GLA_DK)
    v = heads(va, GLA_DV)
    gf = heads(jax.nn.log_sigmoid((gfl @ w_gate_f + b_gate_f).astype(jnp.float32)) / GATE_NORMALIZER, GLA_DK)
    gb = heads(jax.nn.log_sigmoid((gbl @ w_gate_b + b_gate_b).astype(jnp.float32)) / GATE_NORMALIZER, GLA_DK)
    flip = lambda a: jnp.flip(a, axis=2)
    o_f = gla_scan(q, k, v, gf, False)
    o_b = flip(gla_scan(flip(q), flip(k), flip(v), flip(gb), True))
    o = (o_f + o_b).transpose(0, 2, 1, 3)
    o = rmsnorm(o, gla_norm_g).reshape(B, T, GLA_VALUE_DIM).astype(za.dtype)
    return (o * jax.nn.silu(za)) @ w_branch_a


def axial_rope_angles(T):
    rows = T // GRID_W
    r = jnp.repeat(jnp.arange(rows, dtype=jnp.float32), GRID_W)
    c = jnp.tile(jnp.arange(GRID_W, dtype=jnp.float32), rows)
    nf = ROPE_AXIS_DIM // 2
    inv = ROPE_THETA ** (-jnp.arange(nf, dtype=jnp.float32) / nf)
    return r[:, None] * inv, c[:, None] * inv


def rotate(xs, ang):
    half = xs.shape[-1] // 2
    cos = jnp.cos(ang)[None, :, None, :]
    sin = jnp.sin(ang)[None, :, None, :]
    x1, x2 = xs[..., :half], xs[..., half:]
    return jnp.concatenate([x1 * cos - x2 * sin, x2 * cos + x1 * sin], axis=-1)


def apply_axial_rope(x, ang_r, ang_c):
    xf = x.astype(jnp.float32)
    out = jnp.concatenate([rotate(xf[..., :ROPE_AXIS_DIM], ang_r),
                           rotate(xf[..., ROPE_AXIS_DIM:], ang_c)], axis=-1)
    return out.astype(x.dtype)


def block_attention(q, k, v):
    B, T, _, dh = q.shape
    nb = T // Q_BLOCK
    qb = jnp.moveaxis(q.reshape(B, nb, Q_BLOCK, ATT_KV_HEADS, ATT_GROUP, dh), 1, 0)
    scale = ATT_HEAD_DIM ** -0.5

    def one(qblk):
        s = jnp.einsum('bqkgd,bskd->bkgqs', qblk, k).astype(jnp.float32) * scale
        p = jax.nn.softmax(s, axis=-1)
        return jnp.einsum('bkgqs,bskd->bqkgd', p.astype(v.dtype), v)

    o = lax.map(one, qb)
    return jnp.moveaxis(o, 0, 1).reshape(B, T, ATT_Q_DIM)


def attn_branch(qb, kb, vb, zb, q_norm_g, k_norm_g, w_branch_b):
    B, T, _ = qb.shape
    q = rmsnorm(qb.reshape(B, T, ATT_Q_HEADS, ATT_HEAD_DIM), q_norm_g)
    k = rmsnorm(kb.reshape(B, T, ATT_KV_HEADS, ATT_HEAD_DIM), k_norm_g)
    v = vb.reshape(B, T, ATT_KV_HEADS, ATT_HEAD_DIM)
    ang_r, ang_c = axial_rope_angles(T)
    q = apply_axial_rope(q, ang_r, ang_c)
    k = apply_axial_rope(k, ang_r, ang_c)
    o = block_attention(q, k, v)
    return (o * jax.nn.silu(zb)) @ w_branch_b


def layer(x, norm_g, w_in, w_gate_f, b_gate_f, w_gate_b, b_gate_b, gla_norm_g,
          q_norm_g, k_norm_g, w_branch_a, w_branch_b, w_out):
    h = rmsnorm(x, norm_g)
    proj = h @ w_in
    qa, ka, va, gfl, gbl, za, qb, kb, vb, zb, ma, mb = jnp.split(proj, split_points(), axis=-1)
    ya = gla_branch(qa, ka, va, gfl, gbl, za, w_gate_f, b_gate_f, w_gate_b, b_gate_b,
                    gla_norm_g, w_branch_a)
    yb = attn_branch(qb, kb, vb, zb, q_norm_g, k_norm_g, w_branch_b)
    merged = jax.nn.sigmoid(ma) * ya + jax.nn.sigmoid(mb) * yb
    return x + merged @ w_out


def trunk(x, norm_g, w_in, w_gate_f, b_gate_f, w_gate_b, b_gate_b, gla_norm_g,
          q_norm_g, k_norm_g, w_branch_a, w_branch_b, w_out, final_norm_g):
    for l in range(DEPTH):
        x = layer(x, norm_g[l], w_in[l], w_gate_f[l], b_gate_f[l], w_gate_b[l], b_gate_b[l],
                  gla_norm_g[l], q_norm_g[l], k_norm_g[l], w_branch_a[l], w_branch_b[l], w_out[l])
    return rmsnorm(x, final_norm_g)


def setup_inputs(seed: int = 0) -> dict:
    key = jax.random.key(seed)
    ks = jax.random.split(key, 16)
    f32 = jnp.float32
    nrm = lambda k, shape, s: jax.random.normal(k, shape, f32) * s
    return {
        'x_prompt': nrm(ks[0], (BATCH, SEQ, D_MODEL), 1.0),
        'x_sample': nrm(ks[1], (DEC_BATCH, DEC_SEQ, D_MODEL), 1.0),
        'norm_g': 1.0 + nrm(ks[2], (DEPTH, D_MODEL), 0.02),
        'w_in': nrm(ks[3], (DEPTH, D_MODEL, IN_DIM), D_MODEL ** -0.5),
        'w_gate_f': nrm(ks[4], (DEPTH, GATE_RANK, GLA_KEY_DIM), GATE_RANK ** -0.5),
        'b_gate_f': nrm(ks[5], (DEPTH, GLA_KEY_DIM), 0.1),
        'w_gate_b': nrm(ks[6], (DEPTH, GATE_RANK, GLA_KEY_DIM), GATE_RANK ** -0.5),
        'b_gate_b': nrm(ks[7], (DEPTH, GLA_KEY_DIM), 0.1),
        'gla_norm_g': 1.0 + nrm(ks[8], (DEPTH, GLA_DV), 0.02),
        'q_norm_g': 1.0 + nrm(ks[9], (DEPTH, ATT_HEAD_DIM), 0.02),
        'k_norm_g': 1.0 + nrm(ks[10], (DEPTH, ATT_HEAD_DIM), 0.02),
        'w_branch_a': nrm(ks[11], (DEPTH, GLA_VALUE_DIM, D_MODEL), GLA_VALUE_DIM ** -0.5),
        'w_branch_b': nrm(ks[12], (DEPTH, ATT_Q_DIM, D_MODEL), ATT_Q_DIM ** -0.5),
        'w_out': nrm(ks[13], (DEPTH, D_MODEL, D_MODEL), D_MODEL ** -0.5),
        'final_norm_g': 1.0 + nrm(ks[14], (D_MODEL,), 0.02),
    }


def reference(x_prompt, x_sample, norm_g, w_in, w_gate_f, b_gate_f, w_gate_b, b_gate_b,
              gla_norm_g, q_norm_g, k_norm_g, w_branch_a, w_branch_b, w_out, final_norm_g):
    y_prompt = trunk(x_prompt, norm_g, w_in, w_gate_f, b_gate_f, w_gate_b, b_gate_b, gla_norm_g,
                     q_norm_g, k_norm_g, w_branch_a, w_branch_b, w_out, final_norm_g)
    y_sample = trunk(x_sample, norm_g, w_in, w_gate_f, b_gate_f, w_gate_b, b_gate_b, gla_norm_g,
                     q_norm_g, k_norm_g, w_branch_a, w_branch_b, w_out, final_norm_g)
    return (y_prompt, y_sample)
```

```cpp
#include <hip/hip_runtime.h>
#include <hip/hip_cooperative_groups.h>
#include <hip/hip_bf16.h>
#include <cstdio>
#include <cstdint>
#include <cmath>
namespace cg = cooperative_groups;

#define LAS __attribute__((address_space(3)))
#define GAS __attribute__((address_space(1)))
typedef unsigned short bf16_t;
typedef short bf16x8 __attribute__((ext_vector_type(8)));
typedef float f32x4 __attribute__((ext_vector_type(4)));
typedef float f32x2 __attribute__((ext_vector_type(2)));
typedef float f32x16 __attribute__((ext_vector_type(16)));
typedef unsigned u32x4 __attribute__((ext_vector_type(4)));
typedef unsigned u32x2 __attribute__((ext_vector_type(2)));
typedef __bf16 bf16x2_t __attribute__((ext_vector_type(2)));

constexpr int DM = 1024, NTOK = 16384, DEPTH = 4, IN_DIM = 7712, LDP = 7936;
constexpr int C_QA = 0, C_KA = 512, C_VA = 1024, C_QB = 2048, C_KB = 3072, C_VB = 3328, C_ZA = 3584, C_ZB = 4608, C_MA = 5632, C_MB = 6656, C_GL = 7680;
constexpr float EPS = 1e-6f;
constexpr float C2 = 0.125f * 1.4426950408889634f;
constexpr float LN2 = 0.6931471805599453f, LOG2E = 1.4426950408889634f;

constexpr size_t MiB = 1u << 20;
constexpr size_t WS_CTL = 0, CTL_BYTES = 65536;
constexpr size_t WS_TAB = 1 * MiB;
constexpr size_t WS_WIN = 2 * MiB;
constexpr size_t WIN_L = (size_t)LDP * 1024;
constexpr size_t WS_WBR = 64 * MiB;
constexpr size_t WS_WOUT = 80 * MiB;
constexpr size_t WS_PROJ = 88 * MiB;
constexpr size_t WS_XB = 336 * MiB;
constexpr size_t WS_SSP = 368 * MiB;
constexpr size_t WS_EF = 369 * MiB;
constexpr size_t WS_EB = WS_EF + 512 * 1024;
constexpr size_t WS_KLTF = 370 * MiB;
constexpr size_t WS_KLTB = 386 * MiB;
constexpr size_t WS_VT = 402 * MiB;
constexpr size_t WS_OF2 = 434 * MiB;
constexpr size_t WS_END = 466 * MiB;

constexpr int LDS_BYTES = 147456, RING_BYTES = 131072, MISC_OFF = 131072 + 512;
constexpr int NPHASE = 51;

__device__ __forceinline__ unsigned pk2(float lo, float hi) { f32x2 v = {lo, hi}; bf16x2_t b = __builtin_convertvector(v, bf16x2_t); return __builtin_bit_cast(unsigned, b); }
__device__ __forceinline__ float bflo(unsigned u) { return __builtin_bit_cast(float, u << 16); }
__device__ __forceinline__ float bfhi(unsigned u) { return __builtin_bit_cast(float, u & 0xffff0000u); }
__device__ __forceinline__ float bf2f(bf16_t v) { return __builtin_bit_cast(float, ((unsigned)v) << 16); }
__device__ __forceinline__ bf16_t f2bf(float f) { return (bf16_t)(pk2(f, 0.f) & 0xffffu); }
__device__ __forceinline__ float fexp(float x) { return __builtin_amdgcn_exp2f(x * LOG2E); }
__device__ __forceinline__ float sigm(float x) { return __builtin_amdgcn_rcpf(1.f + fexp(-x)); }
__device__ __forceinline__ float silu(float x) { return x * sigm(x); }
__device__ __forceinline__ float logsig(float z) { return fminf(z, 0.f) - LN2 * __builtin_amdgcn_logf(1.f + fexp(-fabsf(z))); }
__device__ __forceinline__ int crow(int r, int hi) { return (r & 3) + 8 * (r >> 2) + 4 * hi; }
#define LDS_BARRIER() do { asm volatile("s_waitcnt lgkmcnt(0)" ::: "memory"); __builtin_amdgcn_s_barrier(); } while (0)
#define MFMA32(a, b, c) __builtin_amdgcn_mfma_f32_32x32x16_bf16((a), (b), (c), 0, 0, 0)

namespace pg8 {
constexpr int BM = 256, BK = 64, HALF = 128, HTB = HALF * BK * 2, NXCD = 8, WGM = 8;
__host__ __device__ __forceinline__ int lds_byte(int r, int c) { const int st = (r >> 4) * 2 + (c >> 5), rr = r & 15, cc = c & 31, ob = rr * 64 + cc * 2; return st * 1024 + (ob ^ (((ob >> 9) & 1) << 5)); }
__host__ __device__ __forceinline__ void stage_rc(int b, int& R, int& C) { const int st = b / 1024, sb = b % 1024, swz = sb ^ (((sb >> 9) & 1) << 5); R = (st >> 1) * 16 + swz / 64; C = (st & 1) * 32 + (swz % 64) / 2; }
__host__ __device__ __forceinline__ int perm32(int rho) { const int n = rho >> 4, i = rho & 15; return 8 * (i >> 2) + 4 * n + (i & 3); }
struct Unit { int pm, pn, sel; };
struct Gemm { const bf16_t* A; const bf16_t* Bt; int lda, ldb, K; int selstep; };
struct StaticOrder {
    int nM, nN, nwg, G, c;
    __device__ void init(int M, int N, int G_, int c_) { nM = M / BM; nN = N / BM; nwg = nM * nN; G = G_; c = c_; }
    __device__ bool next(int i, Unit& u) const {
        const long L = (long)i * G + c; if (L >= nwg) return false;
        int wgid = (int)L; { const int q = nwg / NXCD, r = nwg % NXCD, xcd = wgid % NXCD, off = wgid / NXCD; wgid = (xcd < r ? xcd * (q + 1) : r * (q + 1) + (xcd - r) * q) + off; }
        const int nig = WGM * nN, gid = wgid / nig, fm = gid * WGM, gsz = (nM - fm) < WGM ? (nM - fm) : WGM;
        u.pm = fm + ((wgid % nig) % gsz); u.pn = (wgid % nig) / gsz; u.sel = 0; return true;
    }
};
struct PairOrder {
    StaticOrder b;
    __device__ bool next(int i, Unit& u) const { const bool ok = b.next(i >> 1, u); u.sel = i & 1; return ok; }
};
template <class Epi, bool ALIGN_EPI = true, class Sched = StaticOrder>
__device__ __forceinline__ void gemm_phase(LAS unsigned char* lds, const Gemm g, const Sched& S, const Epi& E) {
    int tid = threadIdx.x; asm volatile("" : "+v"(tid));
    const int wid = __builtin_amdgcn_readfirstlane(tid >> 6), lane = tid & 63, wr = wid >> 2, wc = wid & 3, fr = lane & 15, fq = lane >> 4;
    const int K = g.K, nt = K / BK;
    unsigned voffA[2], voffB[2];
#pragma unroll
    for (int i = 0; i < 2; ++i) { int R, C; stage_rc(tid * 16 + i * 8192, R, C); const int Rb = (R & ~31) + perm32(R & 31);
        voffA[i] = (unsigned)(R * g.lda + C) * 2u; voffB[i] = (unsigned)(Rb * g.ldb + C) * 2u; }
    const size_t kstep = (size_t)(BK * 2);
    const size_t hstepA = (size_t)HALF * g.lda * 2, hstepB = (size_t)HALF * g.ldb * 2;
    const size_t tstepA = 2 * hstepA, tstepB = 2 * hstepB;
    const unsigned ldsw = (unsigned)wid * 1024u;
    const int aoff = lds_byte(wr * 64 + fr, fq * 8), boff = lds_byte(wc * 32 + fr, fq * 8);
#define PG8_SA(b, h) (((b) * 2 + (h)) * HTB)
#define PG8_SB(b, h) ((4 + (b) * 2 + (h)) * HTB)
#define PG8_STAGE(bufoff, gbase, voff) do { _Pragma("unroll") for (int _i = 0; _i < 2; ++_i) \
        __builtin_amdgcn_global_load_lds((const unsigned*)((const char*)(gbase) + (voff)[_i]), (LAS unsigned*)(lds + (bufoff) + ldsw + _i * 8192), 16, 0, 0); } while (0)
#define PG8_LDA(dst, b, h) do { _Pragma("unroll") for (int m = 0; m < 4; ++m) _Pragma("unroll") for (int k = 0; k < 2; ++k) dst[m][k] = *(const LAS bf16x8*)(lds + PG8_SA(b, h) + aoff + m * 2048 + k * 1024); } while (0)
#define PG8_LDB(dst, b, h) do { _Pragma("unroll") for (int n = 0; n < 2; ++n) _Pragma("unroll") for (int k = 0; k < 2; ++k) dst[n][k] = *(const LAS bf16x8*)(lds + PG8_SB(b, h) + boff + n * 2048 + k * 1024); } while (0)
#define PG8_MMA(ai, bj, At, Bt) do { __builtin_amdgcn_s_setprio(1); _Pragma("unroll") for (int m = 0; m < 4; ++m) _Pragma("unroll") for (int n = 0; n < 2; ++n) _Pragma("unroll") for (int k = 0; k < 2; ++k) \
        acc[ai][bj][m][n] = __builtin_amdgcn_mfma_f32_16x16x32_bf16(Bt[n][k], At[m][k], acc[ai][bj][m][n], 0, 0, 0); __builtin_amdgcn_s_setprio(0); } while (0)
#define PG8_WAIT_V(n) asm volatile("s_waitcnt vmcnt(" #n ")" ::: "memory")
#define PG8_WAIT_L(n) asm volatile("s_waitcnt lgkmcnt(" #n ")" ::: "memory")
#define PG8_BAR __builtin_amdgcn_s_barrier()
#define PG8_SCHED __builtin_amdgcn_sched_barrier(0)
    Unit cur, nxt; int ui = 0;
    if (!S.next(0, cur)) return;
    f32x4 acc[2][2][4][2];
#pragma unroll
    for (int a = 0; a < 2; ++a)
#pragma unroll
        for (int b = 0; b < 2; ++b)
#pragma unroll
            for (int m = 0; m < 4; ++m)
#pragma unroll
                for (int n = 0; n < 2; ++n) acc[a][b][m][n] = (f32x4){0.f, 0.f, 0.f, 0.f};
    bf16x8 At[4][2], B0[2][2], B1[2][2];
    const char* cA = (const char*)g.A + (size_t)cur.pm * tstepA + (size_t)cur.sel * g.selstep; const char* cB = (const char*)g.Bt + (size_t)cur.pn * tstepB + (size_t)cur.sel * g.selstep;
    PG8_STAGE(PG8_SB(0, 0), cB, voffB); PG8_STAGE(PG8_SB(0, 1), cB + hstepB, voffB); PG8_STAGE(PG8_SA(0, 0), cA, voffA); PG8_STAGE(PG8_SA(0, 1), cA + hstepA, voffA);
    if (wr == 1) PG8_BAR;
    PG8_WAIT_V(2); PG8_BAR;
    PG8_STAGE(PG8_SB(1, 0), cB + kstep, voffB); PG8_STAGE(PG8_SA(1, 0), cA + kstep, voffA); PG8_STAGE(PG8_SB(1, 1), cB + hstepB + kstep, voffB);
    PG8_WAIT_V(6); PG8_BAR;
    for (;;) {
        const bool has_next = S.next(ui + 1, nxt);
        const char* nA = has_next ? (const char*)g.A + (size_t)nxt.pm * tstepA + (size_t)nxt.sel * g.selstep : cA; const char* nB = has_next ? (const char*)g.Bt + (size_t)nxt.pn * tstepB + (size_t)nxt.sel * g.selstep : cB;
        for (int t = 0; t < nt; t += 2) {
            const bool last = (t == nt - 2);
            const char* a1 = cA + (size_t)(t + 1) * kstep;
            const char* a2 = last ? nA : cA + (size_t)(t + 2) * kstep; const char* b2 = last ? nB : cB + (size_t)(t + 2) * kstep;
            const char* a3 = a2 + kstep; const char* b3 = b2 + kstep;
            PG8_LDB(B0, 0, 0); PG8_LDB(B1, 0, 1); PG8_SCHED; PG8_LDA(At, 0, 0); PG8_STAGE(PG8_SA(1, 1), a1 + hstepA, voffA);
            PG8_WAIT_V(8); PG8_WAIT_L(0); PG8_BAR; PG8_MMA(0, 0, At, B0); PG8_MMA(0, 1, At, B1); PG8_BAR; PG8_SCHED;
            PG8_LDA(At, 0, 1); PG8_STAGE(PG8_SB(0, 0), b2, voffB); PG8_STAGE(PG8_SB(0, 1), b2 + hstepB, voffB); PG8_STAGE(PG8_SA(0, 0), a2, voffA);
            PG8_WAIT_V(8); PG8_WAIT_L(0); PG8_BAR; PG8_MMA(1, 0, At, B0); PG8_MMA(1, 1, At, B1); PG8_BAR; PG8_SCHED;
            PG8_LDB(B0, 1, 0); PG8_LDB(B1, 1, 1); PG8_SCHED; PG8_LDA(At, 1, 0); PG8_STAGE(PG8_SA(0, 1), a2 + hstepA, voffA);
            PG8_WAIT_V(8); PG8_WAIT_L(0); PG8_BAR; PG8_MMA(0, 0, At, B0); PG8_MMA(0, 1, At, B1); PG8_BAR; PG8_SCHED;
            PG8_LDA(At, 1, 1); PG8_STAGE(PG8_SB(1, 0), b3, voffB); PG8_STAGE(PG8_SB(1, 1), b3 + hstepB, voffB); PG8_STAGE(PG8_SA(1, 0), a3, voffA);
            PG8_WAIT_V(8); PG8_WAIT_L(0); PG8_BAR; PG8_MMA(1, 0, At, B0); PG8_MMA(1, 1, At, B1); PG8_BAR; PG8_SCHED;
        }
        if constexpr (ALIGN_EPI) { if (wr == 0) PG8_BAR; }
        E(acc, cur, wr, wc, fr, fq);
        if (!has_next) break;
#pragma unroll
        for (int a = 0; a < 2; ++a)
#pragma unroll
            for (int b = 0; b < 2; ++b)
#pragma unroll
                for (int m = 0; m < 4; ++m)
#pragma unroll
                    for (int n = 0; n < 2; ++n) acc[a][b][m][n] = (f32x4){0.f, 0.f, 0.f, 0.f};
        cur = nxt; cA = nA; cB = nB; ++ui;
        if constexpr (ALIGN_EPI) { if (wr == 1) PG8_BAR; }
    }
    PG8_WAIT_V(0);
    if constexpr (!ALIGN_EPI) { if (wr == 0) PG8_BAR; }
    PG8_BAR;
#undef PG8_SA
#undef PG8_SB
#undef PG8_STAGE
#undef PG8_LDA
#undef PG8_LDB
#undef PG8_MMA
#undef PG8_WAIT_V
#undef PG8_WAIT_L
#undef PG8_BAR
#undef PG8_SCHED
}

struct EpiProj {
    bf16_t* O; const float* ssp;
    __device__ __forceinline__ void operator()(const f32x4 (&acc)[2][2][4][2], const Unit& u, int wr, int wc, int fr, int fq) const {
        const int row0 = u.pm * BM + wr * 64 + fr, col0 = u.pn * BM + wc * 32 + 8 * fq;
#pragma unroll
        for (int ai = 0; ai < 2; ++ai)
#pragma unroll
            for (int m = 0; m < 4; ++m) {
                const int row = row0 + ai * HALF + m * 16;
                const f32x4* sp = (const f32x4*)(ssp + (size_t)row * 16);
                const f32x4 s4 = (sp[0] + sp[1]) + (sp[2] + sp[3]);
                const float rs = __builtin_amdgcn_rsqf(((s4[0] + s4[1]) + (s4[2] + s4[3])) * (1.f / 1024.f) + EPS);
                bf16_t* rowp = O + (size_t)row * LDP + col0;
#pragma unroll
                for (int bj = 0; bj < 2; ++bj) { const f32x4 v0 = acc[ai][bj][m][0] * rs, v1 = acc[ai][bj][m][1] * rs;
                    u32x4 w; w.x = pk2(v0[0], v0[1]); w.y = pk2(v0[2], v0[3]); w.z = pk2(v1[0], v1[1]); w.w = pk2(v1[2], v1[3]);
                    *(u32x4*)(rowp + bj * HALF) = w; }
            }
    }
};
template <int SECOND> struct EpiBranch {
    bf16_t* P; bf16_t* W; int rmask;
    __device__ __forceinline__ void operator()(const f32x4 (&acc)[2][2][4][2], const Unit& u, int wr, int wc, int fr, int fq) const {
        const int row0 = u.pm * BM + wr * 64 + fr, col0 = u.pn * BM + wc * 32 + 8 * fq;
#pragma unroll
        for (int ai = 0; ai < 2; ++ai)
#pragma unroll
            for (int m = 0; m < 4; ++m) {
                bf16_t* rowp = P + (size_t)(row0 + ai * HALF + m * 16) * LDP + col0; bf16_t* roww = W + (size_t)((row0 + ai * HALF + m * 16) & rmask) * LDP + col0;
#pragma unroll
                for (int bj = 0; bj < 2; ++bj) {
                    const u32x4 a = *(const u32x4*)(rowp + C_MA + bj * HALF);
                    float ma[8] = {bflo(a.x), bfhi(a.x), bflo(a.y), bfhi(a.y), bflo(a.z), bfhi(a.z), bflo(a.w), bfhi(a.w)};
                    float o[8];
                    if (SECOND) {
                        const u32x4 b = *(const u32x4*)(rowp + C_MB + bj * HALF);
                        float mb[8] = {bflo(b.x), bfhi(b.x), bflo(b.y), bfhi(b.y), bflo(b.z), bfhi(b.z), bflo(b.w), bfhi(b.w)};
#pragma unroll
                        for (int e = 0; e < 8; ++e) o[e] = ma[e] + acc[ai][bj][m][e >> 2][e & 3] * sigm(mb[e]);
                    } else {
#pragma unroll
                        for (int e = 0; e < 8; ++e) o[e] = acc[ai][bj][m][e >> 2][e & 3] * sigm(ma[e]);
                    }
                    u32x4 w; w.x = pk2(o[0], o[1]); w.y = pk2(o[2], o[3]); w.z = pk2(o[4], o[5]); w.w = pk2(o[6], o[7]);
                    *(u32x4*)(roww + C_MA + bj * HALF) = w;
                }
            }
    }
};
struct EpiBranchPair {
    bf16_t* P;
    __device__ __forceinline__ void operator()(const f32x4 (&acc)[2][2][4][2], const Unit& u, int wr, int wc, int fr, int fq) const {
        if (u.sel == 0) { EpiBranch<0> e{P, P, -1}; e(acc, u, wr, wc, fr, fq); } else { EpiBranch<1> e{P, P, -1}; e(acc, u, wr, wc, fr, fq); }
    }
};
struct EpiOut {
    const float* xold; float* xnew; bf16_t* xb; float* ssp; int rmask;
    __device__ __forceinline__ void operator()(const f32x4 (&acc)[2][2][4][2], const Unit& u, int wr, int wc, int fr, int fq) const {
        const int row0 = u.pm * BM + wr * 64 + fr, col0 = u.pn * BM + wc * 32 + 8 * fq;
#pragma unroll
        for (int ai = 0; ai < 2; ++ai)
#pragma unroll
            for (int m = 0; m < 4; ++m) {
                const int row = row0 + ai * HALF + m * 16;
                float ss = 0.f;
#pragma unroll
                for (int bj = 0; bj < 2; ++bj) {
                    const size_t off = (size_t)row * DM + col0 + bj * HALF, offw = (size_t)(row & rmask) * DM + col0 + bj * HALF;
                    const f32x4 x0 = *(const f32x4*)(xold + off), x1 = *(const f32x4*)(xold + off + 4);
                    const f32x4 v0 = x0 + acc[ai][bj][m][0], v1 = x1 + acc[ai][bj][m][1];
                    *(f32x4*)(xnew + offw) = v0; *(f32x4*)(xnew + offw + 4) = v1;
                    u32x4 w; w.x = pk2(v0[0], v0[1]); w.y = pk2(v0[2], v0[3]); w.z = pk2(v1[0], v1[1]); w.w = pk2(v1[2], v1[3]);
                    *(u32x4*)(xb + offw) = w;
                    ss += (v0[0] * v0[0] + v0[1] * v0[1]) + (v0[2] * v0[2] + v0[3] * v0[3]) + (v1[0] * v1[0] + v1[1] * v1[1]) + (v1[2] * v1[2] + v1[3] * v1[3]);
                }
                ss += __shfl_xor(ss, 16); ss += __shfl_xor(ss, 32);
                if (fq == 0) ssp[(size_t)(row & rmask) * 16 + u.pn * 4 + wc] = ss;
            }
    }
};
}

namespace attn_body {
using bf16 = __hip_bfloat16;
using s16x4 = __attribute__((ext_vector_type(4))) short;
constexpr int D = 64, P = LDP;
constexpr int NW = 8, QBLK = 32, QB = QBLK * NW, KVBLK = 64;
#define SBAR() __builtin_amdgcn_sched_barrier(0)
constexpr int NSLOT = 3, SLOTB = 8192;
constexpr int LDS_K = 0, LDS_V = NSLOT * SLOTB, LDS_WS = 2 * NSLOT * SLOTB, LDS_OST = LDS_WS + NW * 64 * 4, ATT_LDS_BYTES = LDS_OST + NW * 4096;
__device__ __forceinline__ void glds16(const void* gsrc, unsigned lds_dst) { unsigned keep;
  asm volatile("s_mov_b32 %0, m0\n\ts_mov_b32 m0, %2\n\ts_nop 0\n\tglobal_load_lds_dwordx4 %1, off\n\ts_mov_b32 m0, %0" : "=&s"(keep) : "v"(gsrc), "s"(lds_dst) : "memory"); }
__device__ __forceinline__ float max3f(float a, float b, float c) { float r; asm("v_max3_f32 %0, %1, %2, %3" : "=v"(r) : "v"(a), "v"(b), "v"(c)); return r; }
__device__ __forceinline__ float max2f(float a, float b) { float r; asm("v_max_f32_e32 %0, %1, %2" : "=v"(r) : "v"(a), "v"(b)); return r; }
__device__ __forceinline__ float fadd_s(float a, float b) { float r; asm("v_add_f32_e32 %0, %1, %2" : "=v"(r) : "v"(a), "v"(b)); return r; }
__device__ __forceinline__ float fsub_s(float a, float b) { float r; asm("v_sub_f32_e32 %0, %1, %2" : "=v"(r) : "v"(a), "v"(b)); return r; }
__device__ __forceinline__ unsigned cvtpk_s(float lo, float hi) { return pk2(lo, hi); }
#define WAIT_BAR(N) asm volatile("s_waitcnt vmcnt(" #N ") lgkmcnt(0)\n\ts_barrier" ::: "memory")
__device__ __forceinline__ void qkt(f32x16& p0, f32x16& p1, const char* Kslot, const bf16x8* qr, const f32x16& negm, int r32, int hi) {
  const char* kb = Kslot + hi * 1024 + r32 * 16;
  #pragma unroll
  for (int d0 = 0; d0 < 4; ++d0) {
    const bf16x8 b0 = *reinterpret_cast<const bf16x8*>(kb + d0 * 2048);
    const bf16x8 b1 = *reinterpret_cast<const bf16x8*>(kb + d0 * 2048 + 512);
    if (d0 == 0) { p0 = MFMA32(b0, qr[0], negm); p1 = MFMA32(b1, qr[0], negm); }
    else { p0 = MFMA32(b0, qr[d0], p0); p1 = MFMA32(b1, qr[d0], p1); } }
}
typedef __attribute__((address_space(3))) const char* lds_cptr;
typedef short v4i16_t __attribute__((ext_vector_type(4)));
__device__ __forceinline__ void kload8(bf16x8* kf, lds_cptr kp) {
  kf[0] = *(const LAS bf16x8*)(kp);        kf[1] = *(const LAS bf16x8*)(kp + 512);
  kf[2] = *(const LAS bf16x8*)(kp + 2048); kf[3] = *(const LAS bf16x8*)(kp + 2560);
  kf[4] = *(const LAS bf16x8*)(kp + 4096); kf[5] = *(const LAS bf16x8*)(kp + 4608);
  kf[6] = *(const LAS bf16x8*)(kp + 6144); kf[7] = *(const LAS bf16x8*)(kp + 6656);
}
__device__ __forceinline__ void kload2(bf16x8* kf, lds_cptr kp, int j) { kf[2 * j] = *(const LAS bf16x8*)(kp + j * 2048); kf[2 * j + 1] = *(const LAS bf16x8*)(kp + j * 2048 + 512); }
__device__ __forceinline__ s16x4 vtr(lds_cptr p) { return __builtin_bit_cast(s16x4, __builtin_amdgcn_ds_read_tr16_b64_v4i16((LAS v4i16_t*)p)); }
__device__ __forceinline__ float rowmax(const f32x16& p0, const f32x16& p1) {
  float a = max3f(p0[0], p0[1], p1[0]), b = max3f(p0[2], p0[3], p1[1]); a = max3f(a, p1[2], p1[3]);
  #pragma unroll
  for (int r = 4; r < 16; r += 4) { a = max3f(a, p0[r], p0[r + 1]); b = max3f(b, p0[r + 2], p0[r + 3]); a = max3f(a, p1[r], p1[r + 1]); b = max3f(b, p1[r + 2], p1[r + 3]); }
  const float m = max2f(a, b);
  auto rr = __builtin_amdgcn_permlane32_swap(__float_as_uint(m), __float_as_uint(m), false, false);
  return max2f(__uint_as_float(rr[0]), __uint_as_float(rr[1]));
}
__device__ __forceinline__ void pv(f32x16* o, int vb, bf16x8 pa0, bf16x8 pa1, bf16x8 pa2, bf16x8 pa3) {
  #pragma unroll
  for (int d0 = 0; d0 < 2; ++d0) { s16x4 lo[4], hi[4];
    #pragma unroll
    for (int ks = 0; ks < 4; ++ks) {
      asm volatile("ds_read_b64_tr_b16 %0,%1 offset:%c2" : "=&v"(lo[ks]) : "v"(vb), "i"(d0 * 4096 + ks * 1024) : "memory");
      asm volatile("ds_read_b64_tr_b16 %0,%1 offset:%c2" : "=&v"(hi[ks]) : "v"(vb), "i"(d0 * 4096 + ks * 1024 + 512) : "memory"); }
    asm volatile("s_waitcnt lgkmcnt(0)" ::: "memory"); SBAR();
    #define PK(k) (bf16x8){lo[k][0], lo[k][1], lo[k][2], lo[k][3], hi[k][0], hi[k][1], hi[k][2], hi[k][3]}
    o[d0] = MFMA32(pa0, PK(0), o[d0]);
    o[d0] = MFMA32(pa1, PK(1), o[d0]);
    o[d0] = MFMA32(pa2, PK(2), o[d0]);
    o[d0] = MFMA32(pa3, PK(3), o[d0]);
    #undef PK
  }
}
template <int THRL> __device__ __forceinline__ void attn_unit(const bf16* Qu, const bf16* __restrict__ Kh, const bf16* __restrict__ Vh, bf16* Zu, int NT, char* shm, const float* qg, const float* tabc, const float* tabs, int t0) {
  int tid = threadIdx.x; asm volatile("" : "+v"(tid));
  const int lane = tid & 63, r32 = lane & 31, hi = lane >> 5; const int wid = __builtin_amdgcn_readfirstlane(tid >> 6);
  const bf16* Qw = Qu + (long)(wid * QBLK) * P;
  const unsigned lds0 = (unsigned)(uintptr_t)shm;
  float* wsf = (float*)(shm + LDS_WS) + wid * 64;
  const bf16* ksrc = Kh + (long)lane * P + wid * 8;
  const bf16* vsrc = Vh + (long)(16 * (wid & 3) + (lane >> 2)) * P + (wid >> 2) * 32 + (lane & 3) * 8;
  const unsigned kdst = lds0 + LDS_K + wid * 1024, vdst = lds0 + LDS_V + wid * 1024;
  #define DMA_K(t, slot) glds16(ksrc + (long)(t) * KVBLK * P, (unsigned)__builtin_amdgcn_readfirstlane(kdst + (slot)))
  #define DMA_V(t, slot) glds16(vsrc + (long)(t) * KVBLK * P, (unsigned)__builtin_amdgcn_readfirstlane(vdst + (slot)))
  const int vb0 = (int)(lds0 + LDS_V) + ((lane >> 4) & 1) * 32 + (lane & 3) * 8 + (4 * hi + ((lane & 15) >> 2)) * 64;
  const char* Kbase = shm + LDS_K; bf16x8 kf[8];
  const lds_cptr shm3 = (lds_cptr)shm; const lds_cptr kp0 = shm3 + LDS_K + hi * 1024 + r32 * 16; const lds_cptr vp0 = shm3 + LDS_V + ((lane >> 4) & 1) * 32 + (lane & 3) * 8 + (4 * hi + ((lane & 15) >> 2)) * 64;
  DMA_K(0, 0); DMA_V(0, 0); DMA_K(1, SLOTB);
  bf16x8 qr[4];
  #pragma unroll
  for (int d0 = 0; d0 < 4; ++d0) qr[d0] = *reinterpret_cast<const bf16x8*>(&Qw[(long)r32 * P + d0 * 16 + hi * 8]);
  {
    float x[4][8]; float ss = 0.f;
    #pragma unroll
    for (int d0 = 0; d0 < 4; ++d0) { const u32x4 u = __builtin_bit_cast(u32x4, qr[d0]);
      x[d0][0] = bflo(u.x); x[d0][1] = bfhi(u.x); x[d0][2] = bflo(u.y); x[d0][3] = bfhi(u.y); x[d0][4] = bflo(u.z); x[d0][5] = bfhi(u.z); x[d0][6] = bflo(u.w); x[d0][7] = bfhi(u.w);
      #pragma unroll
      for (int j = 0; j < 8; ++j) ss += x[d0][j] * x[d0][j]; }
    { auto rr = __builtin_amdgcn_permlane32_swap(__float_as_uint(ss), __float_as_uint(ss), false, false); ss = __uint_as_float(rr[0]) + __uint_as_float(rr[1]); }
    const float rs = __builtin_amdgcn_rsqf(ss * (1.f / 64.f) + EPS) * C2;
    const int tq = t0 + wid * QBLK + r32, pr = tq >> 6, pc = tq & 63;
    #pragma unroll
    for (int d0 = 0; d0 < 4; ++d0) { const f32x4 g0 = *(const f32x4*)(qg + 16 * d0 + 8 * hi), g1 = *(const f32x4*)(qg + 16 * d0 + 8 * hi + 4);
      #pragma unroll
      for (int j = 0; j < 4; ++j) { x[d0][j] *= rs * g0[j]; x[d0][4 + j] *= rs * g1[j]; } }
    #pragma unroll
    for (int ax = 0; ax < 2; ++ax) { const int pos = ax ? pc : pr;
      const f32x4 c0 = *(const f32x4*)(tabc + pos * 16 + 8 * hi), c1 = *(const f32x4*)(tabc + pos * 16 + 8 * hi + 4), s0 = *(const f32x4*)(tabs + pos * 16 + 8 * hi), s1 = *(const f32x4*)(tabs + pos * 16 + 8 * hi + 4);
      #pragma unroll
      for (int j = 0; j < 8; ++j) { const float cc = j < 4 ? c0[j & 3] : c1[j & 3], sn = j < 4 ? s0[j & 3] : s1[j & 3];
        const float a = x[2 * ax][j], b = x[2 * ax + 1][j]; x[2 * ax][j] = a * cc - b * sn; x[2 * ax + 1][j] = b * cc + a * sn; } }
    #pragma unroll
    for (int d0 = 0; d0 < 4; ++d0) { u32x4 u; u.x = pk2(x[d0][0], x[d0][1]); u.y = pk2(x[d0][2], x[d0][3]); u.z = pk2(x[d0][4], x[d0][5]); u.w = pk2(x[d0][6], x[d0][7]); qr[d0] = __builtin_bit_cast(bf16x8, u); }
  }
  float mhat = 0.f, l_reg = 0.f; f32x16 o[2]; o[0] = f32x16{}; o[1] = f32x16{}; f32x16 negm = f32x16{}; asm volatile("" : "+v"(negm));
  bool resc = false;
  #define START(P0, P1) do { const float rm = rowmax(P0, P1); resc = false; \
    { const float dl = rm; mhat = fadd_s(mhat, dl); \
      _Pragma("unroll") for (int r = 0; r < 16; ++r) { P0[r] = fsub_s(P0[r], dl); P1[r] = fsub_s(P1[r], dl); } \
      _Pragma("unroll") for (int r = 0; r < 16; ++r) negm[r] = -mhat; asm volatile("" : "+v"(negm)); } \
    _Pragma("unroll") for (int r = 0; r < 16; ++r) P0[r] = __builtin_amdgcn_exp2f(P0[r]); } while (0)
  #define RESC() do { if (resc) { asm volatile("s_waitcnt lgkmcnt(0)" ::: "memory"); \
      _Pragma("unroll") for (int d_ = 0; d_ < 2; ++d_) _Pragma("unroll") for (int r = 0; r < 16; ++r) o[d_][r] *= wsf[crow(r, hi)]; } } while (0)
  f32x16 pA0, pA1, pB0, pB1;
  int sl_prev = 0, sl_cur = 0, sl_next = SLOTB;
  #define ROT() do { sl_prev = sl_cur; sl_cur = sl_next; sl_next = (sl_next == (NSLOT - 1) * SLOTB) ? 0 : sl_next + SLOTB; } while (0)
  DMA_K(2, 2 * SLOTB);
  WAIT_BAR(3);
  qkt(pA0, pA1, Kbase, qr, negm, r32, hi); asm volatile("s_nop 15\n\ts_nop 7" : "+v"(pA0), "+v"(pA1));
  START(pA0, pA1);
  _Pragma("unroll") for (int r = 0; r < 16; ++r) pA1[r] = __builtin_amdgcn_exp2f(pA1[r]);
  WAIT_BAR(0);
  DMA_K(3, 0); DMA_V(1, SLOTB);
  ROT();
  kload8(kf, kp0 + sl_cur);
  WAIT_BAR(2);
  s16x4 vlo[8], vhi[8]; u32x4 pw0, pw1, pw2, pw3;
  #define PKW(Pq, B) cvtpk_s(Pq[B], Pq[B + 1])
  #define PAF(k) __builtin_bit_cast(bf16x8, pw##k)
  #define VFR(i) (bf16x8){vlo[i][0], vlo[i][1], vlo[i][2], vlo[i][3], vhi[i][0], vhi[i][1], vhi[i][2], vhi[i][3]}
  #define PIN(x) asm volatile("" : "+v"(x))
  #define MX3(a, b, c) __builtin_fmaxf(__builtin_fmaxf((a), (b)), (c))
  #define GAPA(MF, A0, A1, A2, A3, W0, W1, PW) do { MF; sacc += A0; sacc += A1; sacc += A2; sacc += A3; PIN(sacc); W0; W1; PIN(PW); SBAR(); } while (0)
  #define EX(v) __builtin_amdgcn_exp2f(v)
  #define GAPB(MF, X, B) do { MF; X[B] = EX(X[B]); X[B + 1] = EX(X[B + 1]); X[B + 2] = EX(X[B + 2]); X[B + 3] = EX(X[B + 3]); PIN(X); SBAR(); } while (0)
  #define VRD(i) do { vlo[i] = vtr(vp_ + (((i) >> 2) * 4096 + ((i) & 3) * 1024)); vhi[i] = vtr(vp_ + (((i) >> 2) * 4096 + ((i) & 3) * 1024 + 512)); } while (0)
  #define KRD(G, j) do { if (G) { kload2(kf, kp0 + sl_next, j); SBAR(); } } while (0)
  #define STEP(C0, C1, P0, P1, t, GK, GV, GL) do { SBAR(); \
    const lds_cptr vp_ = vp0 + sl_prev; \
    VRD(0); SBAR(); float sacc = (P0[0] + P0[1]); \
    GAPA(C0 = MFMA32(kf[0], qr[0], negm), P0[2], P0[3], P0[4], P0[5],     pw0[0] = PKW(P0, 0), pw0[1] = PKW(P0, 2), pw0); \
    VRD(4); SBAR(); GAPA(C1 = MFMA32(kf[1], qr[0], negm), P0[6], P0[7], P0[8], P0[9],     pw0[2] = PKW(P0, 4), pw0[3] = PKW(P0, 6), pw0); \
    VRD(1); SBAR(); GAPA(C0 = MFMA32(kf[2], qr[1], C0),   P0[10], P0[11], P0[12], P0[13], pw1[0] = PKW(P0, 8), pw1[1] = PKW(P0, 10), pw1); \
    VRD(5); SBAR(); GAPA(C1 = MFMA32(kf[3], qr[1], C1),   P0[14], P0[15], P1[0], P1[1],   pw1[2] = PKW(P0, 12), pw1[3] = PKW(P0, 14), pw1); \
    VRD(2); SBAR(); GAPA(C0 = MFMA32(kf[4], qr[2], C0),   P1[2], P1[3], P1[4], P1[5],     pw2[0] = PKW(P1, 0), pw2[1] = PKW(P1, 2), pw2); \
    VRD(6); SBAR(); GAPA(C1 = MFMA32(kf[5], qr[2], C1),   P1[6], P1[7], P1[8], P1[9],     pw2[2] = PKW(P1, 4), pw2[3] = PKW(P1, 6), pw2); \
    VRD(3); SBAR(); GAPA(C0 = MFMA32(kf[6], qr[3], C0),   P1[10], P1[11], P1[12], P1[13], pw3[0] = PKW(P1, 8), pw3[1] = PKW(P1, 10), pw3); \
    VRD(7); SBAR(); GAPA(C1 = MFMA32(kf[7], qr[3], C1),   P1[14], P1[15], 0.f, 0.f,       pw3[2] = PKW(P1, 12), pw3[3] = PKW(P1, 14), pw3); \
    l_reg += sacc; \
    if (GK) { DMA_K((t) + 3, sl_cur); } if (GV) { DMA_V((t) + 1, sl_next); } \
    { float a = MX3(C0[0], C0[1], C1[0]), b = MX3(C0[2], C0[3], C1[1]); a = MX3(a, C1[2], C1[3]); \
      _Pragma("unroll") for (int r = 4; r < 16; r += 4) { a = MX3(a, C0[r], C0[r + 1]); b = MX3(b, C0[r + 2], C0[r + 3]); a = MX3(a, C1[r], C1[r + 1]); b = MX3(b, C1[r + 2], C1[r + 3]); } \
      float rm = __builtin_fmaxf(a, b); { auto rr = __builtin_amdgcn_permlane32_swap(__float_as_uint(rm), __float_as_uint(rm), false, false); rm = __builtin_fmaxf(__uint_as_float(rr[0]), __uint_as_float(rr[1])); } \
      resc = false; \
      if (__builtin_expect(__any(rm > (float)THRL), 0)) { const float dl = __builtin_fmaxf(rm, 0.f); mhat += dl; \
        _Pragma("unroll") for (int r = 0; r < 16; ++r) { C0[r] -= dl; C1[r] -= dl; } \
        _Pragma("unroll") for (int r = 0; r < 16; ++r) negm[r] = -mhat; asm volatile("" : "+v"(negm)); \
        const float f = __builtin_amdgcn_exp2f(-dl); l_reg *= f; if (hi == 0) wsf[r32] = f; resc = true; } } \
    SBAR(); \
    GAPB(o[0] = MFMA32(PAF(0), VFR(0), o[0]), C0, 0); \
    GAPB(o[1] = MFMA32(PAF(0), VFR(4), o[1]), C0, 4); \
    KRD(GL, 0); GAPB(o[0] = MFMA32(PAF(1), VFR(1), o[0]), C0, 8); \
    KRD(GL, 1); GAPB(o[1] = MFMA32(PAF(1), VFR(5), o[1]), C0, 12); \
    KRD(GL, 2); GAPB(o[0] = MFMA32(PAF(2), VFR(2), o[0]), C1, 0); \
    KRD(GL, 3); GAPB(o[1] = MFMA32(PAF(2), VFR(6), o[1]), C1, 4); \
    GAPB(o[0] = MFMA32(PAF(3), VFR(3), o[0]), C1, 8); \
    GAPB(o[1] = MFMA32(PAF(3), VFR(7), o[1]), C1, 12); \
    } while (0)
  int t = 1;
  for (; t + 5 < NT; t += 2) {
    STEP(pB0, pB1, pA0, pA1, t, true, true, true);     WAIT_BAR(2); RESC(); ROT();
    STEP(pA0, pA1, pB0, pB1, t + 1, true, true, true); WAIT_BAR(2); RESC(); ROT();
  }
  #define ENDW(tt) do { if ((tt) + 3 < NT) { WAIT_BAR(2); } else if ((tt) + 2 < NT) { WAIT_BAR(1); } else { WAIT_BAR(0); } } while (0)
  for (; t + 1 < NT; t += 2) {
    STEP(pB0, pB1, pA0, pA1, t, (t + 3 < NT), (t + 1 < NT), (t + 1 < NT));       ENDW(t);     RESC(); ROT();
    STEP(pA0, pA1, pB0, pB1, t + 1, (t + 4 < NT), (t + 2 < NT), (t + 2 < NT));   ENDW(t + 1); RESC(); ROT();
  }
  bf16* Zw = Zu + (long)(wid * QBLK) * P;
  u32x4 zpre[4];
  _Pragma("unroll") for (int i = 0; i < 4; ++i) zpre[i] = *(const u32x4*)(Zw + (long)(i * 8 + (lane >> 3)) * P + (lane & 7) * 8);
  STEP(pB0, pB1, pA0, pA1, NT - 1, false, false, false); RESC();
  { float sacc = pB0[0] + pB0[1]; _Pragma("unroll") for (int r = 2; r < 16; ++r) sacc += pB0[r]; _Pragma("unroll") for (int r = 0; r < 16; ++r) sacc += pB1[r]; l_reg += sacc;
    pw0 = (u32x4){PKW(pB0, 0), PKW(pB0, 2), PKW(pB0, 4), PKW(pB0, 6)}; pw1 = (u32x4){PKW(pB0, 8), PKW(pB0, 10), PKW(pB0, 12), PKW(pB0, 14)}; pw2 = (u32x4){PKW(pB1, 0), PKW(pB1, 2), PKW(pB1, 4), PKW(pB1, 6)}; pw3 = (u32x4){PKW(pB1, 8), PKW(pB1, 10), PKW(pB1, 12), PKW(pB1, 14)};
    SBAR(); pv(o, vb0 + sl_cur, PAF(0), PAF(1), PAF(2), PAF(3)); }
  #undef PKW
  #undef PAF
  #undef VFR
  #undef PIN
  #undef MX3
  #undef GAPA
  #undef GAPB
  #undef EX
  #undef VRD
  #undef KRD
  #undef STEP
  #undef ENDW
  { auto rr = __builtin_amdgcn_permlane32_swap(__float_as_uint(l_reg), __float_as_uint(l_reg), false, false); l_reg = __uint_as_float(rr[0]) + __uint_as_float(rr[1]); }
  if (hi == 0) wsf[32 + r32] = l_reg; asm volatile("s_waitcnt lgkmcnt(0)" ::: "memory");
  float rli[16];
  #pragma unroll
  for (int r = 0; r < 16; ++r) rli[r] = __builtin_amdgcn_rcpf(wsf[32 + crow(r, hi)]);
  { bf16* stg = (bf16*)(shm + LDS_OST) + wid * 2048;
    #pragma unroll
    for (int r = 0; r < 16; ++r) { const int orow = crow(r, hi);
      #pragma unroll
      for (int d0 = 0; d0 < 2; ++d0) stg[orow * 64 + d0 * 32 + r32] = __float2bfloat16(o[d0][r] * rli[r]); }
    asm volatile("s_waitcnt lgkmcnt(0)" ::: "memory");
    #pragma unroll
    for (int i = 0; i < 4; ++i) { const int row = i * 8 + (lane >> 3), ch = lane & 7; const u32x4 v = *(const u32x4*)(stg + row * 64 + ch * 8);
      u32x4* zp = (u32x4*)(Zw + (long)row * P + ch * 8); const u32x4 z = zpre[i]; u32x4 w;
      w.x = pk2(bflo(v.x) * silu(bflo(z.x)), bfhi(v.x) * silu(bfhi(z.x))); w.y = pk2(bflo(v.y) * silu(bflo(z.y)), bfhi(v.y) * silu(bfhi(z.y)));
      w.z = pk2(bflo(v.z) * silu(bflo(z.z)), bfhi(v.z) * silu(bfhi(z.z))); w.w = pk2(bflo(v.w) * silu(bflo(z.w)), bfhi(v.w) * silu(bfhi(z.w)));
      *zp = w; } }
  asm volatile("s_waitcnt vmcnt(0) lgkmcnt(0)\n\ts_barrier" ::: "memory");
  #undef DMA_K
  #undef DMA_V
  #undef START
  #undef RESC
  #undef ROT
}
#undef SBAR
#undef WAIT_BAR
}

#define XB_TMO      128
#define XB_XCNT(j)  (256  + 64 * (j))
#define XB_XSUB(j)  (1280 + 64 * (j))
#define XB_XGEN(j)  (2304 + 64 * (j))
#define XB_TOP      3328
#define XB_TOPGEN   3392
#define XCD_BAR_WORDS 3456
#define XB_SPIN_CAP (1u << 20)
__device__ __forceinline__ unsigned xb_ld(unsigned* p)              { return __hip_atomic_load(p, __ATOMIC_RELAXED, __HIP_MEMORY_SCOPE_AGENT); }
__device__ __forceinline__ unsigned xb_add(unsigned* p, unsigned v) { return __hip_atomic_fetch_add(p, v, __ATOMIC_RELAXED, __HIP_MEMORY_SCOPE_AGENT); }
__device__ __forceinline__ unsigned xb_xcc_id() { return (unsigned)__builtin_amdgcn_s_getreg((3 << 11) | 20) & 0xFu; }
#define XB_SPIN(cond, bar) do { unsigned _sp = 0; while (cond) { __builtin_amdgcn_s_sleep(1); \
    if ((++_sp & 255u) == 0u) { if (xb_ld(&(bar)[XB_TMO])) break; if (_sp > XB_SPIN_CAP) { atomicAdd(&(bar)[XB_TMO], 1u); break; } } } } while (0)
struct XcdBarrier { unsigned* bar; unsigned x; volatile LAS unsigned* st; };
__device__ __forceinline__ XcdBarrier xcd_barrier_post(unsigned* bar, volatile LAS unsigned* st) {
    XcdBarrier b; b.bar = bar; b.x = xb_xcc_id(); b.st = st;
    if (threadIdx.x == 0) (void)xb_add(&bar[XB_XCNT(b.x)], 1u);
    return b;
}
__device__ __forceinline__ void xcd_barrier_complete(unsigned* bar, unsigned x, unsigned& nloc, unsigned& nx) {
    const unsigned G = gridDim.x * gridDim.y * gridDim.z;
    unsigned sum, cnt, mine, sp = 0u;
    for (;;) {
        sum = 0u; cnt = 0u; mine = 0u;
#pragma unroll 1
        for (unsigned j = 0; j < 16; ++j) { const unsigned c = xb_ld(&bar[XB_XCNT(j)]); sum += c; cnt += (c > 0u) ? 1u : 0u; mine = (j == x) ? c : mine; }
        if (sum == G) break;
        __builtin_amdgcn_s_sleep(1);
        if ((++sp & 255u) == 0u) { if (xb_ld(&bar[XB_TMO])) break; if (sp > XB_SPIN_CAP) { atomicAdd(&bar[XB_TMO], 1u); break; } }
    }
    nloc = mine > 0u ? mine : 1u; nx = cnt > 0u ? cnt : 1u;
}
__device__ __forceinline__ void xcd_barrier(const XcdBarrier& b) {
    asm volatile("s_waitcnt vmcnt(0)" ::: "memory");
    __syncthreads();
    int t0 = threadIdx.x; asm volatile("" : "+v"(t0));
    if (t0 == 0) {
        unsigned* bar = b.bar;
        __builtin_amdgcn_s_waitcnt(0);
        unsigned nloc = b.st[0], nx = b.st[1];
        if (nloc == 0u) { xcd_barrier_complete(bar, b.x, nloc, nx); b.st[0] = nloc; b.st[1] = nx; }
        const unsigned old = xb_add(&bar[XB_XSUB(b.x)], 1u);
        const unsigned gen = old / nloc;
        if (old + 1u == (gen + 1u) * nloc) {
            __builtin_amdgcn_fence(__ATOMIC_RELEASE, "agent");
            asm volatile("s_waitcnt vmcnt(0)" ::: "memory");
            const unsigned og = xb_add(&bar[XB_TOP], 1u);
            const unsigned tg = og / nx;
            if (og + 1u == (tg + 1u) * nx) xb_add(&bar[XB_TOPGEN], 1u);
            else XB_SPIN(xb_ld(&bar[XB_TOPGEN]) == tg, bar);
            __builtin_amdgcn_fence(__ATOMIC_ACQUIRE, "agent");
            xb_add(&bar[XB_XGEN(b.x)], 1u);
            asm volatile("s_waitcnt vmcnt(0)" ::: "memory");
        } else {
            XB_SPIN(xb_ld(&bar[XB_XGEN(b.x)]) == gen, bar);
            __builtin_amdgcn_fence(__ATOMIC_ACQUIRE, "agent");
            asm volatile("s_waitcnt vmcnt(0)" ::: "memory");
        }
    }
    __syncthreads();
}

__device__ __forceinline__ void xcc_local_barrier(unsigned* cnt, unsigned target) {
    asm volatile("s_waitcnt vmcnt(0)" ::: "memory");
    __syncthreads();
    int t0 = threadIdx.x; asm volatile("" : "+v"(t0));
    if (t0 == 0) {
        (void)xb_add(cnt, 1u);
        unsigned sp = 0; while (xb_ld(cnt) < target) { __builtin_amdgcn_s_sleep(1); if (++sp > (1u << 24)) break; }
        __builtin_amdgcn_fence(__ATOMIC_ACQUIRE, "agent");
        asm volatile("s_waitcnt vmcnt(0)" ::: "memory");
    }
    __syncthreads();
}

struct Args { const float* in[15]; float* out; unsigned char* ws; int ph_lo, ph_hi; };

__device__ __forceinline__ float wave_sum(float v) {
#pragma unroll
    for (int o = 1; o < 64; o <<= 1) v += __shfl_xor(v, o);
    return v;
}

__device__ __forceinline__ void tr_item(const float* W, int ldw, int k0, int n0, bf16_t* dst, int dpitch, const float* gk, float sc, LAS float* scr, int lane) {
#pragma unroll
    for (int i = 0; i < 32; ++i) { const int kk = 2 * i + (lane >> 5); float v = W[(size_t)(k0 + kk) * ldw + n0 + (lane & 31)]; if (gk) v *= gk[k0 + kk]; scr[kk * 33 + (lane & 31)] = v * sc; }
    asm volatile("s_waitcnt lgkmcnt(0)" ::: "memory");
    const int c = lane & 7;
#pragma unroll
    for (int j = 0; j < 4; ++j) { const int n = (lane >> 3) + 8 * j; const LAS float* s = scr + (8 * c) * 33 + n;
        u32x4 o; o.x = pk2(s[0 * 33], s[1 * 33]); o.y = pk2(s[2 * 33], s[3 * 33]); o.z = pk2(s[4 * 33], s[5 * 33]); o.w = pk2(s[6 * 33], s[7 * 33]);
        *(u32x4*)(dst + (size_t)n * dpitch + 8 * c) = o; }
    asm volatile("s_waitcnt lgkmcnt(0)" ::: "memory");
}
__device__ __forceinline__ int map_col(int n0) {
    if (n0 < 2048) return n0;
    if (n0 < 2080) return C_GL;
    if (n0 < 3104) return C_ZA + (n0 - 2080);
    if (n0 < 4128) return C_QB + (n0 - 3104);
    if (n0 < 4384) return C_KB + (n0 - 4128);
    if (n0 < 4640) return C_VB + (n0 - 4384);
    if (n0 < 5664) return C_ZB + (n0 - 4640);
    if (n0 < 6688) return C_MA + (n0 - 5664);
    return C_MB + (n0 - 6688);
}
constexpr int CV_IN = 16 * 241, CV_SQ = 16 * 32, CV_ITEMS = CV_IN + 3 * CV_SQ;
__device__ __forceinline__ void convert_item(const Args& args, int l, int r, bf16_t* WIN, bf16_t* WBR, bf16_t* WOUT, LAS float* scr, int lane) {
    if (r < CV_IN) { const int kb = r / 241, nb = r % 241, n0 = 32 * nb;
        tr_item(args.in[3] + (size_t)l * DM * IN_DIM, IN_DIM, 64 * kb, n0, WIN + (size_t)l * WIN_L + (size_t)map_col(n0) * DM + 64 * kb, DM, args.in[2] + l * DM, n0 < 512 ? 0.08838834764831845f : 1.f, scr, lane);
        return; }
    r -= CV_IN;
    const int which = r / CV_SQ; r %= CV_SQ; const int kb = r / 32, nb = r % 32;
    if (which == 0) tr_item(args.in[11] + (size_t)l * DM * DM, DM, 64 * kb, 32 * nb, WBR + (size_t)l * DM * 2048 + (size_t)(32 * nb) * 2048 + 64 * kb, 2048, nullptr, 1.f, scr, lane);
    else if (which == 1) tr_item(args.in[12] + (size_t)l * DM * DM, DM, 64 * kb, 32 * nb, WBR + (size_t)l * DM * 2048 + (size_t)(32 * nb) * 2048 + 1024 + 64 * kb, 2048, nullptr, 1.f, scr, lane);
    else tr_item(args.in[13] + (size_t)l * DM * DM, DM, 64 * kb, 32 * nb, WOUT + (size_t)l * DM * DM + (size_t)(32 * nb) * DM + 64 * kb, DM, nullptr, 1.f, scr, lane);
}

__device__ __forceinline__ void x_rows_to_bf16(const float* x, bf16_t* xb, float* ssp, int gw, int ngw, int lane) {
    for (int m = gw; m < NTOK; m += ngw) {
        const f32x4* xr = (const f32x4*)(x + (size_t)m * DM) + lane; f32x4 v[4]; float s = 0.f;
#pragma unroll
        for (int j = 0; j < 4; ++j) { v[j] = xr[64 * j]; s += (v[j].x * v[j].x + v[j].y * v[j].y) + (v[j].z * v[j].z + v[j].w * v[j].w); }
        s = wave_sum(s);
        u32x2* o8 = (u32x2*)(xb + (size_t)m * DM) + lane;
#pragma unroll
        for (int j = 0; j < 4; ++j) { u32x2 w; w.x = pk2(v[j].x, v[j].y); w.y = pk2(v[j].z, v[j].w); o8[64 * j] = w; }
        if (lane < 16) ssp[(size_t)m * 16 + lane] = (lane == 0) ? s : 0.f;
    }
}

constexpr int PL_GL = 0, PL_TOT = 8192, PL_QF = 12288, PL_KF = PL_QF + 17408, PL_QB = PL_KF + 17408, PL_KB = PL_QB + 17408, PL_VT = PL_KB + 17408, PL_A = PL_VT + 36864, PL_END = PL_A + 9216;
static_assert(PL_END <= RING_BYTES, "prep LDS");
struct PrepIn { u32x2 gl; u32x4 v[4]; };
struct PrepW { float wf[16], wb[16], bf, bb; };
__device__ __forceinline__ void gla_prep_loadw(PrepW& w, const float* wgf, const float* bgf, const float* wgb, const float* bgb, int h) {
    int tid = threadIdx.x; asm volatile("" : "+v"(tid)); const int c = tid & 127;
#pragma unroll
    for (int r = 0; r < 16; ++r) { w.wf[r] = wgf[r * 512 + h * 128 + c]; w.wb[r] = wgb[r * 512 + h * 128 + c]; }
    w.bf = bgf[h * 128 + c]; w.bb = bgb[h * 128 + c];
}
__device__ __forceinline__ void gla_prep_load(PrepIn& in, const bf16_t* proj, int gc, int h) {
    int tid = threadIdx.x; asm volatile("" : "+v"(tid));
    const int row0 = gc * 64;
    { const int t = tid >> 3, r = (tid & 7) * 4; in.gl = *(const u32x2*)(proj + (size_t)(row0 + t) * LDP + C_GL + r); }
#pragma unroll
    for (int i = 0; i < 4; ++i) { const int idx = tid + 512 * i, t = idx & 63, dv = (idx >> 6) * 8; in.v[i] = *(const u32x4*)(proj + (size_t)(row0 + t) * LDP + C_VA + h * 256 + dv); }
}
__device__ __forceinline__ void gla_prep_tile(LAS unsigned char* lds, const PrepIn& in, const PrepW& pw, int gc, int h, bf16_t* proj,
                                              float* ef, float* eb, bf16_t* kltf, bf16_t* kltb, bf16_t* vtg, bf16_t* pst, int rmask) {
    int tid = threadIdx.x; asm volatile("" : "+v"(tid));
    const int lane = tid & 63, wave = tid >> 6, c = tid & 127, s = tid >> 7, l32 = lane & 31, hh = lane >> 5;
    const int row0 = gc * 64;
    LAS float* GLl = (LAS float*)(lds + PL_GL); LAS float* TOT = (LAS float*)(lds + PL_TOT);
    LAS bf16_t* QFl = (LAS bf16_t*)(lds + PL_QF); LAS bf16_t* KFl = (LAS bf16_t*)(lds + PL_KF); LAS bf16_t* QBl = (LAS bf16_t*)(lds + PL_QB); LAS bf16_t* KBl = (LAS bf16_t*)(lds + PL_KB);
    LAS bf16_t* VTl = (LAS bf16_t*)(lds + PL_VT); LAS bf16_t* Al = (LAS bf16_t*)(lds + PL_A);
    { const int t = tid >> 3, r = (tid & 7) * 4; const u32x2 g = in.gl;
      GLl[t * 32 + r] = bflo(g.x); GLl[t * 32 + r + 1] = bfhi(g.x); GLl[t * 32 + r + 2] = bflo(g.y); GLl[t * 32 + r + 3] = bfhi(g.y); }
#pragma unroll
    for (int i = 0; i < 4; ++i) { const int idx = tid + 512 * i, t = idx & 63, dv = (idx >> 6) * 8;
        const u32x4 v = in.v[i];
        VTl[(dv + 0) * 72 + t] = (bf16_t)(v.x & 0xffffu); VTl[(dv + 1) * 72 + t] = (bf16_t)(v.x >> 16);
        VTl[(dv + 2) * 72 + t] = (bf16_t)(v.y & 0xffffu); VTl[(dv + 3) * 72 + t] = (bf16_t)(v.y >> 16);
        VTl[(dv + 4) * 72 + t] = (bf16_t)(v.z & 0xffffu); VTl[(dv + 5) * 72 + t] = (bf16_t)(v.z >> 16);
        VTl[(dv + 6) * 72 + t] = (bf16_t)(v.w & 0xffffu); VTl[(dv + 7) * 72 + t] = (bf16_t)(v.w >> 16); }
    const float bfv = pw.bf, bbv = pw.bb;
    bf16_t qraw[16], kraw[16];
#pragma unroll
    for (int j = 0; j < 16; ++j) { qraw[j] = proj[(size_t)(row0 + 16 * s + j) * LDP + C_QA + h * 128 + c]; kraw[j] = proj[(size_t)(row0 + 16 * s + j) * LDP + C_KA + h * 128 + c]; }
    LDS_BARRIER();
    float pf[16], sb[16];
#pragma unroll
    for (int j = 0; j < 16; ++j) { const int t = 16 * s + j; float zf = bfv, zb = bbv;
#pragma unroll
        for (int r = 0; r < 16; r += 4) { const f32x4 ga = *(const LAS f32x4*)(GLl + t * 32 + r), gb2 = *(const LAS f32x4*)(GLl + t * 32 + 16 + r);
            zf += ga[0] * pw.wf[r] + ga[1] * pw.wf[r + 1] + ga[2] * pw.wf[r + 2] + ga[3] * pw.wf[r + 3]; zb += gb2[0] * pw.wb[r] + gb2[1] * pw.wb[r + 1] + gb2[2] * pw.wb[r + 2] + gb2[3] * pw.wb[r + 3]; }
        pf[j] = logsig(zf) * (1.f / 16.f); sb[j] = logsig(zb) * (1.f / 16.f); }
#pragma unroll
    for (int j = 1; j < 16; ++j) pf[j] += pf[j - 1];
#pragma unroll
    for (int j = 14; j >= 0; --j) sb[j] += sb[j + 1];
    TOT[(0 * 4 + s) * 128 + c] = pf[15]; TOT[(1 * 4 + s) * 128 + c] = sb[0];
    LDS_BARRIER();
    float offf = 0.f, allf = 0.f, offb = 0.f, allb = 0.f;
#pragma unroll
    for (int s2 = 0; s2 < 4; ++s2) { const float a = TOT[(0 * 4 + s2) * 128 + c], b = TOT[(1 * 4 + s2) * 128 + c]; allf += a; allb += b; if (s2 < s) offf += a; if (s2 > s) offb += b; }
    const float etf = fexp(allf), etb = fexp(allb);
    if (s == 0) { ef[(size_t)(gc * 4 + h) * 128 + c] = etf; eb[(size_t)(gc * 4 + h) * 128 + c] = etb; }
    unsigned klf[8], klb[8];
#pragma unroll
    for (int j = 0; j < 16; j += 2) {
        float o_klf[2], o_klb[2];
#pragma unroll
        for (int e = 0; e < 2; ++e) { const int t = 16 * s + j + e;
            const float q = bf2f(qraw[j + e]), k = bf2f(kraw[j + e]);
            const float bfw = offf + pf[j + e], bbw = offb + sb[j + e];
            const float Ef = fexp(bfw), Eb = fexp(bbw), rEf = __builtin_amdgcn_rcpf(Ef), rEb = __builtin_amdgcn_rcpf(Eb);
            const bf16_t qsf = f2bf(q * Ef), ksf = f2bf(k * rEf), qsb = f2bf(q * Eb), ksb = f2bf(k * rEb);
            o_klf[e] = k * (rEf * etf); o_klb[e] = k * (rEb * etb);
            pst[(size_t)((row0 + t) & rmask) * LDP + C_QA + h * 128 + c] = qsf; pst[(size_t)((row0 + t) & rmask) * LDP + C_KA + h * 128 + c] = qsb;
            QFl[t * 136 + c] = qsf; KFl[t * 136 + c] = ksf; QBl[t * 136 + c] = qsb; KBl[t * 136 + c] = ksb; }
        klf[j >> 1] = pk2(o_klf[0], o_klf[1]); klb[j >> 1] = pk2(o_klb[0], o_klb[1]);
    }
    { u32x4* d = (u32x4*)(kltf + ((size_t)(gc * 4 + h) * 128 + c) * 64 + 16 * s); d[0] = (u32x4){klf[0], klf[1], klf[2], klf[3]}; d[1] = (u32x4){klf[4], klf[5], klf[6], klf[7]};
      u32x4* d2 = (u32x4*)(kltb + ((size_t)(gc * 4 + h) * 128 + c) * 64 + 16 * s); d2[0] = (u32x4){klb[0], klb[1], klb[2], klb[3]}; d2[1] = (u32x4){klb[4], klb[5], klb[6], klb[7]}; }
    LDS_BARRIER();
    { const int dir = wave >> 2, bi = (wave >> 1) & 1, bj = wave & 1;
      const LAS bf16_t* Qt = dir ? QBl : QFl; const LAS bf16_t* Kt = dir ? KBl : KFl;
      f32x16 acc = f32x16{};
#pragma unroll
      for (int ks = 0; ks < 8; ++ks) { const bf16x8 a = *(const LAS bf16x8*)(Qt + (32 * bi + l32) * 136 + 16 * ks + 8 * hh); const bf16x8 b = *(const LAS bf16x8*)(Kt + (32 * bj + l32) * 136 + 16 * ks + 8 * hh); acc = MFMA32(a, b, acc); }
      const int jj = 32 * bj + l32;
#pragma unroll
      for (int r = 0; r < 16; ++r) { const int ii = 32 * bi + crow(r, hh); const bool keep = dir ? (jj > ii) : (jj <= ii); if (keep) Al[ii * 72 + jj] = f2bf(acc[r]); } }
    LDS_BARRIER();
    {
#pragma unroll
      for (int tb = 0; tb < 2; ++tb) { f32x16 acc = f32x16{};
#pragma unroll
        for (int ks = 0; ks < 4; ++ks) { const bf16x8 a = *(const LAS bf16x8*)(VTl + (32 * wave + l32) * 72 + 16 * ks + 8 * hh); const bf16x8 b = *(const LAS bf16x8*)(Al + (32 * tb + l32) * 72 + 16 * ks + 8 * hh); acc = MFMA32(a, b, acc); }
        bf16_t* op = pst + (size_t)((row0 + 32 * tb + l32) & rmask) * LDP + C_VA + h * 256 + 32 * wave + 4 * hh;
#pragma unroll
        for (int g = 0; g < 4; ++g) { u32x2 w; w.x = pk2(acc[4 * g], acc[4 * g + 1]); w.y = pk2(acc[4 * g + 2], acc[4 * g + 3]); *(u32x2*)(op + 8 * g) = w; } }
#pragma unroll
      for (int i = 0; i < 4; ++i) { const int idx = tid + 512 * i, dv = idx >> 3, tg = idx & 7;
        *(u32x4*)(vtg + ((size_t)(gc * 4 + h) * 256 + dv) * 64 + 8 * tg) = *(const LAS u32x4*)(VTl + dv * 72 + 8 * tg); } }
    LDS_BARRIER();
}

template <int NB>
__device__ __forceinline__ void qk_norm_items(bf16_t* proj, int it0, int itstride, int nitems, int T, const float* qg, const float* kg, const float* tabc, const float* tabs, int lane, bf16_t* pst, int rmask) {
    const int li = lane & 15, d0 = 4 * li, half = li >> 3, within = li & 7; const bool first = within < 4;
    bf16_t* p[NB]; bf16_t* pw[NB]; u32x2 u[NB]; f32x4 c4[NB], s4[NB]; bool isq[NB], ok[NB];
#pragma unroll
    for (int i = 0; i < NB; ++i) { const int it = it0 + i * itstride; ok[i] = it < nitems; const int itc = ok[i] ? it : 0; const int row = itc, grp = 4; isq[i] = false;
        p[i] = proj + (size_t)row * LDP + (grp < 4 ? C_QB + 256 * grp : C_KB) + 4 * lane; pw[i] = pst + (size_t)(row & rmask) * LDP + (grp < 4 ? C_QB + 256 * grp : C_KB) + 4 * lane; u[i] = *(const u32x2*)p[i];
        const int t = row % T; const int pos = half ? (t & 63) : (t >> 6);
        c4[i] = *(const f32x4*)(tabc + pos * 16 + 4 * (within & 3)); s4[i] = *(const f32x4*)(tabs + pos * 16 + 4 * (within & 3)); }
    const f32x4 gq = *(const f32x4*)(qg + d0), gk = *(const f32x4*)(kg + d0);
#pragma unroll
    for (int i = 0; i < NB; ++i) {
        float x[4] = {bflo(u[i].x), bfhi(u[i].x), bflo(u[i].y), bfhi(u[i].y)};
        float ss = (x[0] * x[0] + x[1] * x[1]) + (x[2] * x[2] + x[3] * x[3]);
        ss += __shfl_xor(ss, 1); ss += __shfl_xor(ss, 2); ss += __shfl_xor(ss, 4); ss += __shfl_xor(ss, 8);
        const float rs = __builtin_amdgcn_rsqf(ss * (1.f / 64.f) + EPS);
        const f32x4 g4 = isq[i] ? gq : gk; const float sc = isq[i] ? C2 : 1.f;
        float o[4];
#pragma unroll
        for (int e = 0; e < 4; ++e) { const float xn = x[e] * rs * g4[e]; const float pr = __shfl_xor(xn, 4);
            o[e] = (first ? (xn * c4[i][e] - pr * s4[i][e]) : (xn * c4[i][e] + pr * s4[i][e])) * sc; }
        u32x2 w; w.x = pk2(o[0], o[1]); w.y = pk2(o[2], o[3]); if (ok[i]) *(u32x2*)pw[i] = w;
    }
}

constexpr int CH_CB = 36864, CH_OFFK = 17408, CH_OFFE = 17408 + 18432;
__device__ __forceinline__ void gla_chain(LAS unsigned char* lds, int ci, int nchunk, bf16_t* proj, const bf16_t* kltf, const bf16_t* kltb, const bf16_t* vtg, const float* ef, const float* eb, bf16_t* ob, bf16_t* of2, unsigned* done, bf16_t* dry = nullptr) {
    int tid = threadIdx.x; asm volatile("" : "+v"(tid));
    const int lane = tid & 63, wave = __builtin_amdgcn_readfirstlane(tid >> 6);
    const int dir = ci & 1, bh = ci >> 1, b = bh >> 2, h = bh & 3, l32 = lane & 31, hh = lane >> 5;
    const bf16_t* klt = dir ? kltb : kltf; const float* ee = dir ? eb : ef;
    const int qcol = (dir ? C_KA : C_QA) + h * 128;
    const int qt0 = tid >> 4, qc0 = tid & 15;
    const int kd0 = tid >> 3, kc0 = tid & 7;
    f32x16 S[4];
#pragma unroll
    for (int i = 0; i < 4; ++i) S[i] = f32x16{};
#define CH_GC(st) (b * nchunk + (dir ? (nchunk - 1 - (st)) : (st)))
#define CH_CLAMP(st) ((st) < nchunk ? (st) : nchunk - 1)
#define CH_LOAD_T(SET, st) do { const int gc_ = CH_GC(CH_CLAMP(st)); \
        q0##SET = *(const u32x4*)(proj + (size_t)(gc_ * 64 + qt0) * LDP + qcol + qc0 * 8); q1##SET = *(const u32x4*)(proj + (size_t)(gc_ * 64 + qt0 + 32) * LDP + qcol + qc0 * 8); \
        const bf16_t* kb_ = klt + (size_t)(gc_ * 4 + h) * 128 * 64; \
        k0##SET = *(const u32x4*)(kb_ + (size_t)kd0 * 64 + kc0 * 8); k1##SET = *(const u32x4*)(kb_ + (size_t)(kd0 + 64) * 64 + kc0 * 8); \
        if (tid < 32) en##SET = *(const f32x4*)(ee + (size_t)(gc_ * 4 + h) * 128 + tid * 4); } while (0)
#define CH_LOAD_V(SET, st) do { const int gc_ = CH_GC(CH_CLAMP(st)); _Pragma("unroll") for (int ks = 0; ks < 4; ++ks) vf##SET[ks] = *(const bf16x8*)(vtg + ((size_t)(gc_ * 4 + h) * 256 + 32 * wave + l32) * 64 + 16 * ks + 8 * hh); } while (0)
#define CH_STAGE(SET, buf) do { *(LAS u32x4*)((buf) + qt0 * 272 + qc0 * 16) = q0##SET; *(LAS u32x4*)((buf) + (qt0 + 32) * 272 + qc0 * 16) = q1##SET; \
        *(LAS u32x4*)((buf) + CH_OFFK + kd0 * 144 + kc0 * 16) = k0##SET; *(LAS u32x4*)((buf) + CH_OFFK + (kd0 + 64) * 144 + kc0 * 16) = k1##SET; \
        if (tid < 32) *(LAS f32x4*)((buf) + CH_OFFE + tid * 16) = en##SET; } while (0)
    u32x4 q0A, q1A, k0A, k1A, q0B, q1B, k0B, k1B; f32x4 enA = (f32x4){0.f, 0.f, 0.f, 0.f}, enB = enA; bf16x8 vfA[4], vfB[4];
    CH_LOAD_T(A, 0); CH_LOAD_V(A, 0);
    CH_STAGE(A, lds);
    CH_LOAD_T(B, 1); CH_LOAD_V(B, 1);
    __syncthreads();
#define CH_LDQ(bufi, blk_) do { _Pragma("unroll") for (int s_ = 0; s_ < 2; ++s_) _Pragma("unroll") for (int tb_ = 0; tb_ < 2; ++tb_) { \
        const LAS unsigned char* qp_ = cur + (32 * tb_ + l32) * 272 + (32 * (blk_) + 16 * s_ + 4 * hh) * 2; \
        const u32x2 lo_ = *(const LAS u32x2*)qp_, hi_ = *(const LAS u32x2*)(qp_ + 16); qv[bufi][s_][tb_] = (u32x4){lo_.x, lo_.y, hi_.x, hi_.y}; } } while (0)
#define CH_LDE(bufi, blk_) do { _Pragma("unroll") for (int g_ = 0; g_ < 4; ++g_) evv[bufi][g_] = *(const LAS f32x4*)(cur + CH_OFFE + (32 * (blk_) + 8 * g_ + 4 * hh) * 4); } while (0)
#define CH_LDK(bufi, blk_) do { _Pragma("unroll") for (int ks_ = 0; ks_ < 4; ++ks_) kfv[bufi][ks_] = *(const LAS bf16x8*)(cur + CH_OFFK + (32 * (blk_) + l32) * 144 + (16 * ks_ + 8 * hh) * 2); } while (0)
#define CH_STEP(st, CUR, NXT) do { \
        const int gc = CH_GC(st), row0 = gc * 64; \
        LAS unsigned char* cur = lds + ((st) & 1) * CH_CB; LAS unsigned char* nxt = lds + (((st) + 1) & 1) * CH_CB; \
        CH_LOAD_T(CUR, (st) + 2); \
        f32x16 ot[2]; ot[0] = f32x16{}; ot[1] = f32x16{}; \
        u32x4 qv[2][2][2]; bf16x8 kfv[2][4]; \
        CH_LDQ(0, 0); \
        _Pragma("unroll") for (int blk = 0; blk < 4; ++blk) { \
            if (blk < 3) { CH_LDQ((blk + 1) & 1, blk + 1); } else { CH_LDK(0, 0); } \
            __builtin_amdgcn_sched_barrier(0); \
            _Pragma("unroll") for (int s = 0; s < 2; ++s) { \
                u32x4 pa; pa.x = pk2(S[blk][8 * s + 0], S[blk][8 * s + 1]); pa.y = pk2(S[blk][8 * s + 2], S[blk][8 * s + 3]); pa.z = pk2(S[blk][8 * s + 4], S[blk][8 * s + 5]); pa.w = pk2(S[blk][8 * s + 6], S[blk][8 * s + 7]); \
                const bf16x8 sa = __builtin_bit_cast(bf16x8, pa); \
                _Pragma("unroll") for (int tb = 0; tb < 2; ++tb) ot[tb] = MFMA32(sa, __builtin_bit_cast(bf16x8, qv[blk & 1][s][tb]), ot[tb]); } \
            __builtin_amdgcn_sched_barrier(0); } \
        _Pragma("unroll") for (int blk = 0; blk < 4; ++blk) _Pragma("unroll") for (int g = 0; g < 4; ++g) { const f32x4 ev = *(const LAS f32x4*)(cur + CH_OFFE + (32 * blk + 8 * g + 4 * hh) * 4); \
            S[blk][4 * g] *= ev[0]; S[blk][4 * g + 1] *= ev[1]; S[blk][4 * g + 2] *= ev[2]; S[blk][4 * g + 3] *= ev[3]; } \
        __builtin_amdgcn_sched_barrier(0); \
        _Pragma("unroll") for (int blk = 0; blk < 4; ++blk) { \
            if (blk < 3) { CH_LDK((blk + 1) & 1, blk + 1); } \
            __builtin_amdgcn_sched_barrier(0); \
            _Pragma("unroll") for (int ks = 0; ks < 4; ++ks) S[blk] = MFMA32(kfv[blk & 1][ks], vf##CUR[ks], S[blk]); \
            __builtin_amdgcn_sched_barrier(0); } \
        CH_LOAD_V(CUR, (st) + 2); \
        { bf16_t* obase = dry ? dry : (dir ? ob : of2); const int rmk = dry ? 4095 : -1; \
          _Pragma("unroll") for (int tb = 0; tb < 2; ++tb) { bf16_t* op = obase + (size_t)((row0 + 32 * tb + l32) & rmk) * DM + h * 256 + 32 * wave + 4 * hh; \
            _Pragma("unroll") for (int g = 0; g < 4; ++g) { u32x2 w; w.x = pk2(ot[tb][4 * g], ot[tb][4 * g + 1]); w.y = pk2(ot[tb][4 * g + 2], ot[tb][4 * g + 3]); *(u32x2*)(op + 8 * g) = w; } } } \
        CH_STAGE(NXT, nxt); \
        LDS_BARRIER(); } while (0)
    for (int step = 0; step < nchunk; step += 2) {
        CH_STEP(step, A, B);
        CH_STEP(step + 1, B, A);
    }
    if (done) {
        asm volatile("s_waitcnt vmcnt(0)" ::: "memory");
        __syncthreads();
        if (tid == 0) { __builtin_amdgcn_fence(__ATOMIC_RELEASE, "agent"); asm volatile("s_waitcnt vmcnt(0)" ::: "memory"); (void)xb_add(done + 64 * b, 1u); }
    }
#undef CH_GC
#undef CH_CLAMP
#undef CH_LOAD_T
#undef CH_LOAD_V
#undef CH_STAGE
#undef CH_STEP
#undef CH_LDQ
#undef CH_LDE
#undef CH_LDK
}

template <int NB>
__device__ __forceinline__ void ua_items(bf16_t* proj, const bf16_t* ob, const bf16_t* of2, int it0, int itstride, const float* gn, int lane, bf16_t* pst, int rmask) {
    u32x2 a[NB], b[NB], f[NB], z[NB]; bf16_t* zp[NB]; bool ok[NB];
#pragma unroll
    for (int i = 0; i < NB; ++i) { const int itr = it0 + i * itstride; ok[i] = itr < NTOK * 4; const int it = ok[i] ? itr : 0, row = it >> 2, h = it & 3;
        a[i] = *(const u32x2*)(proj + (size_t)row * LDP + C_VA + h * 256 + 4 * lane); b[i] = *(const u32x2*)(ob + (size_t)row * DM + h * 256 + 4 * lane); f[i] = *(const u32x2*)(of2 + (size_t)row * DM + h * 256 + 4 * lane);
        zp[i] = pst + (size_t)(row & rmask) * LDP + C_ZA + h * 256 + 4 * lane; z[i] = *(const u32x2*)(proj + (size_t)row * LDP + C_ZA + h * 256 + 4 * lane); }
    const f32x4 g4 = *(const f32x4*)(gn + 4 * lane);
#pragma unroll
    for (int i = 0; i < NB; ++i) {
        float o[4] = {bflo(a[i].x) + bflo(b[i].x) + bflo(f[i].x), bfhi(a[i].x) + bfhi(b[i].x) + bfhi(f[i].x), bflo(a[i].y) + bflo(b[i].y) + bflo(f[i].y), bfhi(a[i].y) + bfhi(b[i].y) + bfhi(f[i].y)};
        const float ss = wave_sum((o[0] * o[0] + o[1] * o[1]) + (o[2] * o[2] + o[3] * o[3]));
        const float rs = __builtin_amdgcn_rsqf(ss * (1.f / 256.f) + EPS);
        u32x2 w; w.x = pk2(o[0] * rs * g4[0] * silu(bflo(z[i].x)), o[1] * rs * g4[1] * silu(bfhi(z[i].x))); w.y = pk2(o[2] * rs * g4[2] * silu(bflo(z[i].y)), o[3] * rs * g4[3] * silu(bfhi(z[i].y)));
        if (ok[i]) *(u32x2*)zp[i] = w;
    }
}

__global__ void __launch_bounds__(512, 2) hybrid_fwd(Args args) {
    extern __shared__ __attribute__((aligned(16))) unsigned char lds[];
    LAS unsigned char* L = (LAS unsigned char*)lds;
    volatile LAS int* MISC = (volatile LAS int*)(L + MISC_OFF);
    cg::grid_group grid = cg::this_grid();
    if (threadIdx.x < 32) MISC[threadIdx.x] = 0;
    __syncthreads();
    const XcdBarrier xbar = xcd_barrier_post((unsigned*)(args.ws + WS_CTL) + 4096, (volatile LAS unsigned*)(MISC + 8));
    if (threadIdx.x == 0) { const unsigned x = xb_xcc_id() & 7u; MISC[3] = (int)x; MISC[4] = (int)xb_add((unsigned*)(args.ws + WS_CTL) + 1024 + 64 * x, 1u); MISC[5] = 0; MISC[6] = (int)blockIdx.x; MISC[7] = 0; }
    for (int ph = args.ph_lo; ph < args.ph_hi; ++ph) {
        int tid = threadIdx.x; asm volatile("" : "+v"(tid));
        const int lane = tid & 63, wave = __builtin_amdgcn_readfirstlane(tid >> 6);
        int G = gridDim.x, bid = blockIdx.x; asm volatile("" : "+s"(G), "+s"(bid));
        const int gw = bid * 8 + wave, ngw = G * 8;
        int mo = 0; asm volatile("" : "+v"(mo));
        const int vid = __builtin_amdgcn_readfirstlane(MISC[6 + mo]);
        size_t zoff = 0; asm volatile("" : "+s"(zoff));
        unsigned char* ws = args.ws + zoff;
#define AIN(i) (args.in[i])
        float* aout = args.out;
        unsigned* ctl = (unsigned*)(ws + WS_CTL);
        float* tabc = (float*)(ws + WS_TAB); float* tabs = tabc + 1024;
        bf16_t* WIN = (bf16_t*)(ws + WS_WIN); bf16_t* WBR = (bf16_t*)(ws + WS_WBR); bf16_t* WOUT = (bf16_t*)(ws + WS_WOUT);
        bf16_t* proj = (bf16_t*)(ws + WS_PROJ); bf16_t* xb = (bf16_t*)(ws + WS_XB); float* ssp = (float*)(ws + WS_SSP);
        float* ef = (float*)(ws + WS_EF); float* eb = (float*)(ws + WS_EB);
        bf16_t* kltf = (bf16_t*)(ws + WS_KLTF); bf16_t* kltb = (bf16_t*)(ws + WS_KLTB); bf16_t* vtg = (bf16_t*)(ws + WS_VT); bf16_t* of2 = (bf16_t*)(ws + WS_OF2);
        if (ph == 0) {
          {
            LAS float* scr = (LAS float*)(L + wave * 16384);
            for (int it = gw; it < CV_ITEMS; it += ngw) convert_item(args, 0, it, WIN, WBR, WOUT, scr, lane);
            for (int i = bid * 512 + tid; i < DEPTH * 224 * 128; i += G * 512) { const int l = i / (224 * 128), r = i % (224 * 128);
                *(u32x4*)(WIN + (size_t)l * WIN_L + (size_t)IN_DIM * DM + (size_t)r * 8) = (u32x4){0u, 0u, 0u, 0u}; }
            for (int i = bid * 512 + tid; i < 1024; i += G * 512) { const int pos = i >> 4, fi = i & 15;
                const float inv = __builtin_amdgcn_exp2f(-(float)fi * (13.287712379549449f / 16.f)); const float ang = (float)pos * inv;
                float rev = ang * 0.15915494309189535f; rev -= floorf(rev);
                tabc[i] = __builtin_amdgcn_cosf(rev); tabs[i] = __builtin_amdgcn_sinf(rev); }
            x_rows_to_bf16(AIN(0), xb, ssp, gw, ngw, lane);
          }
        } else if (ph == 25 || ph == 50) {
            const int grp = ph == 50; float* xo = aout + (size_t)grp * NTOK * DM; const float* gf = AIN(14);
            for (int m0 = gw; m0 < NTOK; m0 += 2 * ngw) { const int m1 = (m0 + ngw < NTOK) ? m0 + ngw : m0;
                f32x4* xr0 = (f32x4*)(xo + (size_t)m0 * DM) + lane; f32x4* xr1 = (f32x4*)(xo + (size_t)m1 * DM) + lane; f32x4 v0[4], v1[4]; float s0 = 0.f, s1 = 0.f;
#pragma unroll
                for (int j = 0; j < 4; ++j) { v0[j] = xr0[64 * j]; v1[j] = xr1[64 * j]; }
#pragma unroll
                for (int j = 0; j < 4; ++j) { s0 += (v0[j].x * v0[j].x + v0[j].y * v0[j].y) + (v0[j].z * v0[j].z + v0[j].w * v0[j].w); s1 += (v1[j].x * v1[j].x + v1[j].y * v1[j].y) + (v1[j].z * v1[j].z + v1[j].w * v1[j].w); }
                const float rs0 = __builtin_amdgcn_rsqf(wave_sum(s0) * (1.f / 1024.f) + EPS), rs1 = __builtin_amdgcn_rsqf(wave_sum(s1) * (1.f / 1024.f) + EPS);
#pragma unroll
                for (int j = 0; j < 4; ++j) { const f32x4 g4 = *((const f32x4*)gf + lane + 64 * j); xr0[64 * j] = v0[j] * rs0 * g4; if (m1 != m0) xr1[64 * j] = v1[j] * rs1 * g4; } }
            if (grp == 0) x_rows_to_bf16(AIN(1), xb, ssp, gw, ngw, lane);
        } else {
            const int q = (ph < 25) ? ph - 1 : ph - 26; const int grp = ph > 25, l = q / 6, sub = q % 6;
            const int T = grp ? 2048 : 4096, nB = grp ? 8 : 4, nchunk = T / 64;
            float* xres = aout + (size_t)grp * NTOK * DM;
            if (sub == 0) {
                pg8::Gemm g{xb, WIN + (size_t)l * WIN_L, DM, DM, DM, 0}; pg8::StaticOrder S; S.init(NTOK, LDP, G, vid);
                pg8::EpiProj E{proj, ssp};
                pg8::gemm_phase<pg8::EpiProj>(L, g, S, E);
            } else if (sub == 1) {
                { PrepIn pin; gla_prep_load(pin, proj, bid >> 2, bid & 3); PrepW pw; int hcur = bid & 3; gla_prep_loadw(pw, AIN(4) + (size_t)l * 16 * 512, AIN(5) + l * 512, AIN(6) + (size_t)l * 16 * 512, AIN(7) + l * 512, hcur);
                  for (int tile = bid; tile < 1024; tile += G) { PrepIn pnx; const int tn = (tile + G < 1024) ? tile + G : tile; gla_prep_load(pnx, proj, tn >> 2, tn & 3);
                    if ((tile & 3) != hcur) { hcur = tile & 3; gla_prep_loadw(pw, AIN(4) + (size_t)l * 16 * 512, AIN(5) + l * 512, AIN(6) + (size_t)l * 16 * 512, AIN(7) + l * 512, hcur); }
                    gla_prep_tile(L, pin, pw, tile >> 2, tile & 3, proj, ef, eb, kltf, kltb, vtg, proj, -1);
                    pin = pnx; } }
                for (int it = gw; it < NTOK; it += 8 * ngw) qk_norm_items<8>(proj, it, ngw, NTOK, T, AIN(9) + l * 64, AIN(10) + l * 64, tabc, tabs, lane, proj, -1);
            } else if (sub == 2) {
                const int nchain = nB * 4 * 2, nqb = T / 256, natt = nB * 16 * nqb, nua = NTOK * 4 / 64, ncv = (grp == 0 && l < 3) ? (CV_ITEMS + 7) / 8 : 0, total = nchain + natt + nua + ncv;
                unsigned* done = ctl + 8192 + 64 * ((grp * 4 + l) * 8);
                if (tid == 0) MISC[2] = 0;
                unsigned* ctr = ctl + 64 * (grp * 4 + l);
                if (tid == 0) MISC[0] = (int)atomicAdd(ctr, 1u);
                for (;;) {
                    __syncthreads();
                    const int idx = MISC[0];
                    __syncthreads();
                    if (idx >= total) break;
                    int nxti = 0; if (tid == 0) nxti = (int)atomicAdd(ctr, 1u);
                    if (idx >= nchain + natt && idx < nchain + natt + nua) {
                        const int j = idx - nchain - natt, bq = (j * 16) / T;
                        if (tid == 0 && !((MISC[2] >> bq) & 1)) {
                            unsigned sp = 0; while (xb_ld(done + 64 * bq) < 8u) { __builtin_amdgcn_s_sleep(2); if (++sp > (1u << 24)) break; }
                            __builtin_amdgcn_fence(__ATOMIC_ACQUIRE, "agent"); asm volatile("s_waitcnt vmcnt(0)" ::: "memory");
                            MISC[2] = MISC[2] | (1 << bq); }
                        __syncthreads();
                        { int ln = threadIdx.x; asm volatile("" : "+v"(ln)); const int wv = __builtin_amdgcn_readfirstlane(ln >> 6); ln &= 63;
                          ua_items<8>(proj, xb, of2, 64 * j + wv, 8, AIN(8) + l * 256, ln, proj, -1); }
                        if (tid == 0) MISC[0] = nxti; continue; }
                    if (idx >= nchain + natt + nua) { int ln = threadIdx.x; asm volatile("" : "+v"(ln)); const int wv = __builtin_amdgcn_readfirstlane(ln >> 6); ln &= 63; const int r = (idx - nchain - natt - nua) * 8 + wv; if (r < CV_ITEMS) convert_item(args, l + 1, r, WIN, WBR, WOUT, (LAS float*)(L + wv * 16384), ln); if (tid == 0) MISC[0] = nxti; continue; }
                    if (idx < nchain) gla_chain(L, idx, nchunk, proj, kltf, kltb, vtg, ef, eb, xb, of2, done);
                    else
                    {
 const int u = idx - nchain; const int g4 = u & 3, qb = (u >> 2) % nqb, bk = (u >> 2) / nqb, kvh = bk & 3, b = bk >> 2, hq = kvh * 4 + g4;
                        const size_t rb = (size_t)b * T;
                        attn_body::attn_unit<8>((const attn_body::bf16*)(proj + (rb + (size_t)qb * 256) * LDP + C_QB + hq * 64), (const attn_body::bf16*)(proj + rb * LDP + C_KB + kvh * 64),
                                                (const attn_body::bf16*)(proj + rb * LDP + C_VB + kvh * 64), (attn_body::bf16*)(proj + (rb + (size_t)qb * 256) * LDP + C_ZB + hq * 64), T / 64, (char*)lds, AIN(9) + l * 64, tabc, tabs, qb * 256);
                    }
                    if (tid == 0) MISC[0] = nxti;
                }
            } else if (sub == 3) {
            } else if (sub == 4) {
                pg8::StaticOrder S; S.init(NTOK, DM, G, vid);
                { pg8::Gemm g{proj + C_ZA, WBR + (size_t)l * DM * 2048, LDP, 2048, DM, 2048}; pg8::PairOrder S2{S}; pg8::EpiBranchPair E{proj};
                  pg8::gemm_phase<pg8::EpiBranchPair, true, pg8::PairOrder>(L, g, S2, E); }
            } else {
                pg8::Gemm g{proj + C_MA, WOUT + (size_t)l * DM * DM, LDP, DM, DM, 0}; pg8::StaticOrder S; S.init(NTOK, DM, G, vid);
                pg8::EpiOut E{l == 0 ? AIN(grp) : xres, xres, xb, ssp, -1};
                pg8::gemm_phase<pg8::EpiOut>(L, g, S, E);
            }
        }
        { const int qq = (ph < 25) ? ph - 1 : ph - 26; const bool layer_ph = ph != 0 && ph != 25 && ph != 50; const int sb = qq % 6, ll = qq / 6;
          const bool empty = layer_ph && sb == 3;
          const bool local = layer_ph && (sb == 4 || (sb == 5 && ll < 3)) && __builtin_amdgcn_readfirstlane(MISC[5 + mo]) != 0;
          if (ph + 1 < args.ph_hi && !empty) {
              if (args.ph_hi > NPHASE) grid.sync();
              else if (local) { unsigned tg = 0; if (threadIdx.x == 0) { tg = (unsigned)(MISC[7] + 1); MISC[7] = (int)tg; }
                                xcc_local_barrier(ctl + 2048 + 64 * (unsigned)__builtin_amdgcn_readfirstlane(MISC[3 + mo]), tg * (unsigned)(G >> 3)); }
              else xcd_barrier(xbar);
          }
          if (ph == 0) {
              if (threadIdx.x == 0) { bool u = (G & 7) == 0; for (int x = 0; x < 8; ++x) u = u && (xb_ld(ctl + 1024 + 64 * x) == (unsigned)(G >> 3));
                  if (u) { MISC[5] = 1; MISC[6] = MISC[4] * 8 + MISC[3]; } }
              __syncthreads();
          } }
    }
}

extern "C" void kernel_launch(void* const* d_in, const int* in_sizes, int n_in, void* d_out, int out_size, void* d_ws, size_t ws_size, hipStream_t stream) {
    static int grid = 0;
    if (grid == 0) {
        if (n_in != 15 || ws_size < WS_END || out_size != 2 * NTOK * DM) { fprintf(stderr, "kernel_launch: unexpected shapes (n_in %d, ws %zu, out %d)\n", n_in, ws_size, out_size); grid = -1; return; }
        if (hipFuncSetAttribute((const void*)hybrid_fwd, hipFuncAttributeMaxDynamicSharedMemorySize, LDS_BYTES) != hipSuccess) { fprintf(stderr, "kernel_launch: hipFuncSetAttribute failed\n"); grid = -1; return; }
        int dev = 0, cus = 0, per_cu = 0;
        hipGetDevice(&dev); hipDeviceGetAttribute(&cus, hipDeviceAttributeMultiprocessorCount, dev);
        hipOccupancyMaxActiveBlocksPerMultiprocessor(&per_cu, (const void*)hybrid_fwd, 512, LDS_BYTES);
        if (per_cu < 1) { fprintf(stderr, "kernel_launch: occupancy query says %d blocks per CU\n", per_cu); (void)hipGetLastError(); }
        grid = cus;
    }
    if (grid < 0) return;
    (void)hipMemsetAsync((char*)d_ws + WS_CTL, 0, CTL_BYTES, stream);
    Args a{};
    for (int i = 0; i < 15; ++i) a.in[i] = (const float*)d_in[i];
    a.out = (float*)d_out; a.ws = (unsigned char*)d_ws; a.ph_lo = 0; a.ph_hi = NPHASE;
    void* kargs[] = {&a};
    hipError_t e = hipLaunchCooperativeKernel((const void*)hybrid_fwd, dim3(grid), dim3(512), kargs, LDS_BYTES, stream);
    if (e != hipSuccess) fprintf(stderr, "kernel_launch: cooperative launch failed: %s (grid %d)\n", hipGetErrorString(e), grid);
}
```

```cpp
#include <hip/hip_runtime.h>
#include <hip/hip_cooperative_groups.h>
#include <hip/hip_bf16.h>
#include <cstdio>
#include <cstdint>
#include <cmath>
namespace cg = cooperative_groups;

#define LAS __attribute__((address_space(3)))
#define GAS __attribute__((address_space(1)))
typedef unsigned short bf16_t;
typedef short bf16x8 __attribute__((ext_vector_type(8)));
typedef float f32x4 __attribute__((ext_vector_type(4)));
typedef float f32x2 __attribute__((ext_vector_type(2)));
typedef float f32x16 __attribute__((ext_vector_type(16)));
typedef unsigned u32x4 __attribute__((ext_vector_type(4)));
typedef unsigned u32x2 __attribute__((ext_vector_type(2)));
typedef __bf16 bf16x2_t __attribute__((ext_vector_type(2)));

constexpr int DM = 1024, NTOK = 16384, DEPTH = 4, IN_DIM = 7712, LDP = 7936;
constexpr int C_QA = 0, C_KA = 512, C_VA = 1024, C_QB = 2048, C_KB = 3072, C_VB = 3328, C_ZA = 3584, C_ZB = 4608, C_MA = 5632, C_MB = 6656, C_GL = 7680;
constexpr float EPS = 1e-6f;
constexpr float C2 = 0.125f * 1.4426950408889634f;
constexpr float LN2 = 0.6931471805599453f, LOG2E = 1.4426950408889634f;

constexpr size_t MiB = 1u << 20;
constexpr size_t WS_CTL = 0, CTL_BYTES = 65536;
constexpr size_t WS_TAB = 1 * MiB;
constexpr size_t WS_WIN = 2 * MiB;
constexpr size_t WIN_L = (size_t)LDP * 1024;
constexpr size_t WS_WBR = 64 * MiB;
constexpr size_t WS_WOUT = 80 * MiB;
constexpr size_t WS_PROJ = 88 * MiB;
constexpr size_t WS_XB = 336 * MiB;
constexpr size_t WS_SSP = 368 * MiB;
constexpr size_t WS_EF = 369 * MiB;
constexpr size_t WS_EB = WS_EF + 512 * 1024;
constexpr size_t WS_KLTF = 370 * MiB;
constexpr size_t WS_KLTB = 386 * MiB;
constexpr size_t WS_VT = 402 * MiB;
constexpr size_t WS_OF2 = 434 * MiB;
constexpr size_t WS_END = 466 * MiB;

constexpr int LDS_BYTES = 147456, RING_BYTES = 131072, MISC_OFF = 131072 + 512;
constexpr int NPHASE = 51;

__device__ __forceinline__ unsigned pk2(float lo, float hi) { f32x2 v = {lo, hi}; bf16x2_t b = __builtin_convertvector(v, bf16x2_t); return __builtin_bit_cast(unsigned, b); }
__device__ __forceinline__ float bflo(unsigned u) { return __builtin_bit_cast(float, u << 16); }
__device__ __forceinline__ float bfhi(unsigned u) { return __builtin_bit_cast(float, u & 0xffff0000u); }
__device__ __forceinline__ float bf2f(bf16_t v) { return __builtin_bit_cast(float, ((unsigned)v) << 16); }
__device__ __forceinline__ bf16_t f2bf(float f) { return (bf16_t)(pk2(f, 0.f) & 0xffffu); }
__device__ __forceinline__ float fexp(float x) { return __builtin_amdgcn_exp2f(x * LOG2E); }
__device__ __forceinline__ float sigm(float x) { return __builtin_amdgcn_rcpf(1.f + fexp(-x)); }
__device__ __forceinline__ float silu(float x) { return x * sigm(x); }
__device__ __forceinline__ float logsig(float z) { return fminf(z, 0.f) - LN2 * __builtin_amdgcn_logf(1.f + fexp(-fabsf(z))); }
__device__ __forceinline__ int crow(int r, int hi) { return (r & 3) + 8 * (r >> 2) + 4 * hi; }
#define LDS_BARRIER() do { asm volatile("s_waitcnt lgkmcnt(0)" ::: "memory"); __builtin_amdgcn_s_barrier(); } while (0)
#define MFMA32(a, b, c) __builtin_amdgcn_mfma_f32_32x32x16_bf16((a), (b), (c), 0, 0, 0)

namespace pg8 {
constexpr int BM = 256, BK = 64, HALF = 128, HTB = HALF * BK * 2, NXCD = 8, WGM = 8;
__host__ __device__ __forceinline__ int lds_byte(int r, int c) { const int st = (r >> 4) * 2 + (c >> 5), rr = r & 15, cc = c & 31, ob = rr * 64 + cc * 2; return st * 1024 + (ob ^ (((ob >> 9) & 1) << 5)); }
__host__ __device__ __forceinline__ void stage_rc(int b, int& R, int& C) { const int st = b / 1024, sb = b % 1024, swz = sb ^ (((sb >> 9) & 1) << 5); R = (st >> 1) * 16 + swz / 64; C = (st & 1) * 32 + (swz % 64) / 2; }
__host__ __device__ __forceinline__ int perm32(int rho) { const int n = rho >> 4, i = rho & 15; return 8 * (i >> 2) + 4 * n + (i & 3); }
struct Unit { int pm, pn, sel; };
struct Gemm { const bf16_t* A; const bf16_t* Bt; int lda, ldb, K; int selstep; };
struct StaticOrder {
    int nM, nN, nwg, G, c;
    __device__ void init(int M, int N, int G_, int c_) { nM = M / BM; nN = N / BM; nwg = nM * nN; G = G_; c = c_; }
    __device__ bool next(int i, Unit& u) const {
        const long L = (long)i * G + c; if (L >= nwg) return false;
        int wgid = (int)L; { const int q = nwg / NXCD, r = nwg % NXCD, xcd = wgid % NXCD, off = wgid / NXCD; wgid = (xcd < r ? xcd * (q + 1) : r * (q + 1) + (xcd - r) * q) + off; }
        const int nig = WGM * nN, gid = wgid / nig, fm = gid * WGM, gsz = (nM - fm) < WGM ? (nM - fm) : WGM;
        u.pm = fm + ((wgid % nig) % gsz); u.pn = (wgid % nig) / gsz; u.sel = 0; return true;
    }
};
struct PairOrder {
    StaticOrder b;
    __device__ bool next(int i, Unit& u) const { const bool ok = b.next(i >> 1, u); u.sel = i & 1; return ok; }
};
template <class Epi, bool ALIGN_EPI = true, class Sched = StaticOrder>
__device__ __forceinline__ void gemm_phase(LAS unsigned char* lds, const Gemm g, const Sched& S, const Epi& E) {
    int tid = threadIdx.x; asm volatile("" : "+v"(tid));
    const int wid = __builtin_amdgcn_readfirstlane(tid >> 6), lane = tid & 63, wr = wid >> 2, wc = wid & 3, fr = lane & 15, fq = lane >> 4;
    const int K = g.K, nt = K / BK;
    unsigned voffA[2], voffB[2];
#pragma unroll
    for (int i = 0; i < 2; ++i) { int R, C; stage_rc(tid * 16 + i * 8192, R, C); const int Rb = (R & ~31) + perm32(R & 31);
        voffA[i] = (unsigned)(R * g.lda + C) * 2u; voffB[i] = (unsigned)(Rb * g.ldb + C) * 2u; }
    const size_t kstep = (size_t)(BK * 2);
    const size_t hstepA = (size_t)HALF * g.lda * 2, hstepB = (size_t)HALF * g.ldb * 2;
    const size_t tstepA = 2 * hstepA, tstepB = 2 * hstepB;
    const unsigned ldsw = (unsigned)wid * 1024u;
    const int aoff = lds_byte(wr * 64 + fr, fq * 8), boff = lds_byte(wc * 32 + fr, fq * 8);
#define PG8_SA(b, h) (((b) * 2 + (h)) * HTB)
#define PG8_SB(b, h) ((4 + (b) * 2 + (h)) * HTB)
#define PG8_STAGE(bufoff, gbase, voff) do { _Pragma("unroll") for (int _i = 0; _i < 2; ++_i) \
        __builtin_amdgcn_global_load_lds((const unsigned*)((const char*)(gbase) + (voff)[_i]), (LAS unsigned*)(lds + (bufoff) + ldsw + _i * 8192), 16, 0, 0); } while (0)
#define PG8_LDA(dst, b, h) do { _Pragma("unroll") for (int m = 0; m < 4; ++m) _Pragma("unroll") for (int k = 0; k < 2; ++k) dst[m][k] = *(const LAS bf16x8*)(lds + PG8_SA(b, h) + aoff + m * 2048 + k * 1024); } while (0)
#define PG8_LDB(dst, b, h) do { _Pragma("unroll") for (int n = 0; n < 2; ++n) _Pragma("unroll") for (int k = 0; k < 2; ++k) dst[n][k] = *(const LAS bf16x8*)(lds + PG8_SB(b, h) + boff + n * 2048 + k * 1024); } while (0)
#define PG8_MMA(ai, bj, At, Bt) do { __builtin_amdgcn_s_setprio(1); _Pragma("unroll") for (int m = 0; m < 4; ++m) _Pragma("unroll") for (int n = 0; n < 2; ++n) _Pragma("unroll") for (int k = 0; k < 2; ++k) \
        acc[ai][bj][m][n] = __builtin_amdgcn_mfma_f32_16x16x32_bf16(Bt[n][k], At[m][k], acc[ai][bj][m][n], 0, 0, 0); __builtin_amdgcn_s_setprio(0); } while (0)
#define PG8_WAIT_V(n) asm volatile("s_waitcnt vmcnt(" #n ")" ::: "memory")
#define PG8_WAIT_L(n) asm volatile("s_waitcnt lgkmcnt(" #n ")" ::: "memory")
#define PG8_BAR __builtin_amdgcn_s_barrier()
#define PG8_SCHED __builtin_amdgcn_sched_barrier(0)
    Unit cur, nxt; int ui = 0;
    if (!S.next(0, cur)) return;
    f32x4 acc[2][2][4][2];
#pragma unroll
    for (int a = 0; a < 2; ++a)
#pragma unroll
        for (int b = 0; b < 2; ++b)
#pragma unroll
            for (int m = 0; m < 4; ++m)
#pragma unroll
                for (int n = 0; n < 2; ++n) acc[a][b][m][n] = (f32x4){0.f, 0.f, 0.f, 0.f};
    bf16x8 At[4][2], B0[2][2], B1[2][2];
    const char* cA = (const char*)g.A + (size_t)cur.pm * tstepA + (size_t)cur.sel * g.selstep; const char* cB = (const char*)g.Bt + (size_t)cur.pn * tstepB + (size_t)cur.sel * g.selstep;
    PG8_STAGE(PG8_SB(0, 0), cB, voffB); PG8_STAGE(PG8_SB(0, 1), cB + hstepB, voffB); PG8_STAGE(PG8_SA(0, 0), cA, voffA); PG8_STAGE(PG8_SA(0, 1), cA + hstepA, voffA);
    if (wr == 1) PG8_BAR;
    PG8_WAIT_V(2); PG8_BAR;
    PG8_STAGE(PG8_SB(1, 0), cB + kstep, voffB); PG8_STAGE(PG8_SA(1, 0), cA + kstep, voffA); PG8_STAGE(PG8_SB(1, 1), cB + hstepB + kstep, voffB);
    PG8_WAIT_V(6); PG8_BAR;
    for (;;) {
        const bool has_next = S.next(ui + 1, nxt);
        const char* nA = has_next ? (const char*)g.A + (size_t)nxt.pm * tstepA + (size_t)nxt.sel * g.selstep : cA; const char* nB = has_next ? (const char*)g.Bt + (size_t)nxt.pn * tstepB + (size_t)nxt.sel * g.selstep : cB;
        for (int t = 0; t < nt; t += 2) {
            const bool last = (t == nt - 2);
            const char* a1 = cA + (size_t)(t + 1) * kstep;
            const char* a2 = last ? nA : cA + (size_t)(t + 2) * kstep; const char* b2 = last ? nB : cB + (size_t)(t + 2) * kstep;
            const char* a3 = a2 + kstep; const char* b3 = b2 + kstep;
            PG8_LDB(B0, 0, 0); PG8_LDB(B1, 0, 1); PG8_SCHED; PG8_LDA(At, 0, 0); PG8_STAGE(PG8_SA(1, 1), a1 + hstepA, voffA);
            PG8_WAIT_V(8); PG8_WAIT_L(0); PG8_BAR; PG8_MMA(0, 0, At, B0); PG8_MMA(0, 1, At, B1); PG8_BAR; PG8_SCHED;
            PG8_LDA(At, 0, 1); PG8_STAGE(PG8_SB(0, 0), b2, voffB); PG8_STAGE(PG8_SB(0, 1), b2 + hstepB, voffB); PG8_STAGE(PG8_SA(0, 0), a2, voffA);
            PG8_WAIT_V(8); PG8_WAIT_L(0); PG8_BAR; PG8_MMA(1, 0, At, B0); PG8_MMA(1, 1, At, B1); PG8_BAR; PG8_SCHED;
            PG8_LDB(B0, 1, 0); PG8_LDB(B1, 1, 1); PG8_SCHED; PG8_LDA(At, 1, 0); PG8_STAGE(PG8_SA(0, 1), a2 + hstepA, voffA);
            PG8_WAIT_V(8); PG8_WAIT_L(0); PG8_BAR; PG8_MMA(0, 0, At, B0); PG8_MMA(0, 1, At, B1); PG8_BAR; PG8_SCHED;
            PG8_LDA(At, 1, 1); PG8_STAGE(PG8_SB(1, 0), b3, voffB); PG8_STAGE(PG8_SB(1, 1), b3 + hstepB, voffB); PG8_STAGE(PG8_SA(1, 0), a3, voffA);
            PG8_WAIT_V(8); PG8_WAIT_L(0); PG8_BAR; PG8_MMA(1, 0, At, B0); PG8_MMA(1, 1, At, B1); PG8_BAR; PG8_SCHED;
        }
        if constexpr (ALIGN_EPI) { if (wr == 0) PG8_BAR; }
        E(acc, cur, wr, wc, fr, fq);
        if (!has_next) break;
#pragma unroll
        for (int a = 0; a < 2; ++a)
#pragma unroll
            for (int b = 0; b < 2; ++b)
#pragma unroll
                for (int m = 0; m < 4; ++m)
#pragma unroll
                    for (int n = 0; n < 2; ++n) acc[a][b][m][n] = (f32x4){0.f, 0.f, 0.f, 0.f};
        cur = nxt; cA = nA; cB = nB; ++ui;
        if constexpr (ALIGN_EPI) { if (wr == 1) PG8_BAR; }
    }
    PG8_WAIT_V(0);
    if constexpr (!ALIGN_EPI) { if (wr == 0) PG8_BAR; }
    PG8_BAR;
#undef PG8_SA
#undef PG8_SB
#undef PG8_STAGE
#undef PG8_LDA
#undef PG8_LDB
#undef PG8_MMA
#undef PG8_WAIT_V
#undef PG8_WAIT_L
#undef PG8_BAR
#undef PG8_SCHED
}

struct EpiProj {
    bf16_t* O; const float* ssp;
    __device__ __forceinline__ void operator()(const f32x4 (&acc)[2][2][4][2], const Unit& u, int wr, int wc, int fr, int fq) const {
        const int row0 = u.pm * BM + wr * 64 + fr, col0 = u.pn * BM + wc * 32 + 8 * fq;
#pragma unroll
        for (int ai = 0; ai < 2; ++ai)
#pragma unroll
            for (int m = 0; m < 4; ++m) {
                const int row = row0 + ai * HALF + m * 16;
                const f32x4* sp = (const f32x4*)(ssp + (size_t)row * 16);
                const f32x4 s4 = (sp[0] + sp[1]) + (sp[2] + sp[3]);
                const float rs = __builtin_amdgcn_rsqf(((s4[0] + s4[1]) + (s4[2] + s4[3])) * (1.f / 1024.f) + EPS);
                bf16_t* rowp = O + (size_t)row * LDP + col0;
#pragma unroll
                for (int bj = 0; bj < 2; ++bj) { const f32x4 v0 = acc[ai][bj][m][0] * rs, v1 = acc[ai][bj][m][1] * rs;
                    u32x4 w; w.x = pk2(v0[0], v0[1]); w.y = pk2(v0[2], v0[3]); w.z = pk2(v1[0], v1[1]); w.w = pk2(v1[2], v1[3]);
                    *(u32x4*)(rowp + bj * HALF) = w; }
            }
    }
};
template <int SECOND> struct EpiBranch {
    bf16_t* P; bf16_t* W; int rmask;
    __device__ __forceinline__ void operator()(const f32x4 (&acc)[2][2][4][2], const Unit& u, int wr, int wc, int fr, int fq) const {
        const int row0 = u.pm * BM + wr * 64 + fr, col0 = u.pn * BM + wc * 32 + 8 * fq;
#pragma unroll
        for (int ai = 0; ai < 2; ++ai)
#pragma unroll
            for (int m = 0; m < 4; ++m) {
                bf16_t* rowp = P + (size_t)(row0 + ai * HALF + m * 16) * LDP + col0; bf16_t* roww = W + (size_t)((row0 + ai * HALF + m * 16) & rmask) * LDP + col0;
#pragma unroll
                for (int bj = 0; bj < 2; ++bj) {
                    const u32x4 a = *(const u32x4*)(rowp + C_MA + bj * HALF);
                    float ma[8] = {bflo(a.x), bfhi(a.x), bflo(a.y), bfhi(a.y), bflo(a.z), bfhi(a.z), bflo(a.w), bfhi(a.w)};
                    float o[8];
                    if (SECOND) {
                        const u32x4 b = *(const u32x4*)(rowp + C_MB + bj * HALF);
                        float mb[8] = {bflo(b.x), bfhi(b.x), bflo(b.y), bfhi(b.y), bflo(b.z), bfhi(b.z), bflo(b.w), bfhi(b.w)};
#pragma unroll
                        for (int e = 0; e < 8; ++e) o[e] = ma[e] + acc[ai][bj][m][e >> 2][e & 3] * sigm(mb[e]);
                    } else {
#pragma unroll
                        for (int e = 0; e < 8; ++e) o[e] = acc[ai][bj][m][e >> 2][e & 3] * sigm(ma[e]);
                    }
                    u32x4 w; w.x = pk2(o[0], o[1]); w.y = pk2(o[2], o[3]); w.z = pk2(o[4], o[5]); w.w = pk2(o[6], o[7]);
                    *(u32x4*)(roww + C_MA + bj * HALF) = w;
                }
            }
    }
};
struct EpiBranchPair {
    bf16_t* P;
    __device__ __forceinline__ void operator()(const f32x4 (&acc)[2][2][4][2], const Unit& u, int wr, int wc, int fr, int fq) const {
        if (u.sel == 0) { EpiBranch<0> e{P, P, -1}; e(acc, u, wr, wc, fr, fq); } else { EpiBranch<1> e{P, P, -1}; e(acc, u, wr, wc, fr, fq); }
    }
};
struct EpiOut {
    const float* xold; float* xnew; bf16_t* xb; float* ssp; int rmask;
    __device__ __forceinline__ void operator()(const f32x4 (&acc)[2][2][4][2], const Unit& u, int wr, int wc, int fr, int fq) const {
        const int row0 = u.pm * BM + wr * 64 + fr, col0 = u.pn * BM + wc * 32 + 8 * fq;
#pragma unroll
        for (int ai = 0; ai < 2; ++ai)
#pragma unroll
            for (int m = 0; m < 4; ++m) {
                const int row = row0 + ai * HALF + m * 16;
                float ss = 0.f;
#pragma unroll
                for (int bj = 0; bj < 2; ++bj) {
                    const size_t off = (size_t)row * DM + col0 + bj * HALF, offw = (size_t)(row & rmask) * DM + col0 + bj * HALF;
                    const f32x4 x0 = *(const f32x4*)(xold + off), x1 = *(const f32x4*)(xold + off + 4);
                    const f32x4 v0 = x0 + acc[ai][bj][m][0], v1 = x1 + acc[ai][bj][m][1];
                    *(f32x4*)(xnew + offw) = v0; *(f32x4*)(xnew + offw + 4) = v1;
                    u32x4 w; w.x = pk2(v0[0], v0[1]); w.y = pk2(v0[2], v0[3]); w.z = pk2(v1[0], v1[1]); w.w = pk2(v1[2], v1[3]);
                    *(u32x4*)(xb + offw) = w;
                    ss += (v0[0] * v0[0] + v0[1] * v0[1]) + (v0[2] * v0[2] + v0[3] * v0[3]) + (v1[0] * v1[0] + v1[1] * v1[1]) + (v1[2] * v1[2] + v1[3] * v1[3]);
                }
                ss += __shfl_xor(ss, 16); ss += __shfl_xor(ss, 32);
                if (fq == 0) ssp[(size_t)(row & rmask) * 16 + u.pn * 4 + wc] = ss;
            }
    }
};
}

namespace attn_body {
using bf16 = __hip_bfloat16;
using s16x4 = __attribute__((ext_vector_type(4))) short;
constexpr int D = 64, P = LDP;
constexpr int NW = 8, QBLK = 32, QB = QBLK * NW, KVBLK = 64;
#define SBAR() __builtin_amdgcn_sched_barrier(0)
constexpr int NSLOT = 3, SLOTB = 8192;
constexpr int LDS_K = 0, LDS_V = NSLOT * SLOTB, LDS_WS = 2 * NSLOT * SLOTB, LDS_OST = LDS_WS + NW * 64 * 4, ATT_LDS_BYTES = LDS_OST + NW * 4096;
__device__ __forceinline__ void glds16(const void* gsrc, unsigned lds_dst) { unsigned keep;
  asm volatile("s_mov_b32 %0, m0\n\ts_mov_b32 m0, %2\n\ts_nop 0\n\tglobal_load_lds_dwordx4 %1, off\n\ts_mov_b32 m0, %0" : "=&s"(keep) : "v"(gsrc), "s"(lds_dst) : "memory"); }
__device__ __forceinline__ float max3f(float a, float b, float c) { float r; asm("v_max3_f32 %0, %1, %2, %3" : "=v"(r) : "v"(a), "v"(b), "v"(c)); return r; }
__device__ __forceinline__ float max2f(float a, float b) { float r; asm("v_max_f32_e32 %0, %1, %2" : "=v"(r) : "v"(a), "v"(b)); return r; }
__device__ __forceinline__ float fadd_s(float a, float b) { float r; asm("v_add_f32_e32 %0, %1, %2" : "=v"(r) : "v"(a), "v"(b)); return r; }
__device__ __forceinline__ float fsub_s(float a, float b) { float r; asm("v_sub_f32_e32 %0, %1, %2" : "=v"(r) : "v"(a), "v"(b)); return r; }
__device__ __forceinline__ unsigned cvtpk_s(float lo, float hi) { return pk2(lo, hi); }
#define WAIT_BAR(N) asm volatile("s_waitcnt vmcnt(" #N ") lgkmcnt(0)\n\ts_barrier" ::: "memory")
__device__ __forceinline__ void qkt(f32x16& p0, f32x16& p1, const char* Kslot, const bf16x8* qr, const f32x16& negm, int r32, int hi) {
  const char* kb = Kslot + hi * 1024 + r32 * 16;
  #pragma unroll
  for (int d0 = 0; d0 < 4; ++d0) {
    const bf16x8 b0 = *reinterpret_cast<const bf16x8*>(kb + d0 * 2048);
    const bf16x8 b1 = *reinterpret_cast<const bf16x8*>(kb + d0 * 2048 + 512);
    if (d0 == 0) { p0 = MFMA32(b0, qr[0], negm); p1 = MFMA32(b1, qr[0], negm); }
    else { p0 = MFMA32(b0, qr[d0], p0); p1 = MFMA32(b1, qr[d0], p1); } }
}
typedef __attribute__((address_space(3))) const char* lds_cptr;
typedef short v4i16_t __attribute__((ext_vector_type(4)));
__device__ __forceinline__ void kload8(bf16x8* kf, lds_cptr kp) {
  kf[0] = *(const LAS bf16x8*)(kp);        kf[1] = *(const LAS bf16x8*)(kp + 512);
  kf[2] = *(const LAS bf16x8*)(kp + 2048); kf[3] = *(const LAS bf16x8*)(kp + 2560);
  kf[4] = *(const LAS bf16x8*)(kp + 4096); kf[5] = *(const LAS bf16x8*)(kp + 4608);
  kf[6] = *(const LAS bf16x8*)(kp + 6144); kf[7] = *(const LAS bf16x8*)(kp + 6656);
}
__device__ __forceinline__ void kload2(bf16x8* kf, lds_cptr kp, int j) { kf[2 * j] = *(const LAS bf16x8*)(kp + j * 2048); kf[2 * j + 1] = *(const LAS bf16x8*)(kp + j * 2048 + 512); }
__device__ __forceinline__ s16x4 vtr(lds_cptr p) { return __builtin_bit_cast(s16x4, __builtin_amdgcn_ds_read_tr16_b64_v4i16((LAS v4i16_t*)p)); }
__device__ __forceinline__ float rowmax(const f32x16& p0, const f32x16& p1) {
  float a = max3f(p0[0], p0[1], p1[0]), b = max3f(p0[2], p0[3], p1[1]); a = max3f(a, p1[2], p1[3]);
  #pragma unroll
  for (int r = 4; r < 16; r += 4) { a = max3f(a, p0[r], p0[r + 1]); b = max3f(b, p0[r + 2], p0[r + 3]); a = max3f(a, p1[r], p1[r + 1]); b = max3f(b, p1[r + 2], p1[r + 3]); }
  const float m = max2f(a, b);
  auto rr = __builtin_amdgcn_permlane32_swap(__float_as_uint(m), __float_as_uint(m), false, false);
  return max2f(__uint_as_float(rr[0]), __uint_as_float(rr[1]));
}
__device__ __forceinline__ void pv(f32x16* o, int vb, bf16x8 pa0, bf16x8 pa1, bf16x8 pa2, bf16x8 pa3) {
  #pragma unroll
  for (int d0 = 0; d0 < 2; ++d0) { s16x4 lo[4], hi[4];
    #pragma unroll
    for (int ks = 0; ks < 4; ++ks) {
      asm volatile("ds_read_b64_tr_b16 %0,%1 offset:%c2" : "=&v"(lo[ks]) : "v"(vb), "i"(d0 * 4096 + ks * 1024) : "memory");
      asm volatile("ds_read_b64_tr_b16 %0,%1 offset:%c2" : "=&v"(hi[ks]) : "v"(vb), "i"(d0 * 4096 + ks * 1024 + 512) : "memory"); }
    asm volatile("s_waitcnt lgkmcnt(0)" ::: "memory"); SBAR();
    #define PK(k) (bf16x8){lo[k][0], lo[k][1], lo[k][2], lo[k][3], hi[k][0], hi[k][1], hi[k][2], hi[k][3]}
    o[d0] = MFMA32(pa0, PK(0), o[d0]);
    o[d0] = MFMA32(pa1, PK(1), o[d0]);
    o[d0] = MFMA32(pa2, PK(2), o[d0]);
    o[d0] = MFMA32(pa3, PK(3), o[d0]);
    #undef PK
  }
}
template <int THRL> __device__ __forceinline__ void attn_unit(const bf16* Qu, const bf16* __restrict__ Kh, const bf16* __restrict__ Vh, bf16* Zu, int NT, char* shm, const float* qg, const float* tabc, const float* tabs, int t0) {
  int tid = threadIdx.x; asm volatile("" : "+v"(tid));
  const int lane = tid & 63, r32 = lane & 31, hi = lane >> 5; const int wid = __builtin_amdgcn_readfirstlane(tid >> 6);
  const bf16* Qw = Qu + (long)(wid * QBLK) * P;
  const unsigned lds0 = (unsigned)(uintptr_t)shm;
  float* wsf = (float*)(shm + LDS_WS) + wid * 64;
  const bf16* ksrc = Kh + (long)lane * P + wid * 8;
  const bf16* vsrc = Vh + (long)(16 * (wid & 3) + (lane >> 2)) * P + (wid >> 2) * 32 + (lane & 3) * 8;
  const unsigned kdst = lds0 + LDS_K + wid * 1024, vdst = lds0 + LDS_V + wid * 1024;
  #define DMA_K(t, slot) glds16(ksrc + (long)(t) * KVBLK * P, (unsigned)__builtin_amdgcn_readfirstlane(kdst + (slot)))
  #define DMA_V(t, slot) glds16(vsrc + (long)(t) * KVBLK * P, (unsigned)__builtin_amdgcn_readfirstlane(vdst + (slot)))
  const int vb0 = (int)(lds0 + LDS_V) + ((lane >> 4) & 1) * 32 + (lane & 3) * 8 + (4 * hi + ((lane & 15) >> 2)) * 64;
  const char* Kbase = shm + LDS_K; bf16x8 kf[8];
  const lds_cptr shm3 = (lds_cptr)shm; const lds_cptr kp0 = shm3 + LDS_K + hi * 1024 + r32 * 16; const lds_cptr vp0 = shm3 + LDS_V + ((lane >> 4) & 1) * 32 + (lane & 3) * 8 + (4 * hi + ((lane & 15) >> 2)) * 64;
  DMA_K(0, 0); DMA_V(0, 0); DMA_K(1, SLOTB);
  bf16x8 qr[4];
  #pragma unroll
  for (int d0 = 0; d0 < 4; ++d0) qr[d0] = *reinterpret_cast<const bf16x8*>(&Qw[(long)r32 * P + d0 * 16 + hi * 8]);
  {
    float x[4][8]; float ss = 0.f;
    #pragma unroll
    for (int d0 = 0; d0 < 4; ++d0) { const u32x4 u = __builtin_bit_cast(u32x4, qr[d0]);
      x[d0][0] = bflo(u.x); x[d0][1] = bfhi(u.x); x[d0][2] = bflo(u.y); x[d0][3] = bfhi(u.y); x[d0][4] = bflo(u.z); x[d0][5] = bfhi(u.z); x[d0][6] = bflo(u.w); x[d0][7] = bfhi(u.w);
      #pragma unroll
      for (int j = 0; j < 8; ++j) ss += x[d0][j] * x[d0][j]; }
    { auto rr = __builtin_amdgcn_permlane32_swap(__float_as_uint(ss), __float_as_uint(ss), false, false); ss = __uint_as_float(rr[0]) + __uint_as_float(rr[1]); }
    const float rs = __builtin_amdgcn_rsqf(ss * (1.f / 64.f) + EPS) * C2;
    const int tq = t0 + wid * QBLK + r32, pr = tq >> 6, pc = tq & 63;
    #pragma unroll
    for (int d0 = 0; d0 < 4; ++d0) { const f32x4 g0 = *(const f32x4*)(qg + 16 * d0 + 8 * hi), g1 = *(const f32x4*)(qg + 16 * d0 + 8 * hi + 4);
      #pragma unroll
      for (int j = 0; j < 4; ++j) { x[d0][j] *= rs * g0[j]; x[d0][4 + j] *= rs * g1[j]; } }
    #pragma unroll
    for (int ax = 0; ax < 2; ++ax) { const int pos = ax ? pc : pr;
      const f32x4 c0 = *(const f32x4*)(tabc + pos * 16 + 8 * hi), c1 = *(const f32x4*)(tabc + pos * 16 + 8 * hi + 4), s0 = *(const f32x4*)(tabs + pos * 16 + 8 * hi), s1 = *(const f32x4*)(tabs + pos * 16 + 8 * hi + 4);
      #pragma unroll
      for (int j = 0; j < 8; ++j) { const float cc = j < 4 ? c0[j & 3] : c1[j & 3], sn = j < 4 ? s0[j & 3] : s1[j & 3];
        const float a = x[2 * ax][j], b = x[2 * ax + 1][j]; x[2 * ax][j] = a * cc - b * sn; x[2 * ax + 1][j] = b * cc + a * sn; } }
    #pragma unroll
    for (int d0 = 0; d0 < 4; ++d0) { u32x4 u; u.x = pk2(x[d0][0], x[d0][1]); u.y = pk2(x[d0][2], x[d0][3]); u.z = pk2(x[d0][4], x[d0][5]); u.w = pk2(x[d0][6], x[d0][7]); qr[d0] = __builtin_bit_cast(bf16x8, u); }
  }
  float mhat = 0.f, l_reg = 0.f; f32x16 o[2]; o[0] = f32x16{}; o[1] = f32x16{}; f32x16 negm = f32x16{}; asm volatile("" : "+v"(negm));
  bool resc = false;
  #define START(P0, P1) do { const float rm = rowmax(P0, P1); resc = false; \
    { const float dl = rm; mhat = fadd_s(mhat, dl); \
      _Pragma("unroll") for (int r = 0; r < 16; ++r) { P0[r] = fsub_s(P0[r], dl); P1[r] = fsub_s(P1[r], dl); } \
      _Pragma("unroll") for (int r = 0; r < 16; ++r) negm[r] = -mhat; asm volatile("" : "+v"(negm)); } \
    _Pragma("unroll") for (int r = 0; r < 16; ++r) P0[r] = __builtin_amdgcn_exp2f(P0[r]); } while (0)
  #define RESC() do { if (resc) { asm volatile("s_waitcnt lgkmcnt(0)" ::: "memory"); \
      _Pragma("unroll") for (int d_ = 0; d_ < 2; ++d_) _Pragma("unroll") for (int r = 0; r < 16; ++r) o[d_][r] *= wsf[crow(r, hi)]; } } while (0)
  f32x16 pA0, pA1, pB0, pB1;
  int sl_prev = 0, sl_cur = 0, sl_next = SLOTB;
  #define ROT() do { sl_prev = sl_cur; sl_cur = sl_next; sl_next = (sl_next == (NSLOT - 1) * SLOTB) ? 0 : sl_next + SLOTB; } while (0)
  DMA_K(2, 2 * SLOTB);
  WAIT_BAR(3);
  qkt(pA0, pA1, Kbase, qr, negm, r32, hi); asm volatile("s_nop 15\n\ts_nop 7" : "+v"(pA0), "+v"(pA1));
  START(pA0, pA1);
  _Pragma("unroll") for (int r = 0; r < 16; ++r) pA1[r] = __builtin_amdgcn_exp2f(pA1[r]);
  WAIT_BAR(0);
  DMA_K(3, 0); DMA_V(1, SLOTB);
  ROT();
  kload8(kf, kp0 + sl_cur);
  WAIT_BAR(2);
  s16x4 vlo[8], vhi[8]; u32x4 pw0, pw1, pw2, pw3;
  #define PKW(Pq, B) cvtpk_s(Pq[B], Pq[B + 1])
  #define PAF(k) __builtin_bit_cast(bf16x8, pw##k)
  #define VFR(i) (bf16x8){vlo[i][0], vlo[i][1], vlo[i][2], vlo[i][3], vhi[i][0], vhi[i][1], vhi[i][2], vhi[i][3]}
  #define PIN(x) asm volatile("" : "+v"(x))
  #define MX3(a, b, c) __builtin_fmaxf(__builtin_fmaxf((a), (b)), (c))
  #define GAPA(MF, A0, A1, A2, A3, W0, W1, PW) do { MF; sacc += A0; sacc += A1; sacc += A2; sacc += A3; PIN(sacc); W0; W1; PIN(PW); SBAR(); } while (0)
  #define EX(v) __builtin_amdgcn_exp2f(v)
  #define GAPB(MF, X, B) do { MF; X[B] = EX(X[B]); X[B + 1] = EX(X[B + 1]); X[B + 2] = EX(X[B + 2]); X[B + 3] = EX(X[B + 3]); PIN(X); SBAR(); } while (0)
  #define VRD(i) do { vlo[i] = vtr(vp_ + (((i) >> 2) * 4096 + ((i) & 3) * 1024)); vhi[i] = vtr(vp_ + (((i) >> 2) * 4096 + ((i) & 3) * 1024 + 512)); } while (0)
  #define KRD(G, j) do { if (G) { kload2(kf, kp0 + sl_next, j); SBAR(); } } while (0)
  #define STEP(C0, C1, P0, P1, t, GK, GV, GL) do { SBAR(); \
    const lds_cptr vp_ = vp0 + sl_prev; \
    VRD(0); SBAR(); float sacc = (P0[0] + P0[1]); \
    GAPA(C0 = MFMA32(kf[0], qr[0], negm), P0[2], P0[3], P0[4], P0[5],     pw0[0] = PKW(P0, 0), pw0[1] = PKW(P0, 2), pw0); \
    VRD(4); SBAR(); GAPA(C1 = MFMA32(kf[1], qr[0], negm), P0[6], P0[7], P0[8], P0[9],     pw0[2] = PKW(P0, 4), pw0[3] = PKW(P0, 6), pw0); \
    VRD(1); SBAR(); GAPA(C0 = MFMA32(kf[2], qr[1], C0),   P0[10], P0[11], P0[12], P0[13], pw1[0] = PKW(P0, 8), pw1[1] = PKW(P0, 10), pw1); \
    VRD(5); SBAR(); GAPA(C1 = MFMA32(kf[3], qr[1], C1),   P0[14], P0[15], P1[0], P1[1],   pw1[2] = PKW(P0, 12), pw1[3] = PKW(P0, 14), pw1); \
    VRD(2); SBAR(); GAPA(C0 = MFMA32(kf[4], qr[2], C0),   P1[2], P1[3], P1[4], P1[5],     pw2[0] = PKW(P1, 0), pw2[1] = PKW(P1, 2), pw2); \
    VRD(6); SBAR(); GAPA(C1 = MFMA32(kf[5], qr[2], C1),   P1[6], P1[7], P1[8], P1[9],     pw2[2] = PKW(P1, 4), pw2[3] = PKW(P1, 6), pw2); \
    VRD(3); SBAR(); GAPA(C0 = MFMA32(kf[6], qr[3], C0),   P1[10], P1[11], P1[12], P1[13], pw3[0] = PKW(P1, 8), pw3[1] = PKW(P1, 10), pw3); \
    VRD(7); SBAR(); GAPA(C1 = MFMA32(kf[7], qr[3], C1),   P1[14], P1[15], 0.f, 0.f,       pw3[2] = PKW(P1, 12), pw3[3] = PKW(P1, 14), pw3); \
    l_reg += sacc; \
    if (GK) { DMA_K((t) + 3, sl_cur); } if (GV) { DMA_V((t) + 1, sl_next); } \
    { float a = MX3(C0[0], C0[1], C1[0]), b = MX3(C0[2], C0[3], C1[1]); a = MX3(a, C1[2], C1[3]); \
      _Pragma("unroll") for (int r = 4; r < 16; r += 4) { a = MX3(a, C0[r], C0[r + 1]); b = MX3(b, C0[r + 2], C0[r + 3]); a = MX3(a, C1[r], C1[r + 1]); b = MX3(b, C1[r + 2], C1[r + 3]); } \
      float rm = __builtin_fmaxf(a, b); { auto rr = __builtin_amdgcn_permlane32_swap(__float_as_uint(rm), __float_as_uint(rm), false, false); rm = __builtin_fmaxf(__uint_as_float(rr[0]), __uint_as_float(rr[1])); } \
      resc = false; \
      if (__builtin_expect(__any(rm > (float)THRL), 0)) { const float dl = __builtin_fmaxf(rm, 0.f); mhat += dl; \
        _Pragma("unroll") for (int r = 0; r < 16; ++r) { C0[r] -= dl; C1[r] -= dl; } \
        _Pragma("unroll") for (int r = 0; r < 16; ++r) negm[r] = -mhat; asm volatile("" : "+v"(negm)); \
        const float f = __builtin_amdgcn_exp2f(-dl); l_reg *= f; if (hi == 0) wsf[r32] = f; resc = true; } } \
    SBAR(); \
    GAPB(o[0] = MFMA32(PAF(0), VFR(0), o[0]), C0, 0); \
    GAPB(o[1] = MFMA32(PAF(0), VFR(4), o[1]), C0, 4); \
    KRD(GL, 0); GAPB(o[0] = MFMA32(PAF(1), VFR(1), o[0]), C0, 8); \
    KRD(GL, 1); GAPB(o[1] = MFMA32(PAF(1), VFR(5), o[1]), C0, 12); \
    KRD(GL, 2); GAPB(o[0] = MFMA32(PAF(2), VFR(2), o[0]), C1, 0); \
    KRD(GL, 3); GAPB(o[1] = MFMA32(PAF(2), VFR(6), o[1]), C1, 4); \
    GAPB(o[0] = MFMA32(PAF(3), VFR(3), o[0]), C1, 8); \
    GAPB(o[1] = MFMA32(PAF(3), VFR(7), o[1]), C1, 12); \
    } while (0)
  int t = 1;
  for (; t + 5 < NT; t += 2) {
    STEP(pB0, pB1, pA0, pA1, t, true, true, true);     WAIT_BAR(2); RESC(); ROT();
    STEP(pA0, pA1, pB0, pB1, t + 1, true, true, true); WAIT_BAR(2); RESC(); ROT();
  }
  #define ENDW(tt) do { if ((tt) + 3 < NT) { WAIT_BAR(2); } else if ((tt) + 2 < NT) { WAIT_BAR(1); } else { WAIT_BAR(0); } } while (0)
  for (; t + 1 < NT; t += 2) {
    STEP(pB0, pB1, pA0, pA1, t, (t + 3 < NT), (t + 1 < NT), (t + 1 < NT));       ENDW(t);     RESC(); ROT();
    STEP(pA0, pA1, pB0, pB1, t + 1, (t + 4 < NT), (t + 2 < NT), (t + 2 < NT));   ENDW(t + 1); RESC(); ROT();
  }
  STEP(pB0, pB1, pA0, pA1, NT - 1, false, false, false); RESC();
  { float sacc = pB0[0] + pB0[1]; _Pragma("unroll") for (int r = 2; r < 16; ++r) sacc += pB0[r]; _Pragma("unroll") for (int r = 0; r < 16; ++r) sacc += pB1[r]; l_reg += sacc;
    pw0 = (u32x4){PKW(pB0, 0), PKW(pB0, 2), PKW(pB0, 4), PKW(pB0, 6)}; pw1 = (u32x4){PKW(pB0, 8), PKW(pB0, 10), PKW(pB0, 12), PKW(pB0, 14)}; pw2 = (u32x4){PKW(pB1, 0), PKW(pB1, 2), PKW(pB1, 4), PKW(pB1, 6)}; pw3 = (u32x4){PKW(pB1, 8), PKW(pB1, 10), PKW(pB1, 12), PKW(pB1, 14)};
    SBAR(); pv(o, vb0 + sl_cur, PAF(0), PAF(1), PAF(2), PAF(3)); }
  #undef PKW
  #undef PAF
  #undef VFR
  #undef PIN
  #undef MX3
  #undef GAPA
  #undef GAPB
  #undef EX
  #undef VRD
  #undef KRD
  #undef STEP
  #undef ENDW
  { auto rr = __builtin_amdgcn_permlane32_swap(__float_as_uint(l_reg), __float_as_uint(l_reg), false, false); l_reg = __uint_as_float(rr[0]) + __uint_as_float(rr[1]); }
  if (hi == 0) wsf[32 + r32] = l_reg; asm volatile("s_waitcnt lgkmcnt(0)" ::: "memory");
  float rli[16];
  #pragma unroll
  for (int r = 0; r < 16; ++r) rli[r] = __builtin_amdgcn_rcpf(wsf[32 + crow(r, hi)]);
  bf16* Zw = Zu + (long)(wid * QBLK) * P;
  { bf16* stg = (bf16*)(shm + LDS_OST) + wid * 2048;
    #pragma unroll
    for (int r = 0; r < 16; ++r) { const int orow = crow(r, hi);
      #pragma unroll
      for (int d0 = 0; d0 < 2; ++d0) stg[orow * 64 + d0 * 32 + r32] = __float2bfloat16(o[d0][r] * rli[r]); }
    asm volatile("s_waitcnt lgkmcnt(0)" ::: "memory");
    #pragma unroll
    for (int i = 0; i < 4; ++i) { const int row = i * 8 + (lane >> 3), ch = lane & 7; const u32x4 v = *(const u32x4*)(stg + row * 64 + ch * 8);
      u32x4* zp = (u32x4*)(Zw + (long)row * P + ch * 8); const u32x4 z = *zp; u32x4 w;
      w.x = pk2(bflo(v.x) * silu(bflo(z.x)), bfhi(v.x) * silu(bfhi(z.x))); w.y = pk2(bflo(v.y) * silu(bflo(z.y)), bfhi(v.y) * silu(bfhi(z.y)));
      w.z = pk2(bflo(v.z) * silu(bflo(z.z)), bfhi(v.z) * silu(bfhi(z.z))); w.w = pk2(bflo(v.w) * silu(bflo(z.w)), bfhi(v.w) * silu(bfhi(z.w)));
      *zp = w; } }
  asm volatile("s_waitcnt vmcnt(0) lgkmcnt(0)\n\ts_barrier" ::: "memory");
  #undef DMA_K
  #undef DMA_V
  #undef START
  #undef RESC
  #undef ROT
}
#undef SBAR
#undef WAIT_BAR
}

#define XB_TMO      128
#define XB_XCNT(j)  (256  + 64 * (j))
#define XB_XSUB(j)  (1280 + 64 * (j))
#define XB_XGEN(j)  (2304 + 64 * (j))
#define XB_TOP      3328
#define XB_TOPGEN   3392
#define XCD_BAR_WORDS 3456
#define XB_SPIN_CAP (1u << 20)
__device__ __forceinline__ unsigned xb_ld(unsigned* p)              { return __hip_atomic_load(p, __ATOMIC_RELAXED, __HIP_MEMORY_SCOPE_AGENT); }
__device__ __forceinline__ unsigned xb_add(unsigned* p, unsigned v) { return __hip_atomic_fetch_add(p, v, __ATOMIC_RELAXED, __HIP_MEMORY_SCOPE_AGENT); }
__device__ __forceinline__ unsigned xb_xcc_id() { return (unsigned)__builtin_amdgcn_s_getreg((3 << 11) | 20) & 0xFu; }
#define XB_SPIN(cond, bar) do { unsigned _sp = 0; while (cond) { __builtin_amdgcn_s_sleep(1); \
    if ((++_sp & 255u) == 0u) { if (xb_ld(&(bar)[XB_TMO])) break; if (_sp > XB_SPIN_CAP) { atomicAdd(&(bar)[XB_TMO], 1u); break; } } } } while (0)
struct XcdBarrier { unsigned* bar; unsigned x; volatile LAS unsigned* st; };
__device__ __forceinline__ XcdBarrier xcd_barrier_post(unsigned* bar, volatile LAS unsigned* st) {
    XcdBarrier b; b.bar = bar; b.x = xb_xcc_id(); b.st = st;
    if (threadIdx.x == 0) (void)xb_add(&bar[XB_XCNT(b.x)], 1u);
    return b;
}
__device__ __forceinline__ void xcd_barrier_complete(unsigned* bar, unsigned x, unsigned& nloc, unsigned& nx) {
    const unsigned G = gridDim.x * gridDim.y * gridDim.z;
    unsigned sum, cnt, mine, sp = 0u;
    for (;;) {
        sum = 0u; cnt = 0u; mine = 0u;
#pragma unroll 1
        for (unsigned j = 0; j < 16; ++j) { const unsigned c = xb_ld(&bar[XB_XCNT(j)]); sum += c; cnt += (c > 0u) ? 1u : 0u; mine = (j == x) ? c : mine; }
        if (sum == G) break;
        __builtin_amdgcn_s_sleep(1);
        if ((++sp & 255u) == 0u) { if (xb_ld(&bar[XB_TMO])) break; if (sp > XB_SPIN_CAP) { atomicAdd(&bar[XB_TMO], 1u); break; } }
    }
    nloc = mine > 0u ? mine : 1u; nx = cnt > 0u ? cnt : 1u;
}
__device__ __forceinline__ void xcd_barrier(const XcdBarrier& b) {
    asm volatile("s_waitcnt vmcnt(0)" ::: "memory");
    __syncthreads();
    int t0 = threadIdx.x; asm volatile("" : "+v"(t0));
    if (t0 == 0) {
        unsigned* bar = b.bar;
        __builtin_amdgcn_s_waitcnt(0);
        unsigned nloc = b.st[0], nx = b.st[1];
        if (nloc == 0u) { xcd_barrier_complete(bar, b.x, nloc, nx); b.st[0] = nloc; b.st[1] = nx; }
        const unsigned old = xb_add(&bar[XB_XSUB(b.x)], 1u);
        const unsigned gen = old / nloc;
        if (old + 1u == (gen + 1u) * nloc) {
            __builtin_amdgcn_fence(__ATOMIC_RELEASE, "agent");
            asm volatile("s_waitcnt vmcnt(0)" ::: "memory");
            const unsigned og = xb_add(&bar[XB_TOP], 1u);
            const unsigned tg = og / nx;
            if (og + 1u == (tg + 1u) * nx) xb_add(&bar[XB_TOPGEN], 1u);
            else XB_SPIN(xb_ld(&bar[XB_TOPGEN]) == tg, bar);
            __builtin_amdgcn_fence(__ATOMIC_ACQUIRE, "agent");
            xb_add(&bar[XB_XGEN(b.x)], 1u);
            asm volatile("s_waitcnt vmcnt(0)" ::: "memory");
        } else {
            XB_SPIN(xb_ld(&bar[XB_XGEN(b.x)]) == gen, bar);
            __builtin_amdgcn_fence(__ATOMIC_ACQUIRE, "agent");
            asm volatile("s_waitcnt vmcnt(0)" ::: "memory");
        }
    }
    __syncthreads();
}

struct Args { const float* in[15]; float* out; unsigned char* ws; int ph_lo, ph_hi; };

__device__ __forceinline__ float wave_sum(float v) {
#pragma unroll
    for (int o = 1; o < 64; o <<= 1) v += __shfl_xor(v, o);
    return v;
}

__device__ __forceinline__ void tr_item(const float* W, int ldw, int k0, int n0, bf16_t* dst, int dpitch, const float* gk, float sc, LAS float* scr, int lane) {
#pragma unroll
    for (int i = 0; i < 32; ++i) { const int kk = 2 * i + (lane >> 5); float v = __builtin_nontemporal_load(W + (size_t)(k0 + kk) * ldw + n0 + (lane & 31)); if (gk) v *= gk[k0 + kk]; scr[kk * 33 + (lane & 31)] = v * sc; }
    asm volatile("s_waitcnt lgkmcnt(0)" ::: "memory");
    const int c = lane & 7;
#pragma unroll
    for (int j = 0; j < 4; ++j) { const int n = (lane >> 3) + 8 * j; const LAS float* s = scr + (8 * c) * 33 + n;
        u32x4 o; o.x = pk2(s[0 * 33], s[1 * 33]); o.y = pk2(s[2 * 33], s[3 * 33]); o.z = pk2(s[4 * 33], s[5 * 33]); o.w = pk2(s[6 * 33], s[7 * 33]);
        *(u32x4*)(dst + (size_t)n * dpitch + 8 * c) = o; }
    asm volatile("s_waitcnt lgkmcnt(0)" ::: "memory");
}
__device__ __forceinline__ int map_col(int n0) {
    if (n0 < 2048) return n0;
    if (n0 < 2080) return C_GL;
    if (n0 < 3104) return C_ZA + (n0 - 2080);
    if (n0 < 4128) return C_QB + (n0 - 3104);
    if (n0 < 4384) return C_KB + (n0 - 4128);
    if (n0 < 4640) return C_VB + (n0 - 4384);
    if (n0 < 5664) return C_ZB + (n0 - 4640);
    if (n0 < 6688) return C_MA + (n0 - 5664);
    return C_MB + (n0 - 6688);
}
constexpr int CV_IN = 16 * 241, CV_SQ = 16 * 32, CV_ITEMS = CV_IN + 3 * CV_SQ;
__device__ __forceinline__ void convert_item(const Args& args, int l, int r, bf16_t* WIN, bf16_t* WBR, bf16_t* WOUT, LAS float* scr, int lane) {
    if (r < CV_IN) { const int kb = r / 241, nb = r % 241, n0 = 32 * nb;
        tr_item(args.in[3] + (size_t)l * DM * IN_DIM, IN_DIM, 64 * kb, n0, WIN + (size_t)l * WIN_L + (size_t)map_col(n0) * DM + 64 * kb, DM, args.in[2] + l * DM, n0 < 512 ? 0.08838834764831845f : 1.f, scr, lane);
        return; }
    r -= CV_IN;
    const int which = r / CV_SQ; r %= CV_SQ; const int kb = r / 32, nb = r % 32;
    if (which == 0) tr_item(args.in[11] + (size_t)l * DM * DM, DM, 64 * kb, 32 * nb, WBR + (size_t)l * DM * 2048 + (size_t)(32 * nb) * 2048 + 64 * kb, 2048, nullptr, 1.f, scr, lane);
    else if (which == 1) tr_item(args.in[12] + (size_t)l * DM * DM, DM, 64 * kb, 32 * nb, WBR + (size_t)l * DM * 2048 + (size_t)(32 * nb) * 2048 + 1024 + 64 * kb, 2048, nullptr, 1.f, scr, lane);
    else tr_item(args.in[13] + (size_t)l * DM * DM, DM, 64 * kb, 32 * nb, WOUT + (size_t)l * DM * DM + (size_t)(32 * nb) * DM + 64 * kb, DM, nullptr, 1.f, scr, lane);
}

__device__ __forceinline__ void x_rows_to_bf16(const float* x, bf16_t* xb, float* ssp, int gw, int ngw, int lane) {
    for (int m = gw; m < NTOK; m += ngw) {
        const f32x4* xr = (const f32x4*)(x + (size_t)m * DM) + lane; f32x4 v[4]; float s = 0.f;
#pragma unroll
        for (int j = 0; j < 4; ++j) { v[j] = __builtin_nontemporal_load(xr + 64 * j); s += (v[j].x * v[j].x + v[j].y * v[j].y) + (v[j].z * v[j].z + v[j].w * v[j].w); }
        s = wave_sum(s);
        u32x2* o8 = (u32x2*)(xb + (size_t)m * DM) + lane;
#pragma unroll
        for (int j = 0; j < 4; ++j) { u32x2 w; w.x = pk2(v[j].x, v[j].y); w.y = pk2(v[j].z, v[j].w); o8[64 * j] = w; }
        if (lane < 16) ssp[(size_t)m * 16 + lane] = (lane == 0) ? s : 0.f;
    }
}

constexpr int PL_GL = 0, PL_TOT = 8192, PL_QF = 12288, PL_KF = PL_QF + 17408, PL_QB = PL_KF + 17408, PL_KB = PL_QB + 17408, PL_VT = PL_KB + 17408, PL_A = PL_VT + 36864, PL_END = PL_A + 9216;
static_assert(PL_END <= RING_BYTES, "prep LDS");
struct PrepIn { u32x2 gl; u32x4 v[4]; };
struct PrepW { float wf[16], wb[16], bf, bb; };
__device__ __forceinline__ void gla_prep_loadw(PrepW& w, const float* wgf, const float* bgf, const float* wgb, const float* bgb, int h) {
    int tid = threadIdx.x; asm volatile("" : "+v"(tid)); const int c = tid & 127;
#pragma unroll
    for (int r = 0; r < 16; ++r) { w.wf[r] = wgf[r * 512 + h * 128 + c]; w.wb[r] = wgb[r * 512 + h * 128 + c]; }
    w.bf = bgf[h * 128 + c]; w.bb = bgb[h * 128 + c];
}
__device__ __forceinline__ void gla_prep_load(PrepIn& in, const bf16_t* proj, int gc, int h) {
    int tid = threadIdx.x; asm volatile("" : "+v"(tid));
    const int row0 = gc * 64;
    { const int t = tid >> 3, r = (tid & 7) * 4; in.gl = *(const u32x2*)(proj + (size_t)(row0 + t) * LDP + C_GL + r); }
#pragma unroll
    for (int i = 0; i < 4; ++i) { const int idx = tid + 512 * i, t = idx & 63, dv = (idx >> 6) * 8; in.v[i] = *(const u32x4*)(proj + (size_t)(row0 + t) * LDP + C_VA + h * 256 + dv); }
}
__device__ __forceinline__ void gla_prep_tile(LAS unsigned char* lds, const PrepIn& in, const PrepW& pw, int gc, int h, bf16_t* proj,
                                              float* ef, float* eb, bf16_t* kltf, bf16_t* kltb, bf16_t* vtg, bf16_t* pst, int rmask) {
    int tid = threadIdx.x; asm volatile("" : "+v"(tid));
    const int lane = tid & 63, wave = tid >> 6, c = tid & 127, s = tid >> 7, l32 = lane & 31, hh = lane >> 5;
    const int row0 = gc * 64;
    LAS float* GLl = (LAS float*)(lds + PL_GL); LAS float* TOT = (LAS float*)(lds + PL_TOT);
    LAS bf16_t* QFl = (LAS bf16_t*)(lds + PL_QF); LAS bf16_t* KFl = (LAS bf16_t*)(lds + PL_KF); LAS bf16_t* QBl = (LAS bf16_t*)(lds + PL_QB); LAS bf16_t* KBl = (LAS bf16_t*)(lds + PL_KB);
    LAS bf16_t* VTl = (LAS bf16_t*)(lds + PL_VT); LAS bf16_t* Al = (LAS bf16_t*)(lds + PL_A);
    { const int t = tid >> 3, r = (tid & 7) * 4; const u32x2 g = in.gl;
      GLl[t * 32 + r] = bflo(g.x); GLl[t * 32 + r + 1] = bfhi(g.x); GLl[t * 32 + r + 2] = bflo(g.y); GLl[t * 32 + r + 3] = bfhi(g.y); }
#pragma unroll
    for (int i = 0; i < 4; ++i) { const int idx = tid + 512 * i, t = idx & 63, dv = (idx >> 6) * 8;
        const u32x4 v = in.v[i];
        VTl[(dv + 0) * 72 + t] = (bf16_t)(v.x & 0xffffu); VTl[(dv + 1) * 72 + t] = (bf16_t)(v.x >> 16);
        VTl[(dv + 2) * 72 + t] = (bf16_t)(v.y & 0xffffu); VTl[(dv + 3) * 72 + t] = (bf16_t)(v.y >> 16);
        VTl[(dv + 4) * 72 + t] = (bf16_t)(v.z & 0xffffu); VTl[(dv + 5) * 72 + t] = (bf16_t)(v.z >> 16);
        VTl[(dv + 6) * 72 + t] = (bf16_t)(v.w & 0xffffu); VTl[(dv + 7) * 72 + t] = (bf16_t)(v.w >> 16); }
    const float bfv = pw.bf, bbv = pw.bb;
    bf16_t qraw[16], kraw[16];
#pragma unroll
    for (int j = 0; j < 16; ++j) { qraw[j] = proj[(size_t)(row0 + 16 * s + j) * LDP + C_QA + h * 128 + c]; kraw[j] = proj[(size_t)(row0 + 16 * s + j) * LDP + C_KA + h * 128 + c]; }
    LDS_BARRIER();
    float pf[16], sb[16];
#pragma unroll
    for (int j = 0; j < 16; ++j) { const int t = 16 * s + j; float zf = bfv, zb = bbv;
#pragma unroll
        for (int r = 0; r < 16; r += 4) { const f32x4 ga = *(const LAS f32x4*)(GLl + t * 32 + r), gb2 = *(const LAS f32x4*)(GLl + t * 32 + 16 + r);
            zf += ga[0] * pw.wf[r] + ga[1] * pw.wf[r + 1] + ga[2] * pw.wf[r + 2] + ga[3] * pw.wf[r + 3]; zb += gb2[0] * pw.wb[r] + gb2[1] * pw.wb[r + 1] + gb2[2] * pw.wb[r + 2] + gb2[3] * pw.wb[r + 3]; }
        pf[j] = logsig(zf) * (1.f / 16.f); sb[j] = logsig(zb) * (1.f / 16.f); }
#pragma unroll
    for (int j = 1; j < 16; ++j) pf[j] += pf[j - 1];
#pragma unroll
    for (int j = 14; j >= 0; --j) sb[j] += sb[j + 1];
    TOT[(0 * 4 + s) * 128 + c] = pf[15]; TOT[(1 * 4 + s) * 128 + c] = sb[0];
    LDS_BARRIER();
    float offf = 0.f, allf = 0.f, offb = 0.f, allb = 0.f;
#pragma unroll
    for (int s2 = 0; s2 < 4; ++s2) { const float a = TOT[(0 * 4 + s2) * 128 + c], b = TOT[(1 * 4 + s2) * 128 + c]; allf += a; allb += b; if (s2 < s) offf += a; if (s2 > s) offb += b; }
    const float etf = fexp(allf), etb = fexp(allb);
    if (s == 0) { ef[(size_t)(gc * 4 + h) * 128 + c] = etf; eb[(size_t)(gc * 4 + h) * 128 + c] = etb; }
    unsigned klf[8], klb[8];
#pragma unroll
    for (int j = 0; j < 16; j += 2) {
        float o_klf[2], o_klb[2];
#pragma unroll
        for (int e = 0; e < 2; ++e) { const int t = 16 * s + j + e;
            const float q = bf2f(qraw[j + e]), k = bf2f(kraw[j + e]);
            const float bfw = offf + pf[j + e], bbw = offb + sb[j + e];
            const float Ef = fexp(bfw), Eb = fexp(bbw), rEf = __builtin_amdgcn_rcpf(Ef), rEb = __builtin_amdgcn_rcpf(Eb);
            const bf16_t qsf = f2bf(q * Ef), ksf = f2bf(k * rEf), qsb = f2bf(q * Eb), ksb = f2bf(k * rEb);
            o_klf[e] = k * (rEf * etf); o_klb[e] = k * (rEb * etb);
            pst[(size_t)((row0 + t) & rmask) * LDP + C_QA + h * 128 + c] = qsf; pst[(size_t)((row0 + t) & rmask) * LDP + C_KA + h * 128 + c] = qsb;
            QFl[t * 136 + c] = qsf; KFl[t * 136 + c] = ksf; QBl[t * 136 + c] = qsb; KBl[t * 136 + c] = ksb; }
        klf[j >> 1] = pk2(o_klf[0], o_klf[1]); klb[j >> 1] = pk2(o_klb[0], o_klb[1]);
    }
    { u32x4* d = (u32x4*)(kltf + ((size_t)(gc * 4 + h) * 128 + c) * 64 + 16 * s); d[0] = (u32x4){klf[0], klf[1], klf[2], klf[3]}; d[1] = (u32x4){klf[4], klf[5], klf[6], klf[7]};
      u32x4* d2 = (u32x4*)(kltb + ((size_t)(gc * 4 + h) * 128 + c) * 64 + 16 * s); d2[0] = (u32x4){klb[0], klb[1], klb[2], klb[3]}; d2[1] = (u32x4){klb[4], klb[5], klb[6], klb[7]}; }
    LDS_BARRIER();
    { const int dir = wave >> 2, bi = (wave >> 1) & 1, bj = wave & 1;
      const LAS bf16_t* Qt = dir ? QBl : QFl; const LAS bf16_t* Kt = dir ? KBl : KFl;
      f32x16 acc = f32x16{};
#pragma unroll
      for (int ks = 0; ks < 8; ++ks) { const bf16x8 a = *(const LAS bf16x8*)(Qt + (32 * bi + l32) * 136 + 16 * ks + 8 * hh); const bf16x8 b = *(const LAS bf16x8*)(Kt + (32 * bj + l32) * 136 + 16 * ks + 8 * hh); acc = MFMA32(a, b, acc); }
      const int jj = 32 * bj + l32;
#pragma unroll
      for (int r = 0; r < 16; ++r) { const int ii = 32 * bi + crow(r, hh); const bool keep = dir ? (jj > ii) : (jj <= ii); if (keep) Al[ii * 72 + jj] = f2bf(acc[r]); } }
    LDS_BARRIER();
    {
#pragma unroll
      for (int tb = 0; tb < 2; ++tb) { f32x16 acc = f32x16{};
#pragma unroll
        for (int ks = 0; ks < 4; ++ks) { const bf16x8 a = *(const LAS bf16x8*)(VTl + (32 * wave + l32) * 72 + 16 * ks + 8 * hh); const bf16x8 b = *(const LAS bf16x8*)(Al + (32 * tb + l32) * 72 + 16 * ks + 8 * hh); acc = MFMA32(a, b, acc); }
        bf16_t* op = pst + (size_t)((row0 + 32 * tb + l32) & rmask) * LDP + C_VA + h * 256 + 32 * wave + 4 * hh;
#pragma unroll
        for (int g = 0; g < 4; ++g) { u32x2 w; w.x = pk2(acc[4 * g], acc[4 * g + 1]); w.y = pk2(acc[4 * g + 2], acc[4 * g + 3]); *(u32x2*)(op + 8 * g) = w; } }
#pragma unroll
      for (int i = 0; i < 4; ++i) { const int idx = tid + 512 * i, dv = idx >> 3, tg = idx & 7;
        *(u32x4*)(vtg + ((size_t)(gc * 4 + h) * 256 + dv) * 64 + 8 * tg) = *(const LAS u32x4*)(VTl + dv * 72 + 8 * tg); } }
    LDS_BARRIER();
}

template <int NB>
__device__ __forceinline__ void qk_norm_items(bf16_t* proj, int it0, int itstride, int nitems, int T, const float* qg, const float* kg, const float* tabc, const float* tabs, int lane, bf16_t* pst, int rmask) {
    const int li = lane & 15, d0 = 4 * li, half = li >> 3, within = li & 7; const bool first = within < 4;
    bf16_t* p[NB]; bf16_t* pw[NB]; u32x2 u[NB]; f32x4 c4[NB], s4[NB]; bool isq[NB], ok[NB];
#pragma unroll
    for (int i = 0; i < NB; ++i) { const int it = it0 + i * itstride; ok[i] = it < nitems; const int itc = ok[i] ? it : 0; const int row = itc, grp = 4; isq[i] = false;
        p[i] = proj + (size_t)row * LDP + (grp < 4 ? C_QB + 256 * grp : C_KB) + 4 * lane; pw[i] = pst + (size_t)(row & rmask) * LDP + (grp < 4 ? C_QB + 256 * grp : C_KB) + 4 * lane; u[i] = *(const u32x2*)p[i];
        const int t = row % T; const int pos = half ? (t & 63) : (t >> 6);
        c4[i] = *(const f32x4*)(tabc + pos * 16 + 4 * (within & 3)); s4[i] = *(const f32x4*)(tabs + pos * 16 + 4 * (within & 3)); }
    const f32x4 gq = *(const f32x4*)(qg + d0), gk = *(const f32x4*)(kg + d0);
#pragma unroll
    for (int i = 0; i < NB; ++i) {
        float x[4] = {bflo(u[i].x), bfhi(u[i].x), bflo(u[i].y), bfhi(u[i].y)};
        float ss = (x[0] * x[0] + x[1] * x[1]) + (x[2] * x[2] + x[3] * x[3]);
        ss += __shfl_xor(ss, 1); ss += __shfl_xor(ss, 2); ss += __shfl_xor(ss, 4); ss += __shfl_xor(ss, 8);
        const float rs = __builtin_amdgcn_rsqf(ss * (1.f / 64.f) + EPS);
        const f32x4 g4 = isq[i] ? gq : gk; const float sc = isq[i] ? C2 : 1.f;
        float o[4];
#pragma unroll
        for (int e = 0; e < 4; ++e) { const float xn = x[e] * rs * g4[e]; const float pr = __shfl_xor(xn, 4);
            o[e] = (first ? (xn * c4[i][e] - pr * s4[i][e]) : (xn * c4[i][e] + pr * s4[i][e])) * sc; }
        u32x2 w; w.x = pk2(o[0], o[1]); w.y = pk2(o[2], o[3]); if (ok[i]) *(u32x2*)pw[i] = w;
    }
}

constexpr int CH_CB = 36864, CH_OFFK = 17408, CH_OFFE = 17408 + 18432;
__device__ __forceinline__ void gla_chain(LAS unsigned char* lds, int ci, int nchunk, bf16_t* proj, const bf16_t* kltf, const bf16_t* kltb, const bf16_t* vtg, const float* ef, const float* eb, bf16_t* ob, bf16_t* of2, unsigned* done, bf16_t* dry = nullptr) {
    int tid = threadIdx.x; asm volatile("" : "+v"(tid));
    const int lane = tid & 63, wave = __builtin_amdgcn_readfirstlane(tid >> 6);
    const int dir = ci & 1, bh = ci >> 1, b = bh >> 2, h = bh & 3, l32 = lane & 31, hh = lane >> 5;
    const bf16_t* klt = dir ? kltb : kltf; const float* ee = dir ? eb : ef;
    const int qcol = (dir ? C_KA : C_QA) + h * 128;
    const int qt0 = tid >> 4, qc0 = tid & 15;
    const int kd0 = tid >> 3, kc0 = tid & 7;
    f32x16 S[4];
#pragma unroll
    for (int i = 0; i < 4; ++i) S[i] = f32x16{};
#define CH_GC(st) (b * nchunk + (dir ? (nchunk - 1 - (st)) : (st)))
#define CH_CLAMP(st) ((st) < nchunk ? (st) : nchunk - 1)
#define CH_LOAD_T(SET, st) do { const int gc_ = CH_GC(CH_CLAMP(st)); \
        q0##SET = *(const u32x4*)(proj + (size_t)(gc_ * 64 + qt0) * LDP + qcol + qc0 * 8); q1##SET = *(const u32x4*)(proj + (size_t)(gc_ * 64 + qt0 + 32) * LDP + qcol + qc0 * 8); \
        const bf16_t* kb_ = klt + (size_t)(gc_ * 4 + h) * 128 * 64; \
        k0##SET = *(const u32x4*)(kb_ + (size_t)kd0 * 64 + kc0 * 8); k1##SET = *(const u32x4*)(kb_ + (size_t)(kd0 + 64) * 64 + kc0 * 8); \
        if (tid < 32) en##SET = *(const f32x4*)(ee + (size_t)(gc_ * 4 + h) * 128 + tid * 4); } while (0)
#define CH_LOAD_V(SET, st) do { const int gc_ = CH_GC(CH_CLAMP(st)); _Pragma("unroll") for (int ks = 0; ks < 4; ++ks) vf##SET[ks] = *(const bf16x8*)(vtg + ((size_t)(gc_ * 4 + h) * 256 + 32 * wave + l32) * 64 + 16 * ks + 8 * hh); } while (0)
#define CH_STAGE(SET, buf) do { *(LAS u32x4*)((buf) + qt0 * 272 + qc0 * 16) = q0##SET; *(LAS u32x4*)((buf) + (qt0 + 32) * 272 + qc0 * 16) = q1##SET; \
        *(LAS u32x4*)((buf) + CH_OFFK + kd0 * 144 + kc0 * 16) = k0##SET; *(LAS u32x4*)((buf) + CH_OFFK + (kd0 + 64) * 144 + kc0 * 16) = k1##SET; \
        if (tid < 32) *(LAS f32x4*)((buf) + CH_OFFE + tid * 16) = en##SET; } while (0)
    u32x4 q0A, q1A, k0A, k1A, q0B, q1B, k0B, k1B; f32x4 enA = (f32x4){0.f, 0.f, 0.f, 0.f}, enB = enA; bf16x8 vfA[4], vfB[4];
    CH_LOAD_T(A, 0); CH_LOAD_V(A, 0);
    CH_STAGE(A, lds);
    CH_LOAD_T(B, 1); CH_LOAD_V(B, 1);
    __syncthreads();
#define CH_LDQ(bufi, blk_) do { _Pragma("unroll") for (int s_ = 0; s_ < 2; ++s_) _Pragma("unroll") for (int tb_ = 0; tb_ < 2; ++tb_) { \
        const LAS unsigned char* qp_ = cur + (32 * tb_ + l32) * 272 + (32 * (blk_) + 16 * s_ + 4 * hh) * 2; \
        const u32x2 lo_ = *(const LAS u32x2*)qp_, hi_ = *(const LAS u32x2*)(qp_ + 16); qv[bufi][s_][tb_] = (u32x4){lo_.x, lo_.y, hi_.x, hi_.y}; } } while (0)
#define CH_LDE(bufi, blk_) do { _Pragma("unroll") for (int g_ = 0; g_ < 4; ++g_) evv[bufi][g_] = *(const LAS f32x4*)(cur + CH_OFFE + (32 * (blk_) + 8 * g_ + 4 * hh) * 4); } while (0)
#define CH_LDK(bufi, blk_) do { _Pragma("unroll") for (int ks_ = 0; ks_ < 4; ++ks_) kfv[bufi][ks_] = *(const LAS bf16x8*)(cur + CH_OFFK + (32 * (blk_) + l32) * 144 + (16 * ks_ + 8 * hh) * 2); } while (0)
#define CH_STEP(st, CUR, NXT) do { \
        const int gc = CH_GC(st), row0 = gc * 64; \
        LAS unsigned char* cur = lds + ((st) & 1) * CH_CB; LAS unsigned char* nxt = lds + (((st) + 1) & 1) * CH_CB; \
        CH_LOAD_T(CUR, (st) + 2); \
        f32x16 ot[2]; ot[0] = f32x16{}; ot[1] = f32x16{}; \
        u32x4 qv[2][2][2]; bf16x8 kfv[2][4]; \
        CH_LDQ(0, 0); \
        _Pragma("unroll") for (int blk = 0; blk < 4; ++blk) { \
            if (blk < 3) { CH_LDQ((blk + 1) & 1, blk + 1); } else { CH_LDK(0, 0); } \
            __builtin_amdgcn_sched_barrier(0); \
            _Pragma("unroll") for (int s = 0; s < 2; ++s) { \
                u32x4 pa; pa.x = pk2(S[blk][8 * s + 0], S[blk][8 * s + 1]); pa.y = pk2(S[blk][8 * s + 2], S[blk][8 * s + 3]); pa.z = pk2(S[blk][8 * s + 4], S[blk][8 * s + 5]); pa.w = pk2(S[blk][8 * s + 6], S[blk][8 * s + 7]); \
                const bf16x8 sa = __builtin_bit_cast(bf16x8, pa); \
                _Pragma("unroll") for (int tb = 0; tb < 2; ++tb) ot[tb] = MFMA32(sa, __builtin_bit_cast(bf16x8, qv[blk & 1][s][tb]), ot[tb]); } \
            __builtin_amdgcn_sched_barrier(0); } \
        _Pragma("unroll") for (int blk = 0; blk < 4; ++blk) _Pragma("unroll") for (int g = 0; g < 4; ++g) { const f32x4 ev = *(const LAS f32x4*)(cur + CH_OFFE + (32 * blk + 8 * g + 4 * hh) * 4); \
            S[blk][4 * g] *= ev[0]; S[blk][4 * g + 1] *= ev[1]; S[blk][4 * g + 2] *= ev[2]; S[blk][4 * g + 3] *= ev[3]; } \
        __builtin_amdgcn_sched_barrier(0); \
        _Pragma("unroll") for (int blk = 0; blk < 4; ++blk) { \
            if (blk < 3) { CH_LDK((blk + 1) & 1, blk + 1); } \
            __builtin_amdgcn_sched_barrier(0); \
            _Pragma("unroll") for (int ks = 0; ks < 4; ++ks) S[blk] = MFMA32(kfv[blk & 1][ks], vf##CUR[ks], S[blk]); \
            __builtin_amdgcn_sched_barrier(0); } \
        CH_LOAD_V(CUR, (st) + 2); \
        { bf16_t* obase = dry ? dry : (dir ? ob : of2); const int rmk = dry ? 4095 : -1; \
          _Pragma("unroll") for (int tb = 0; tb < 2; ++tb) { bf16_t* op = obase + (size_t)((row0 + 32 * tb + l32) & rmk) * DM + h * 256 + 32 * wave + 4 * hh; \
            _Pragma("unroll") for (int g = 0; g < 4; ++g) { u32x2 w; w.x = pk2(ot[tb][4 * g], ot[tb][4 * g + 1]); w.y = pk2(ot[tb][4 * g + 2], ot[tb][4 * g + 3]); *(u32x2*)(op + 8 * g) = w; } } } \
        CH_STAGE(NXT, nxt); \
        LDS_BARRIER(); } while (0)
    for (int step = 0; step < nchunk; step += 2) {
        CH_STEP(step, A, B);
        CH_STEP(step + 1, B, A);
    }
    if (done) {
        asm volatile("s_waitcnt vmcnt(0)" ::: "memory");
        __syncthreads();
        if (tid == 0) { __builtin_amdgcn_fence(__ATOMIC_RELEASE, "agent"); asm volatile("s_waitcnt vmcnt(0)" ::: "memory"); (void)xb_add(done + 64 * b, 1u); }
    }
#undef CH_GC
#undef CH_CLAMP
#undef CH_LOAD_T
#undef CH_LOAD_V
#undef CH_STAGE
#undef CH_STEP
#undef CH_LDQ
#undef CH_LDE
#undef CH_LDK
}

template <int NB>
__device__ __forceinline__ void ua_items(bf16_t* proj, const bf16_t* ob, const bf16_t* of2, int it0, int itstride, const float* gn, int lane, bf16_t* pst, int rmask) {
    u32x2 a[NB], b[NB], f[NB], z[NB]; bf16_t* zp[NB]; bool ok[NB];
#pragma unroll
    for (int i = 0; i < NB; ++i) { const int itr = it0 + i * itstride; ok[i] = itr < NTOK * 4; const int it = ok[i] ? itr : 0, row = it >> 2, h = it & 3;
        a[i] = *(const u32x2*)(proj + (size_t)row * LDP + C_VA + h * 256 + 4 * lane); b[i] = *(const u32x2*)(ob + (size_t)row * DM + h * 256 + 4 * lane); f[i] = *(const u32x2*)(of2 + (size_t)row * DM + h * 256 + 4 * lane);
        zp[i] = pst + (size_t)(row & rmask) * LDP + C_ZA + h * 256 + 4 * lane; z[i] = *(const u32x2*)(proj + (size_t)row * LDP + C_ZA + h * 256 + 4 * lane); }
    const f32x4 g4 = *(const f32x4*)(gn + 4 * lane);
#pragma unroll
    for (int i = 0; i < NB; ++i) {
        float o[4] = {bflo(a[i].x) + bflo(b[i].x) + bflo(f[i].x), bfhi(a[i].x) + bfhi(b[i].x) + bfhi(f[i].x), bflo(a[i].y) + bflo(b[i].y) + bflo(f[i].y), bfhi(a[i].y) + bfhi(b[i].y) + bfhi(f[i].y)};
        const float ss = wave_sum((o[0] * o[0] + o[1] * o[1]) + (o[2] * o[2] + o[3] * o[3]));
        const float rs = __builtin_amdgcn_rsqf(ss * (1.f / 256.f) + EPS);
        u32x2 w; w.x = pk2(o[0] * rs * g4[0] * silu(bflo(z[i].x)), o[1] * rs * g4[1] * silu(bfhi(z[i].x))); w.y = pk2(o[2] * rs * g4[2] * silu(bflo(z[i].y)), o[3] * rs * g4[3] * silu(bfhi(z[i].y)));
        if (ok[i]) *(u32x2*)zp[i] = w;
    }
}

__global__ void __launch_bounds__(512, 2) hybrid_fwd(Args args) {
    extern __shared__ __attribute__((aligned(16))) unsigned char lds[];
    LAS unsigned char* L = (LAS unsigned char*)lds;
    volatile LAS int* MISC = (volatile LAS int*)(L + MISC_OFF);
    cg::grid_group grid = cg::this_grid();
    if (threadIdx.x < 32) MISC[threadIdx.x] = 0;
    __syncthreads();
    const XcdBarrier xbar = xcd_barrier_post((unsigned*)(args.ws + WS_CTL) + 4096, (volatile LAS unsigned*)(MISC + 8));
    for (int ph = args.ph_lo; ph < args.ph_hi; ++ph) {
        int tid = threadIdx.x; asm volatile("" : "+v"(tid));
        const int lane = tid & 63, wave = __builtin_amdgcn_readfirstlane(tid >> 6);
        int G = gridDim.x, bid = blockIdx.x; asm volatile("" : "+s"(G), "+s"(bid));
        const int gw = bid * 8 + wave, ngw = G * 8;
        size_t zoff = 0; asm volatile("" : "+s"(zoff));
        unsigned char* ws = args.ws + zoff;
#define AIN(i) (args.in[i])
        float* aout = args.out;
        unsigned* ctl = (unsigned*)(ws + WS_CTL);
        float* tabc = (float*)(ws + WS_TAB); float* tabs = tabc + 1024;
        bf16_t* WIN = (bf16_t*)(ws + WS_WIN); bf16_t* WBR = (bf16_t*)(ws + WS_WBR); bf16_t* WOUT = (bf16_t*)(ws + WS_WOUT);
        bf16_t* proj = (bf16_t*)(ws + WS_PROJ); bf16_t* xb = (bf16_t*)(ws + WS_XB); float* ssp = (float*)(ws + WS_SSP);
        float* ef = (float*)(ws + WS_EF); float* eb = (float*)(ws + WS_EB);
        bf16_t* kltf = (bf16_t*)(ws + WS_KLTF); bf16_t* kltb = (bf16_t*)(ws + WS_KLTB); bf16_t* vtg = (bf16_t*)(ws + WS_VT); bf16_t* of2 = (bf16_t*)(ws + WS_OF2);
        if (ph == 0) {
          {
            LAS float* scr = (LAS float*)(L + wave * 16384);
            for (int it = gw; it < CV_ITEMS; it += ngw) convert_item(args, 0, it, WIN, WBR, WOUT, scr, lane);
            for (int i = bid * 512 + tid; i < DEPTH * 224 * 128; i += G * 512) { const int l = i / (224 * 128), r = i % (224 * 128);
                *(u32x4*)(WIN + (size_t)l * WIN_L + (size_t)IN_DIM * DM + (size_t)r * 8) = (u32x4){0u, 0u, 0u, 0u}; }
            for (int i = bid * 512 + tid; i < 1024; i += G * 512) { const int pos = i >> 4, fi = i & 15;
                const float inv = __builtin_amdgcn_exp2f(-(float)fi * (13.287712379549449f / 16.f)); const float ang = (float)pos * inv;
                float rev = ang * 0.15915494309189535f; rev -= floorf(rev);
                tabc[i] = __builtin_amdgcn_cosf(rev); tabs[i] = __builtin_amdgcn_sinf(rev); }
            x_rows_to_bf16(AIN(0), xb, ssp, gw, ngw, lane);
          }
        } else if (ph == 25 || ph == 50) {
            const int grp = ph == 50; float* xo = aout + (size_t)grp * NTOK * DM; const float* gf = AIN(14);
            for (int m0 = gw; m0 < NTOK; m0 += 2 * ngw) { const int m1 = (m0 + ngw < NTOK) ? m0 + ngw : m0;
                f32x4* xr0 = (f32x4*)(xo + (size_t)m0 * DM) + lane; f32x4* xr1 = (f32x4*)(xo + (size_t)m1 * DM) + lane; f32x4 v0[4], v1[4]; float s0 = 0.f, s1 = 0.f;
#pragma unroll
                for (int j = 0; j < 4; ++j) { v0[j] = xr0[64 * j]; v1[j] = xr1[64 * j]; }
#pragma unroll
                for (int j = 0; j < 4; ++j) { s0 += (v0[j].x * v0[j].x + v0[j].y * v0[j].y) + (v0[j].z * v0[j].z + v0[j].w * v0[j].w); s1 += (v1[j].x * v1[j].x + v1[j].y * v1[j].y) + (v1[j].z * v1[j].z + v1[j].w * v1[j].w); }
                const float rs0 = __builtin_amdgcn_rsqf(wave_sum(s0) * (1.f / 1024.f) + EPS), rs1 = __builtin_amdgcn_rsqf(wave_sum(s1) * (1.f / 1024.f) + EPS);
#pragma unroll
                for (int j = 0; j < 4; ++j) { const f32x4 g4 = *((const f32x4*)gf + lane + 64 * j); xr0[64 * j] = v0[j] * rs0 * g4; if (m1 != m0) xr1[64 * j] = v1[j] * rs1 * g4; } }
            if (grp == 0) x_rows_to_bf16(AIN(1), xb, ssp, gw, ngw, lane);
        } else {
            const int q = (ph < 25) ? ph - 1 : ph - 26; const int grp = ph > 25, l = q / 6, sub = q % 6;
            const int T = grp ? 2048 : 4096, nB = grp ? 8 : 4, nchunk = T / 64;
            float* xres = aout + (size_t)grp * NTOK * DM;
            if (sub == 0) {
                pg8::Gemm g{xb, WIN + (size_t)l * WIN_L, DM, DM, DM, 0}; pg8::StaticOrder S; S.init(NTOK, LDP, G, bid);
                pg8::EpiProj E{proj, ssp};
                pg8::gemm_phase<pg8::EpiProj>(L, g, S, E);
            } else if (sub == 1) {
                { PrepIn pin; gla_prep_load(pin, proj, bid >> 2, bid & 3); PrepW pw; int hcur = bid & 3; gla_prep_loadw(pw, AIN(4) + (size_t)l * 16 * 512, AIN(5) + l * 512, AIN(6) + (size_t)l * 16 * 512, AIN(7) + l * 512, hcur);
                  for (int tile = bid; tile < 1024; tile += G) { PrepIn pnx; const int tn = (tile + G < 1024) ? tile + G : tile; gla_prep_load(pnx, proj, tn >> 2, tn & 3);
                    if ((tile & 3) != hcur) { hcur = tile & 3; gla_prep_loadw(pw, AIN(4) + (size_t)l * 16 * 512, AIN(5) + l * 512, AIN(6) + (size_t)l * 16 * 512, AIN(7) + l * 512, hcur); }
                    gla_prep_tile(L, pin, pw, tile >> 2, tile & 3, proj, ef, eb, kltf, kltb, vtg, proj, -1);
                    pin = pnx; } }
                for (int it = gw; it < NTOK; it += 8 * ngw) qk_norm_items<8>(proj, it, ngw, NTOK, T, AIN(9) + l * 64, AIN(10) + l * 64, tabc, tabs, lane, proj, -1);
            } else if (sub == 2) {
                const int nchain = nB * 4 * 2, nqb = T / 256, natt = nB * 16 * nqb, nua = NTOK * 4 / 64, ncv = (grp == 0 && l < 3) ? (CV_ITEMS + 7) / 8 : 0, total = nchain + natt + nua + ncv;
                unsigned* done = ctl + 8192 + 64 * ((grp * 4 + l) * 8);
                if (tid == 0) MISC[2] = 0;
                unsigned* ctr = ctl + 64 * (grp * 4 + l);
                if (tid == 0) MISC[0] = (int)atomicAdd(ctr, 1u);
                for (;;) {
                    __syncthreads();
                    const int idx = MISC[0];
                    __syncthreads();
                    if (idx >= total) break;
                    int nxti = 0; if (tid == 0) nxti = (int)atomicAdd(ctr, 1u);
                    if (idx >= nchain + natt && idx < nchain + natt + nua) {
                        const int j = idx - nchain - natt, bq = (j * 16) / T;
                        if (tid == 0 && !((MISC[2] >> bq) & 1)) {
                            unsigned sp = 0; while (xb_ld(done + 64 * bq) < 8u) { __builtin_amdgcn_s_sleep(2); if (++sp > (1u << 24)) break; }
                            __builtin_amdgcn_fence(__ATOMIC_ACQUIRE, "agent"); asm volatile("s_waitcnt vmcnt(0)" ::: "memory");
                            MISC[2] = MISC[2] | (1 << bq); }
                        __syncthreads();
                        { int ln = threadIdx.x; asm volatile("" : "+v"(ln)); const int wv = __builtin_amdgcn_readfirstlane(ln >> 6); ln &= 63;
                          ua_items<8>(proj, xb, of2, 64 * j + wv, 8, AIN(8) + l * 256, ln, proj, -1); }
                        if (tid == 0) MISC[0] = nxti; continue; }
                    if (idx >= nchain + natt + nua) { int ln = threadIdx.x; asm volatile("" : "+v"(ln)); const int wv = __builtin_amdgcn_readfirstlane(ln >> 6); ln &= 63; const int r = (idx - nchain - natt - nua) * 8 + wv; if (r < CV_ITEMS) convert_item(args, l + 1, r, WIN, WBR, WOUT, (LAS float*)(L + wv * 16384), ln); if (tid == 0) MISC[0] = nxti; continue; }
                    if (idx < nchain) gla_chain(L, idx, nchunk, proj, kltf, kltb, vtg, ef, eb, xb, of2, done);
                    else
                    {
 const int u = idx - nchain; const int g4 = u & 3, qb = (u >> 2) % nqb, bk = (u >> 2) / nqb, kvh = bk & 3, b = bk >> 2, hq = kvh * 4 + g4;
                        const size_t rb = (size_t)b * T;
                        attn_body::attn_unit<8>((const attn_body::bf16*)(proj + (rb + (size_t)qb * 256) * LDP + C_QB + hq * 64), (const attn_body::bf16*)(proj + rb * LDP + C_KB + kvh * 64),
                                                (const attn_body::bf16*)(proj + rb * LDP + C_VB + kvh * 64), (attn_body::bf16*)(proj + (rb + (size_t)qb * 256) * LDP + C_ZB + hq * 64), T / 64, (char*)lds, AIN(9) + l * 64, tabc, tabs, qb * 256);
                    }
                    if (tid == 0) MISC[0] = nxti;
                }
            } else if (sub == 3) {
            } else if (sub == 4) {
                pg8::StaticOrder S; S.init(NTOK, DM, G, bid);
                { pg8::Gemm g{proj + C_ZA, WBR + (size_t)l * DM * 2048, LDP, 2048, DM, 2048}; pg8::PairOrder S2{S}; pg8::EpiBranchPair E{proj};
                  pg8::gemm_phase<pg8::EpiBranchPair, true, pg8::PairOrder>(L, g, S2, E); }
            } else {
                pg8::Gemm g{proj + C_MA, WOUT + (size_t)l * DM * DM, LDP, DM, DM, 0}; pg8::StaticOrder S; S.init(NTOK, DM, G, bid);
                pg8::EpiOut E{l == 0 ? AIN(grp) : xres, xres, xb, ssp, -1};
                pg8::gemm_phase<pg8::EpiOut>(L, g, S, E);
            }
        }
        { const int qq = (ph < 25) ? ph - 1 : ph - 26; const bool empty = ph != 0 && ph != 25 && ph != 50 && (qq % 6) == 3;
          if (ph + 1 < args.ph_hi && !empty) { if (args.ph_hi > NPHASE) grid.sync(); else xcd_barrier(xbar); } }
    }
}

extern "C" void kernel_launch(void* const* d_in, const int* in_sizes, int n_in, void* d_out, int out_size, void* d_ws, size_t ws_size, hipStream_t stream) {
    static int grid = 0;
    if (grid == 0) {
        if (n_in != 15 || ws_size < WS_END || out_size != 2 * NTOK * DM) { fprintf(stderr, "kernel_launch: unexpected shapes (n_in %d, ws %zu, out %d)\n", n_in, ws_size, out_size); grid = -1; return; }
        if (hipFuncSetAttribute((const void*)hybrid_fwd, hipFuncAttributeMaxDynamicSharedMemorySize, LDS_BYTES) != hipSuccess) { fprintf(stderr, "kernel_launch: hipFuncSetAttribute failed\n"); grid = -1; return; }
        int dev = 0, cus = 0, per_cu = 0;
        hipGetDevice(&dev); hipDeviceGetAttribute(&cus, hipDeviceAttributeMultiprocessorCount, dev);
        hipOccupancyMaxActiveBlocksPerMultiprocessor(&per_cu, (const void*)hybrid_fwd, 512, LDS_BYTES);
        if (per_cu < 1) { fprintf(stderr, "kernel_launch: occupancy query says %d blocks per CU\n", per_cu); (void)hipGetLastError(); }
        grid = cus;
    }
    if (grid < 0) return;
    (void)hipMemsetAsync((char*)d_ws + WS_CTL, 0, CTL_BYTES, stream);
    Args a{};
    for (int i = 0; i < 15; ++i) a.in[i] = (const float*)d_in[i];
    a.out = (float*)d_out; a.ws = (unsigned char*)d_ws; a.ph_lo = 0; a.ph_hi = NPHASE;
    void* kargs[] = {&a};
    hipError_t e = hipLaunchCooperativeKernel((const void*)hybrid_fwd, dim3(grid), dim3(512), kargs, LDS_BYTES, stream);
    if (e != hipSuccess) fprintf(stderr, "kernel_launch: cooperative launch failed: %s (grid %d)\n", hipGetErrorString(e), grid);
}
```

```cpp
#include <hip/hip_runtime.h>
#include <hip/hip_cooperative_groups.h>
#include <hip/hip_bf16.h>
#include <cstdio>
#include <cstdint>
#include <cmath>
namespace cg = cooperative_groups;

#define LAS __attribute__((address_space(3)))
#define GAS __attribute__((address_space(1)))
typedef unsigned short bf16_t;
typedef short bf16x8 __attribute__((ext_vector_type(8)));
typedef float f32x4 __attribute__((ext_vector_type(4)));
typedef float f32x2 __attribute__((ext_vector_type(2)));
typedef float f32x16 __attribute__((ext_vector_type(16)));
typedef unsigned u32x4 __attribute__((ext_vector_type(4)));
typedef unsigned u32x2 __attribute__((ext_vector_type(2)));
typedef __bf16 bf16x2_t __attribute__((ext_vector_type(2)));

constexpr int DM = 1024, NTOK = 16384, DEPTH = 4, IN_DIM = 7712, LDP = 7936;
constexpr int C_QA = 0, C_KA = 512, C_VA = 1024, C_QB = 2048, C_KB = 3072, C_VB = 3328, C_ZA = 3584, C_ZB = 4608, C_MA = 5632, C_MB = 6656, C_GL = 7680;
constexpr float EPS = 1e-6f;
constexpr float C2 = 0.125f * 1.4426950408889634f;
constexpr float LN2 = 0.6931471805599453f, LOG2E = 1.4426950408889634f;

constexpr size_t MiB = 1u << 20;
constexpr size_t WS_CTL = 0, CTL_BYTES = 65536;
constexpr size_t WS_TAB = 1 * MiB;
constexpr size_t WS_WIN = 2 * MiB;
constexpr size_t WIN_L = (size_t)LDP * 1024;
constexpr size_t WS_WBR = 64 * MiB;
constexpr size_t WS_WOUT = 80 * MiB;
constexpr size_t WS_PROJ = 88 * MiB;
constexpr size_t WS_XB = 336 * MiB;
constexpr size_t WS_SSP = 368 * MiB;
constexpr size_t WS_EF = 369 * MiB;
constexpr size_t WS_EB = WS_EF + 512 * 1024;
constexpr size_t WS_KLTF = 370 * MiB;
constexpr size_t WS_KLTB = 386 * MiB;
constexpr size_t WS_VT = 402 * MiB;
constexpr size_t WS_OF2 = 434 * MiB;
constexpr size_t WS_END = 466 * MiB;

constexpr int LDS_BYTES = 147456, RING_BYTES = 131072, MISC_OFF = 131072 + 512;
constexpr int NPHASE = 51;

__device__ __forceinline__ unsigned pk2(float lo, float hi) { f32x2 v = {lo, hi}; bf16x2_t b = __builtin_convertvector(v, bf16x2_t); return __builtin_bit_cast(unsigned, b); }
__device__ __forceinline__ float bflo(unsigned u) { return __builtin_bit_cast(float, u << 16); }
__device__ __forceinline__ float bfhi(unsigned u) { return __builtin_bit_cast(float, u & 0xffff0000u); }
__device__ __forceinline__ float bf2f(bf16_t v) { return __builtin_bit_cast(float, ((unsigned)v) << 16); }
__device__ __forceinline__ bf16_t f2bf(float f) { return (bf16_t)(pk2(f, 0.f) & 0xffffu); }
__device__ __forceinline__ float fexp(float x) { return __builtin_amdgcn_exp2f(x * LOG2E); }
__device__ __forceinline__ float sigm(float x) { return __builtin_amdgcn_rcpf(1.f + fexp(-x)); }
__device__ __forceinline__ float silu(float x) { return x * sigm(x); }
__device__ __forceinline__ float logsig(float z) { return fminf(z, 0.f) - LN2 * __builtin_amdgcn_logf(1.f + fexp(-fabsf(z))); }
__device__ __forceinline__ int crow(int r, int hi) { return (r & 3) + 8 * (r >> 2) + 4 * hi; }
#define LDS_BARRIER() do { asm volatile("s_waitcnt lgkmcnt(0)" ::: "memory"); __builtin_amdgcn_s_barrier(); } while (0)
#define MFMA32(a, b, c) __builtin_amdgcn_mfma_f32_32x32x16_bf16((a), (b), (c), 0, 0, 0)

namespace pg8 {
constexpr int BM = 256, BK = 64, HALF = 128, HTB = HALF * BK * 2, NXCD = 8, WGM = 8;
__host__ __device__ __forceinline__ int lds_byte(int r, int c) { const int st = (r >> 4) * 2 + (c >> 5), rr = r & 15, cc = c & 31, ob = rr * 64 + cc * 2; return st * 1024 + (ob ^ (((ob >> 9) & 1) << 5)); }
__host__ __device__ __forceinline__ void stage_rc(int b, int& R, int& C) { const int st = b / 1024, sb = b % 1024, swz = sb ^ (((sb >> 9) & 1) << 5); R = (st >> 1) * 16 + swz / 64; C = (st & 1) * 32 + (swz % 64) / 2; }
__host__ __device__ __forceinline__ int perm32(int rho) { const int n = rho >> 4, i = rho & 15; return 8 * (i >> 2) + 4 * n + (i & 3); }
struct Unit { int pm, pn, sel; };
struct Gemm { const bf16_t* A; const bf16_t* Bt; int lda, ldb, K; int selstep; };
struct StaticOrder {
    int nM, nN, nwg, G, c;
    __device__ void init(int M, int N, int G_, int c_) { nM = M / BM; nN = N / BM; nwg = nM * nN; G = G_; c = c_; }
    __device__ bool next(int i, Unit& u) const {
        const long L = (long)i * G + c; if (L >= nwg) return false;
        int wgid = (int)L; { const int q = nwg / NXCD, r = nwg % NXCD, xcd = wgid % NXCD, off = wgid / NXCD; wgid = (xcd < r ? xcd * (q + 1) : r * (q + 1) + (xcd - r) * q) + off; }
        const int nig = WGM * nN, gid = wgid / nig, fm = gid * WGM, gsz = (nM - fm) < WGM ? (nM - fm) : WGM;
        u.pm = fm + ((wgid % nig) % gsz); u.pn = (wgid % nig) / gsz; u.sel = 0; return true;
    }
};
struct PairOrder {
    StaticOrder b;
    __device__ bool next(int i, Unit& u) const { const bool ok = b.next(i >> 1, u); u.sel = i & 1; return ok; }
};
template <class Epi, bool ALIGN_EPI = true, class Sched = StaticOrder>
__device__ __forceinline__ void gemm_phase(LAS unsigned char* lds, const Gemm g, const Sched& S, const Epi& E) {
    int tid = threadIdx.x; asm volatile("" : "+v"(tid));
    const int wid = __builtin_amdgcn_readfirstlane(tid >> 6), lane = tid & 63, wr = wid >> 2, wc = wid & 3, fr = lane & 15, fq = lane >> 4;
    const int K = g.K, nt = K / BK;
    unsigned voffA[2], voffB[2];
#pragma unroll
    for (int i = 0; i < 2; ++i) { int R, C; stage_rc(tid * 16 + i * 8192, R, C); const int Rb = (R & ~31) + perm32(R & 31);
        voffA[i] = (unsigned)(R * g.lda + C) * 2u; voffB[i] = (unsigned)(Rb * g.ldb + C) * 2u; }
    const size_t kstep = (size_t)(BK * 2);
    const size_t hstepA = (size_t)HALF * g.lda * 2, hstepB = (size_t)HALF * g.ldb * 2;
    const size_t tstepA = 2 * hstepA, tstepB = 2 * hstepB;
    const unsigned ldsw = (unsigned)wid * 1024u;
    const int aoff = lds_byte(wr * 64 + fr, fq * 8), boff = lds_byte(wc * 32 + fr, fq * 8);
#define PG8_SA(b, h) (((b) * 2 + (h)) * HTB)
#define PG8_SB(b, h) ((4 + (b) * 2 + (h)) * HTB)
#define PG8_STAGE(bufoff, gbase, voff) do { _Pragma("unroll") for (int _i = 0; _i < 2; ++_i) \
        __builtin_amdgcn_global_load_lds((const unsigned*)((const char*)(gbase) + (voff)[_i]), (LAS unsigned*)(lds + (bufoff) + ldsw + _i * 8192), 16, 0, 0); } while (0)
#define PG8_LDA(dst, b, h) do { _Pragma("unroll") for (int m = 0; m < 4; ++m) _Pragma("unroll") for (int k = 0; k < 2; ++k) dst[m][k] = *(const LAS bf16x8*)(lds + PG8_SA(b, h) + aoff + m * 2048 + k * 1024); } while (0)
#define PG8_LDB(dst, b, h) do { _Pragma("unroll") for (int n = 0; n < 2; ++n) _Pragma("unroll") for (int k = 0; k < 2; ++k) dst[n][k] = *(const LAS bf16x8*)(lds + PG8_SB(b, h) + boff + n * 2048 + k * 1024); } while (0)
#define PG8_MMA(ai, bj, At, Bt) do { __builtin_amdgcn_s_setprio(1); _Pragma("unroll") for (int m = 0; m < 4; ++m) _Pragma("unroll") for (int n = 0; n < 2; ++n) _Pragma("unroll") for (int k = 0; k < 2; ++k) \
        acc[ai][bj][m][n] = __builtin_amdgcn_mfma_f32_16x16x32_bf16(Bt[n][k], At[m][k], acc[ai][bj][m][n], 0, 0, 0); __builtin_amdgcn_s_setprio(0); } while (0)
#define PG8_WAIT_V(n) asm volatile("s_waitcnt vmcnt(" #n ")" ::: "memory")
#define PG8_WAIT_L(n) asm volatile("s_waitcnt lgkmcnt(" #n ")" ::: "memory")
#define PG8_BAR __builtin_amdgcn_s_barrier()
#define PG8_SCHED __builtin_amdgcn_sched_barrier(0)
    Unit cur, nxt; int ui = 0;
    if (!S.next(0, cur)) return;
    f32x4 acc[2][2][4][2];
#pragma unroll
    for (int a = 0; a < 2; ++a)
#pragma unroll
        for (int b = 0; b < 2; ++b)
#pragma unroll
            for (int m = 0; m < 4; ++m)
#pragma unroll
                for (int n = 0; n < 2; ++n) acc[a][b][m][n] = (f32x4){0.f, 0.f, 0.f, 0.f};
    bf16x8 At[4][2], B0[2][2], B1[2][2];
    const char* cA = (const char*)g.A + (size_t)cur.pm * tstepA + (size_t)cur.sel * g.selstep; const char* cB = (const char*)g.Bt + (size_t)cur.pn * tstepB + (size_t)cur.sel * g.selstep;
    PG8_STAGE(PG8_SB(0, 0), cB, voffB); PG8_STAGE(PG8_SB(0, 1), cB + hstepB, voffB); PG8_STAGE(PG8_SA(0, 0), cA, voffA); PG8_STAGE(PG8_SA(0, 1), cA + hstepA, voffA);
    if (wr == 1) PG8_BAR;
    PG8_WAIT_V(2); PG8_BAR;
    PG8_STAGE(PG8_SB(1, 0), cB + kstep, voffB); PG8_STAGE(PG8_SA(1, 0), cA + kstep, voffA); PG8_STAGE(PG8_SB(1, 1), cB + hstepB + kstep, voffB);
    PG8_WAIT_V(6); PG8_BAR;
    for (;;) {
        const bool has_next = S.next(ui + 1, nxt);
        const char* nA = has_next ? (const char*)g.A + (size_t)nxt.pm * tstepA + (size_t)nxt.sel * g.selstep : cA; const char* nB = has_next ? (const char*)g.Bt + (size_t)nxt.pn * tstepB + (size_t)nxt.sel * g.selstep : cB;
        for (int t = 0; t < nt; t += 2) {
            const bool last = (t == nt - 2);
            const char* a1 = cA + (size_t)(t + 1) * kstep;
            const char* a2 = last ? nA : cA + (size_t)(t + 2) * kstep; const char* b2 = last ? nB : cB + (size_t)(t + 2) * kstep;
            const char* a3 = a2 + kstep; const char* b3 = b2 + kstep;
            PG8_LDB(B0, 0, 0); PG8_LDB(B1, 0, 1); PG8_SCHED; PG8_LDA(At, 0, 0); PG8_STAGE(PG8_SA(1, 1), a1 + hstepA, voffA);
            PG8_WAIT_V(8); PG8_WAIT_L(0); PG8_BAR; PG8_MMA(0, 0, At, B0); PG8_MMA(0, 1, At, B1); PG8_BAR; PG8_SCHED;
            PG8_LDA(At, 0, 1); PG8_STAGE(PG8_SB(0, 0), b2, voffB); PG8_STAGE(PG8_SB(0, 1), b2 + hstepB, voffB); PG8_STAGE(PG8_SA(0, 0), a2, voffA);
            PG8_WAIT_V(8); PG8_WAIT_L(0); PG8_BAR; PG8_MMA(1, 0, At, B0); PG8_MMA(1, 1, At, B1); PG8_BAR; PG8_SCHED;
            PG8_LDB(B0, 1, 0); PG8_LDB(B1, 1, 1); PG8_SCHED; PG8_LDA(At, 1, 0); PG8_STAGE(PG8_SA(0, 1), a2 + hstepA, voffA);
            PG8_WAIT_V(8); PG8_WAIT_L(0); PG8_BAR; PG8_MMA(0, 0, At, B0); PG8_MMA(0, 1, At, B1); PG8_BAR; PG8_SCHED;
            PG8_LDA(At, 1, 1); PG8_STAGE(PG8_SB(1, 0), b3, voffB); PG8_STAGE(PG8_SB(1, 1), b3 + hstepB, voffB); PG8_STAGE(PG8_SA(1, 0), a3, voffA);
            PG8_WAIT_V(8); PG8_WAIT_L(0); PG8_BAR; PG8_MMA(1, 0, At, B0); PG8_MMA(1, 1, At, B1); PG8_BAR; PG8_SCHED;
        }
        if constexpr (ALIGN_EPI) { if (wr == 0) PG8_BAR; }
        E(acc, cur, wr, wc, fr, fq);
        if (!has_next) break;
#pragma unroll
        for (int a = 0; a < 2; ++a)
#pragma unroll
            for (int b = 0; b < 2; ++b)
#pragma unroll
                for (int m = 0; m < 4; ++m)
#pragma unroll
                    for (int n = 0; n < 2; ++n) acc[a][b][m][n] = (f32x4){0.f, 0.f, 0.f, 0.f};
        cur = nxt; cA = nA; cB = nB; ++ui;
        if constexpr (ALIGN_EPI) { if (wr == 1) PG8_BAR; }
    }
    PG8_WAIT_V(0);
    if constexpr (!ALIGN_EPI) { if (wr == 0) PG8_BAR; }
    PG8_BAR;
#undef PG8_SA
#undef PG8_SB
#undef PG8_STAGE
#undef PG8_LDA
#undef PG8_LDB
#undef PG8_MMA
#undef PG8_WAIT_V
#undef PG8_WAIT_L
#undef PG8_BAR
#undef PG8_SCHED
}

struct EpiProj {
    bf16_t* O; const float* ssp;
    __device__ __forceinline__ void operator()(const f32x4 (&acc)[2][2][4][2], const Unit& u, int wr, int wc, int fr, int fq) const {
        const int row0 = u.pm * BM + wr * 64 + fr, col0 = u.pn * BM + wc * 32 + 8 * fq;
#pragma unroll
        for (int ai = 0; ai < 2; ++ai)
#pragma unroll
            for (int m = 0; m < 4; ++m) {
                const int row = row0 + ai * HALF + m * 16;
                const f32x4* sp = (const f32x4*)(ssp + (size_t)row * 16);
                const f32x4 s4 = (sp[0] + sp[1]) + (sp[2] + sp[3]);
                const float rs = __builtin_amdgcn_rsqf(((s4[0] + s4[1]) + (s4[2] + s4[3])) * (1.f / 1024.f) + EPS);
                bf16_t* rowp = O + (size_t)row * LDP + col0;
#pragma unroll
                for (int bj = 0; bj < 2; ++bj) { const f32x4 v0 = acc[ai][bj][m][0] * rs, v1 = acc[ai][bj][m][1] * rs;
                    u32x4 w; w.x = pk2(v0[0], v0[1]); w.y = pk2(v0[2], v0[3]); w.z = pk2(v1[0], v1[1]); w.w = pk2(v1[2], v1[3]);
                    *(u32x4*)(rowp + bj * HALF) = w; }
            }
    }
};
template <int SECOND> struct EpiBranch {
    bf16_t* P; bf16_t* W; int rmask;
    __device__ __forceinline__ void operator()(const f32x4 (&acc)[2][2][4][2], const Unit& u, int wr, int wc, int fr, int fq) const {
        const int row0 = u.pm * BM + wr * 64 + fr, col0 = u.pn * BM + wc * 32 + 8 * fq;
#pragma unroll
        for (int ai = 0; ai < 2; ++ai)
#pragma unroll
            for (int m = 0; m < 4; ++m) {
                bf16_t* rowp = P + (size_t)(row0 + ai * HALF + m * 16) * LDP + col0; bf16_t* roww = W + (size_t)((row0 + ai * HALF + m * 16) & rmask) * LDP + col0;
#pragma unroll
                for (int bj = 0; bj < 2; ++bj) {
                    const u32x4 a = *(const u32x4*)(rowp + C_MA + bj * HALF);
                    float ma[8] = {bflo(a.x), bfhi(a.x), bflo(a.y), bfhi(a.y), bflo(a.z), bfhi(a.z), bflo(a.w), bfhi(a.w)};
                    float o[8];
                    if (SECOND) {
                        const u32x4 b = *(const u32x4*)(rowp + C_MB + bj * HALF);
                        float mb[8] = {bflo(b.x), bfhi(b.x), bflo(b.y), bfhi(b.y), bflo(b.z), bfhi(b.z), bflo(b.w), bfhi(b.w)};
#pragma unroll
                        for (int e = 0; e < 8; ++e) o[e] = ma[e] + acc[ai][bj][m][e >> 2][e & 3] * sigm(mb[e]);
                    } else {
#pragma unroll
                        for (int e = 0; e < 8; ++e) o[e] = acc[ai][bj][m][e >> 2][e & 3] * sigm(ma[e]);
                    }
                    u32x4 w; w.x = pk2(o[0], o[1]); w.y = pk2(o[2], o[3]); w.z = pk2(o[4], o[5]); w.w = pk2(o[6], o[7]);
                    *(u32x4*)(roww + C_MA + bj * HALF) = w;
                }
            }
    }
};
struct EpiBranchPair {
    bf16_t* P;
    __device__ __forceinline__ void operator()(const f32x4 (&acc)[2][2][4][2], const Unit& u, int wr, int wc, int fr, int fq) const {
        if (u.sel == 0) { EpiBranch<0> e{P, P, -1}; e(acc, u, wr, wc, fr, fq); } else { EpiBranch<1> e{P, P, -1}; e(acc, u, wr, wc, fr, fq); }
    }
};
struct EpiOut {
    const float* xold; float* xnew; bf16_t* xb; float* ssp; int rmask;
    __device__ __forceinline__ void operator()(const f32x4 (&acc)[2][2][4][2], const Unit& u, int wr, int wc, int fr, int fq) const {
        const int row0 = u.pm * BM + wr * 64 + fr, col0 = u.pn * BM + wc * 32 + 8 * fq;
#pragma unroll
        for (int ai = 0; ai < 2; ++ai)
#pragma unroll
            for (int m = 0; m < 4; ++m) {
                const int row = row0 + ai * HALF + m * 16;
                float ss = 0.f;
#pragma unroll
                for (int bj = 0; bj < 2; ++bj) {
                    const size_t off = (size_t)row * DM + col0 + bj * HALF, offw = (size_t)(row & rmask) * DM + col0 + bj * HALF;
                    const f32x4 x0 = *(const f32x4*)(xold + off), x1 = *(const f32x4*)(xold + off + 4);
                    const f32x4 v0 = x0 + acc[ai][bj][m][0], v1 = x1 + acc[ai][bj][m][1];
                    *(f32x4*)(xnew + offw) = v0; *(f32x4*)(xnew + offw + 4) = v1;
                    u32x4 w; w.x = pk2(v0[0], v0[1]); w.y = pk2(v0[2], v0[3]); w.z = pk2(v1[0], v1[1]); w.w = pk2(v1[2], v1[3]);
                    *(u32x4*)(xb + offw) = w;
                    ss += (v0[0] * v0[0] + v0[1] * v0[1]) + (v0[2] * v0[2] + v0[3] * v0[3]) + (v1[0] * v1[0] + v1[1] * v1[1]) + (v1[2] * v1[2] + v1[3] * v1[3]);
                }
                ss += __shfl_xor(ss, 16); ss += __shfl_xor(ss, 32);
                if (fq == 0) ssp[(size_t)(row & rmask) * 16 + u.pn * 4 + wc] = ss;
            }
    }
};
}

namespace attn_body {
using bf16 = __hip_bfloat16;
using s16x4 = __attribute__((ext_vector_type(4))) short;
constexpr int D = 64, P = LDP;
constexpr int NW = 8, QBLK = 32, QB = QBLK * NW, KVBLK = 64;
#define SBAR() __builtin_amdgcn_sched_barrier(0)
constexpr int NSLOT = 3, SLOTB = 8192;
constexpr int LDS_K = 0, LDS_V = NSLOT * SLOTB, LDS_WS = 2 * NSLOT * SLOTB, LDS_OST = LDS_WS + NW * 64 * 4, ATT_LDS_BYTES = LDS_OST + NW * 4096;
__device__ __forceinline__ void glds16(const void* gsrc, unsigned lds_dst) { unsigned keep;
  asm volatile("s_mov_b32 %0, m0\n\ts_mov_b32 m0, %2\n\ts_nop 0\n\tglobal_load_lds_dwordx4 %1, off\n\ts_mov_b32 m0, %0" : "=&s"(keep) : "v"(gsrc), "s"(lds_dst) : "memory"); }
__device__ __forceinline__ float max3f(float a, float b, float c) { float r; asm("v_max3_f32 %0, %1, %2, %3" : "=v"(r) : "v"(a), "v"(b), "v"(c)); return r; }
__device__ __forceinline__ float max2f(float a, float b) { float r; asm("v_max_f32_e32 %0, %1, %2" : "=v"(r) : "v"(a), "v"(b)); return r; }
__device__ __forceinline__ float fadd_s(float a, float b) { float r; asm("v_add_f32_e32 %0, %1, %2" : "=v"(r) : "v"(a), "v"(b)); return r; }
__device__ __forceinline__ float fsub_s(float a, float b) { float r; asm("v_sub_f32_e32 %0, %1, %2" : "=v"(r) : "v"(a), "v"(b)); return r; }
__device__ __forceinline__ unsigned cvtpk_s(float lo, float hi) { return pk2(lo, hi); }
#define WAIT_BAR(N) asm volatile("s_waitcnt vmcnt(" #N ") lgkmcnt(0)\n\ts_barrier" ::: "memory")
__device__ __forceinline__ void qkt(f32x16& p0, f32x16& p1, const char* Kslot, const bf16x8* qr, const f32x16& negm, int r32, int hi) {
  const char* kb = Kslot + hi * 1024 + r32 * 16;
  #pragma unroll
  for (int d0 = 0; d0 < 4; ++d0) {
    const bf16x8 b0 = *reinterpret_cast<const bf16x8*>(kb + d0 * 2048);
    const bf16x8 b1 = *reinterpret_cast<const bf16x8*>(kb + d0 * 2048 + 512);
    if (d0 == 0) { p0 = MFMA32(b0, qr[0], negm); p1 = MFMA32(b1, qr[0], negm); }
    else { p0 = MFMA32(b0, qr[d0], p0); p1 = MFMA32(b1, qr[d0], p1); } }
}
typedef __attribute__((address_space(3))) const char* lds_cptr;
typedef short v4i16_t __attribute__((ext_vector_type(4)));
__device__ __forceinline__ void kload8(bf16x8* kf, lds_cptr kp) {
  kf[0] = *(const LAS bf16x8*)(kp);        kf[1] = *(const LAS bf16x8*)(kp + 512);
  kf[2] = *(const LAS bf16x8*)(kp + 2048); kf[3] = *(const LAS bf16x8*)(kp + 2560);
  kf[4] = *(const LAS bf16x8*)(kp + 4096); kf[5] = *(const LAS bf16x8*)(kp + 4608);
  kf[6] = *(const LAS bf16x8*)(kp + 6144); kf[7] = *(const LAS bf16x8*)(kp + 6656);
}
__device__ __forceinline__ void kload2(bf16x8* kf, lds_cptr kp, int j) { kf[2 * j] = *(const LAS bf16x8*)(kp + j * 2048); kf[2 * j + 1] = *(const LAS bf16x8*)(kp + j * 2048 + 512); }
__device__ __forceinline__ s16x4 vtr(lds_cptr p) { return __builtin_bit_cast(s16x4, __builtin_amdgcn_ds_read_tr16_b64_v4i16((LAS v4i16_t*)p)); }
__device__ __forceinline__ float rowmax(const f32x16& p0, const f32x16& p1) {
  float a = max3f(p0[0], p0[1], p1[0]), b = max3f(p0[2], p0[3], p1[1]); a = max3f(a, p1[2], p1[3]);
  #pragma unroll
  for (int r = 4; r < 16; r += 4) { a = max3f(a, p0[r], p0[r + 1]); b = max3f(b, p0[r + 2], p0[r + 3]); a = max3f(a, p1[r], p1[r + 1]); b = max3f(b, p1[r + 2], p1[r + 3]); }
  const float m = max2f(a, b);
  auto rr = __builtin_amdgcn_permlane32_swap(__float_as_uint(m), __float_as_uint(m), false, false);
  return max2f(__uint_as_float(rr[0]), __uint_as_float(rr[1]));
}
__device__ __forceinline__ void pv(f32x16* o, int vb, bf16x8 pa0, bf16x8 pa1, bf16x8 pa2, bf16x8 pa3) {
  #pragma unroll
  for (int d0 = 0; d0 < 2; ++d0) { s16x4 lo[4], hi[4];
    #pragma unroll
    for (int ks = 0; ks < 4; ++ks) {
      asm volatile("ds_read_b64_tr_b16 %0,%1 offset:%c2" : "=&v"(lo[ks]) : "v"(vb), "i"(d0 * 4096 + ks * 1024) : "memory");
      asm volatile("ds_read_b64_tr_b16 %0,%1 offset:%c2" : "=&v"(hi[ks]) : "v"(vb), "i"(d0 * 4096 + ks * 1024 + 512) : "memory"); }
    asm volatile("s_waitcnt lgkmcnt(0)" ::: "memory"); SBAR();
    #define PK(k) (bf16x8){lo[k][0], lo[k][1], lo[k][2], lo[k][3], hi[k][0], hi[k][1], hi[k][2], hi[k][3]}
    o[d0] = MFMA32(pa0, PK(0), o[d0]);
    o[d0] = MFMA32(pa1, PK(1), o[d0]);
    o[d0] = MFMA32(pa2, PK(2), o[d0]);
    o[d0] = MFMA32(pa3, PK(3), o[d0]);
    #undef PK
  }
}
template <int THRL> __device__ __forceinline__ void attn_unit(const bf16* Qu, const bf16* __restrict__ Kh, const bf16* __restrict__ Vh, bf16* Zu, int NT, char* shm, const float* qg, const float* tabc, const float* tabs, int t0) {
  int tid = threadIdx.x; asm volatile("" : "+v"(tid));
  const int lane = tid & 63, r32 = lane & 31, hi = lane >> 5; const int wid = __builtin_amdgcn_readfirstlane(tid >> 6);
  const bf16* Qw = Qu + (long)(wid * QBLK) * P;
  const unsigned lds0 = (unsigned)(uintptr_t)shm;
  float* wsf = (float*)(shm + LDS_WS) + wid * 64;
  const bf16* ksrc = Kh + (long)lane * P + wid * 8;
  const bf16* vsrc = Vh + (long)(16 * (wid & 3) + (lane >> 2)) * P + (wid >> 2) * 32 + (lane & 3) * 8;
  const unsigned kdst = lds0 + LDS_K + wid * 1024, vdst = lds0 + LDS_V + wid * 1024;
  #define DMA_K(t, slot) glds16(ksrc + (long)(t) * KVBLK * P, (unsigned)__builtin_amdgcn_readfirstlane(kdst + (slot)))
  #define DMA_V(t, slot) glds16(vsrc + (long)(t) * KVBLK * P, (unsigned)__builtin_amdgcn_readfirstlane(vdst + (slot)))
  const int vb0 = (int)(lds0 + LDS_V) + ((lane >> 4) & 1) * 32 + (lane & 3) * 8 + (4 * hi + ((lane & 15) >> 2)) * 64;
  const char* Kbase = shm + LDS_K; bf16x8 kf[8];
  const lds_cptr shm3 = (lds_cptr)shm; const lds_cptr kp0 = shm3 + LDS_K + hi * 1024 + r32 * 16; const lds_cptr vp0 = shm3 + LDS_V + ((lane >> 4) & 1) * 32 + (lane & 3) * 8 + (4 * hi + ((lane & 15) >> 2)) * 64;
  DMA_K(0, 0); DMA_V(0, 0); DMA_K(1, SLOTB);
  bf16x8 qr[4];
  #pragma unroll
  for (int d0 = 0; d0 < 4; ++d0) qr[d0] = *reinterpret_cast<const bf16x8*>(&Qw[(long)r32 * P + d0 * 16 + hi * 8]);
  {
    float x[4][8]; float ss = 0.f;
    #pragma unroll
    for (int d0 = 0; d0 < 4; ++d0) { const u32x4 u = __builtin_bit_cast(u32x4, qr[d0]);
      x[d0][0] = bflo(u.x); x[d0][1] = bfhi(u.x); x[d0][2] = bflo(u.y); x[d0][3] = bfhi(u.y); x[d0][4] = bflo(u.z); x[d0][5] = bfhi(u.z); x[d0][6] = bflo(u.w); x[d0][7] = bfhi(u.w);
      #pragma unroll
      for (int j = 0; j < 8; ++j) ss += x[d0][j] * x[d0][j]; }
    { auto rr = __builtin_amdgcn_permlane32_swap(__float_as_uint(ss), __float_as_uint(ss), false, false); ss = __uint_as_float(rr[0]) + __uint_as_float(rr[1]); }
    const float rs = __builtin_amdgcn_rsqf(ss * (1.f / 64.f) + EPS) * C2;
    const int tq = t0 + wid * QBLK + r32, pr = tq >> 6, pc = tq & 63;
    #pragma unroll
    for (int d0 = 0; d0 < 4; ++d0) { const f32x4 g0 = *(const f32x4*)(qg + 16 * d0 + 8 * hi), g1 = *(const f32x4*)(qg + 16 * d0 + 8 * hi + 4);
      #pragma unroll
      for (int j = 0; j < 4; ++j) { x[d0][j] *= rs * g0[j]; x[d0][4 + j] *= rs * g1[j]; } }
    #pragma unroll
    for (int ax = 0; ax < 2; ++ax) { const int pos = ax ? pc : pr;
      const f32x4 c0 = *(const f32x4*)(tabc + pos * 16 + 8 * hi), c1 = *(const f32x4*)(tabc + pos * 16 + 8 * hi + 4), s0 = *(const f32x4*)(tabs + pos * 16 + 8 * hi), s1 = *(const f32x4*)(tabs + pos * 16 + 8 * hi + 4);
      #pragma unroll
      for (int j = 0; j < 8; ++j) { const float cc = j < 4 ? c0[j & 3] : c1[j & 3], sn = j < 4 ? s0[j & 3] : s1[j & 3];
        const float a = x[2 * ax][j], b = x[2 * ax + 1][j]; x[2 * ax][j] = a * cc - b * sn; x[2 * ax + 1][j] = b * cc + a * sn; } }
    #pragma unroll
    for (int d0 = 0; d0 < 4; ++d0) { u32x4 u; u.x = pk2(x[d0][0], x[d0][1]); u.y = pk2(x[d0][2], x[d0][3]); u.z = pk2(x[d0][4], x[d0][5]); u.w = pk2(x[d0][6], x[d0][7]); qr[d0] = __builtin_bit_cast(bf16x8, u); }
  }
  float mhat = 0.f, l_reg = 0.f; f32x16 o[2]; o[0] = f32x16{}; o[1] = f32x16{}; f32x16 negm = f32x16{}; asm volatile("" : "+v"(negm));
  bool resc = false;
  #define START(P0, P1) do { const float rm = rowmax(P0, P1); resc = false; \
    { const float dl = rm; mhat = fadd_s(mhat, dl); \
      _Pragma("unroll") for (int r = 0; r < 16; ++r) { P0[r] = fsub_s(P0[r], dl); P1[r] = fsub_s(P1[r], dl); } \
      _Pragma("unroll") for (int r = 0; r < 16; ++r) negm[r] = -mhat; asm volatile("" : "+v"(negm)); } \
    _Pragma("unroll") for (int r = 0; r < 16; ++r) P0[r] = __builtin_amdgcn_exp2f(P0[r]); } while (0)
  #define RESC() do { if (resc) { asm volatile("s_waitcnt lgkmcnt(0)" ::: "memory"); \
      _Pragma("unroll") for (int d_ = 0; d_ < 2; ++d_) _Pragma("unroll") for (int r = 0; r < 16; ++r) o[d_][r] *= wsf[crow(r, hi)]; } } while (0)
  f32x16 pA0, pA1, pB0, pB1;
  int sl_prev = 0, sl_cur = 0, sl_next = SLOTB;
  #define ROT() do { sl_prev = sl_cur; sl_cur = sl_next; sl_next = (sl_next == (NSLOT - 1) * SLOTB) ? 0 : sl_next + SLOTB; } while (0)
  DMA_K(2, 2 * SLOTB);
  WAIT_BAR(3);
  qkt(pA0, pA1, Kbase, qr, negm, r32, hi); asm volatile("s_nop 15\n\ts_nop 7" : "+v"(pA0), "+v"(pA1));
  START(pA0, pA1);
  _Pragma("unroll") for (int r = 0; r < 16; ++r) pA1[r] = __builtin_amdgcn_exp2f(pA1[r]);
  WAIT_BAR(0);
  DMA_K(3, 0); DMA_V(1, SLOTB);
  ROT();
  kload8(kf, kp0 + sl_cur);
  WAIT_BAR(2);
  s16x4 vlo[8], vhi[8]; u32x4 pw0, pw1, pw2, pw3;
  #define PKW(Pq, B) cvtpk_s(Pq[B], Pq[B + 1])
  #define PAF(k) __builtin_bit_cast(bf16x8, pw##k)
  #define VFR(i) (bf16x8){vlo[i][0], vlo[i][1], vlo[i][2], vlo[i][3], vhi[i][0], vhi[i][1], vhi[i][2], vhi[i][3]}
  #define PIN(x) asm volatile("" : "+v"(x))
  #define MX3(a, b, c) __builtin_fmaxf(__builtin_fmaxf((a), (b)), (c))
  #define GAPA(MF, A0, A1, A2, A3, W0, W1, PW) do { MF; sacc += A0; sacc += A1; sacc += A2; sacc += A3; PIN(sacc); W0; W1; PIN(PW); SBAR(); } while (0)
  #define EX(v) __builtin_amdgcn_exp2f(v)
  #define GAPB(MF, X, B) do { MF; X[B] = EX(X[B]); X[B + 1] = EX(X[B + 1]); X[B + 2] = EX(X[B + 2]); X[B + 3] = EX(X[B + 3]); PIN(X); SBAR(); } while (0)
  #define VRD(i) do { vlo[i] = vtr(vp_ + (((i) >> 2) * 4096 + ((i) & 3) * 1024)); vhi[i] = vtr(vp_ + (((i) >> 2) * 4096 + ((i) & 3) * 1024 + 512)); } while (0)
  #define KRD(G, j) do { if (G) { kload2(kf, kp0 + sl_next, j); SBAR(); } } while (0)
  #define STEP(C0, C1, P0, P1, t, GK, GV, GL) do { SBAR(); \
    const lds_cptr vp_ = vp0 + sl_prev; \
    VRD(0); SBAR(); float sacc = (P0[0] + P0[1]); \
    GAPA(C0 = MFMA32(kf[0], qr[0], negm), P0[2], P0[3], P0[4], P0[5],     pw0[0] = PKW(P0, 0), pw0[1] = PKW(P0, 2), pw0); \
    VRD(4); SBAR(); GAPA(C1 = MFMA32(kf[1], qr[0], negm), P0[6], P0[7], P0[8], P0[9],     pw0[2] = PKW(P0, 4), pw0[3] = PKW(P0, 6), pw0); \
    VRD(1); SBAR(); GAPA(C0 = MFMA32(kf[2], qr[1], C0),   P0[10], P0[11], P0[12], P0[13], pw1[0] = PKW(P0, 8), pw1[1] = PKW(P0, 10), pw1); \
    VRD(5); SBAR(); GAPA(C1 = MFMA32(kf[3], qr[1], C1),   P0[14], P0[15], P1[0], P1[1],   pw1[2] = PKW(P0, 12), pw1[3] = PKW(P0, 14), pw1); \
    VRD(2); SBAR(); GAPA(C0 = MFMA32(kf[4], qr[2], C0),   P1[2], P1[3], P1[4], P1[5],     pw2[0] = PKW(P1, 0), pw2[1] = PKW(P1, 2), pw2); \
    VRD(6); SBAR(); GAPA(C1 = MFMA32(kf[5], qr[2], C1),   P1[6], P1[7], P1[8], P1[9],     pw2[2] = PKW(P1, 4), pw2[3] = PKW(P1, 6), pw2); \
    VRD(3); SBAR(); GAPA(C0 = MFMA32(kf[6], qr[3], C0),   P1[10], P1[11], P1[12], P1[13], pw3[0] = PKW(P1, 8), pw3[1] = PKW(P1, 10), pw3); \
    VRD(7); SBAR(); GAPA(C1 = MFMA32(kf[7], qr[3], C1),   P1[14], P1[15], 0.f, 0.f,       pw3[2] = PKW(P1, 12), pw3[3] = PKW(P1, 14), pw3); \
    l_reg += sacc; \
    if (GK) { DMA_K((t) + 3, sl_cur); } if (GV) { DMA_V((t) + 1, sl_next); } \
    { float a = MX3(C0[0], C0[1], C1[0]), b = MX3(C0[2], C0[3], C1[1]); a = MX3(a, C1[2], C1[3]); \
      _Pragma("unroll") for (int r = 4; r < 16; r += 4) { a = MX3(a, C0[r], C0[r + 1]); b = MX3(b, C0[r + 2], C0[r + 3]); a = MX3(a, C1[r], C1[r + 1]); b = MX3(b, C1[r + 2], C1[r + 3]); } \
      float rm = __builtin_fmaxf(a, b); { auto rr = __builtin_amdgcn_permlane32_swap(__float_as_uint(rm), __float_as_uint(rm), false, false); rm = __builtin_fmaxf(__uint_as_float(rr[0]), __uint_as_float(rr[1])); } \
      resc = false; \
      if (__builtin_expect(__any(rm > (float)THRL), 0)) { const float dl = __builtin_fmaxf(rm, 0.f); mhat += dl; \
        _Pragma("unroll") for (int r = 0; r < 16; ++r) { C0[r] -= dl; C1[r] -= dl; } \
        _Pragma("unroll") for (int r = 0; r < 16; ++r) negm[r] = -mhat; asm volatile("" : "+v"(negm)); \
        const float f = __builtin_amdgcn_exp2f(-dl); l_reg *= f; if (hi == 0) wsf[r32] = f; resc = true; } } \
    SBAR(); \
    GAPB(o[0] = MFMA32(PAF(0), VFR(0), o[0]), C0, 0); \
    GAPB(o[1] = MFMA32(PAF(0), VFR(4), o[1]), C0, 4); \
    KRD(GL, 0); GAPB(o[0] = MFMA32(PAF(1), VFR(1), o[0]), C0, 8); \
    KRD(GL, 1); GAPB(o[1] = MFMA32(PAF(1), VFR(5), o[1]), C0, 12); \
    KRD(GL, 2); GAPB(o[0] = MFMA32(PAF(2), VFR(2), o[0]), C1, 0); \
    KRD(GL, 3); GAPB(o[1] = MFMA32(PAF(2), VFR(6), o[1]), C1, 4); \
    GAPB(o[0] = MFMA32(PAF(3), VFR(3), o[0]), C1, 8); \
    GAPB(o[1] = MFMA32(PAF(3), VFR(7), o[1]), C1, 12); \
    } while (0)
  int t = 1;
  for (; t + 5 < NT; t += 2) {
    STEP(pB0, pB1, pA0, pA1, t, true, true, true);     WAIT_BAR(2); RESC(); ROT();
    STEP(pA0, pA1, pB0, pB1, t + 1, true, true, true); WAIT_BAR(2); RESC(); ROT();
  }
  #define ENDW(tt) do { if ((tt) + 3 < NT) { WAIT_BAR(2); } else if ((tt) + 2 < NT) { WAIT_BAR(1); } else { WAIT_BAR(0); } } while (0)
  for (; t + 1 < NT; t += 2) {
    STEP(pB0, pB1, pA0, pA1, t, (t + 3 < NT), (t + 1 < NT), (t + 1 < NT));       ENDW(t);     RESC(); ROT();
    STEP(pA0, pA1, pB0, pB1, t + 1, (t + 4 < NT), (t + 2 < NT), (t + 2 < NT));   ENDW(t + 1); RESC(); ROT();
  }
  STEP(pB0, pB1, pA0, pA1, NT - 1, false, false, false); RESC();
  { float sacc = pB0[0] + pB0[1]; _Pragma("unroll") for (int r = 2; r < 16; ++r) sacc += pB0[r]; _Pragma("unroll") for (int r = 0; r < 16; ++r) sacc += pB1[r]; l_reg += sacc;
    pw0 = (u32x4){PKW(pB0, 0), PKW(pB0, 2), PKW(pB0, 4), PKW(pB0, 6)}; pw1 = (u32x4){PKW(pB0, 8), PKW(pB0, 10), PKW(pB0, 12), PKW(pB0, 14)}; pw2 = (u32x4){PKW(pB1, 0), PKW(pB1, 2), PKW(pB1, 4), PKW(pB1, 6)}; pw3 = (u32x4){PKW(pB1, 8), PKW(pB1, 10), PKW(pB1, 12), PKW(pB1, 14)};
    SBAR(); pv(o, vb0 + sl_cur, PAF(0), PAF(1), PAF(2), PAF(3)); }
  #undef PKW
  #undef PAF
  #undef VFR
  #undef PIN
  #undef MX3
  #undef GAPA
  #undef GAPB
  #undef EX
  #undef VRD
  #undef KRD
  #undef STEP
  #undef ENDW
  { auto rr = __builtin_amdgcn_permlane32_swap(__float_as_uint(l_reg), __float_as_uint(l_reg), false, false); l_reg = __uint_as_float(rr[0]) + __uint_as_float(rr[1]); }
  if (hi == 0) wsf[32 + r32] = l_reg; asm volatile("s_waitcnt lgkmcnt(0)" ::: "memory");
  float rli[16];
  #pragma unroll
  for (int r = 0; r < 16; ++r) rli[r] = __builtin_amdgcn_rcpf(wsf[32 + crow(r, hi)]);
  bf16* Zw = Zu + (long)(wid * QBLK) * P;
  { bf16* stg = (bf16*)(shm + LDS_OST) + wid * 2048;
    #pragma unroll
    for (int r = 0; r < 16; ++r) { const int orow = crow(r, hi);
      #pragma unroll
      for (int d0 = 0; d0 < 2; ++d0) stg[orow * 64 + d0 * 32 + r32] = __float2bfloat16(o[d0][r] * rli[r]); }
    asm volatile("s_waitcnt lgkmcnt(0)" ::: "memory");
    #pragma unroll
    for (int i = 0; i < 4; ++i) { const int row = i * 8 + (lane >> 3), ch = lane & 7; const u32x4 v = *(const u32x4*)(stg + row * 64 + ch * 8);
      u32x4* zp = (u32x4*)(Zw + (long)row * P + ch * 8); const u32x4 z = *zp; u32x4 w;
      w.x = pk2(bflo(v.x) * silu(bflo(z.x)), bfhi(v.x) * silu(bfhi(z.x))); w.y = pk2(bflo(v.y) * silu(bflo(z.y)), bfhi(v.y) * silu(bfhi(z.y)));
      w.z = pk2(bflo(v.z) * silu(bflo(z.z)), bfhi(v.z) * silu(bfhi(z.z))); w.w = pk2(bflo(v.w) * silu(bflo(z.w)), bfhi(v.w) * silu(bfhi(z.w)));
      *zp = w; } }
  asm volatile("s_waitcnt vmcnt(0) lgkmcnt(0)\n\ts_barrier" ::: "memory");
  #undef DMA_K
  #undef DMA_V
  #undef START
  #undef RESC
  #undef ROT
}
#undef SBAR
#undef WAIT_BAR
}

#define XB_TMO      128
#define XB_XCNT(j)  (256  + 64 * (j))
#define XB_XSUB(j)  (1280 + 64 * (j))
#define XB_XGEN(j)  (2304 + 64 * (j))
#define XB_TOP      3328
#define XB_TOPGEN   3392
#define XCD_BAR_WORDS 3456
#define XB_SPIN_CAP (1u << 20)
__device__ __forceinline__ unsigned xb_ld(unsigned* p)              { return __hip_atomic_load(p, __ATOMIC_RELAXED, __HIP_MEMORY_SCOPE_AGENT); }
__device__ __forceinline__ unsigned xb_add(unsigned* p, unsigned v) { return __hip_atomic_fetch_add(p, v, __ATOMIC_RELAXED, __HIP_MEMORY_SCOPE_AGENT); }
__device__ __forceinline__ unsigned xb_xcc_id() { return (unsigned)__builtin_amdgcn_s_getreg((3 << 11) | 20) & 0xFu; }
#define XB_SPIN(cond, bar) do { unsigned _sp = 0; while (cond) { __builtin_amdgcn_s_sleep(1); \
    if ((++_sp & 255u) == 0u) { if (xb_ld(&(bar)[XB_TMO])) break; if (_sp > XB_SPIN_CAP) { atomicAdd(&(bar)[XB_TMO], 1u); break; } } } } while (0)
struct XcdBarrier { unsigned* bar; unsigned x; volatile LAS unsigned* st; };
__device__ __forceinline__ XcdBarrier xcd_barrier_post(unsigned* bar, volatile LAS unsigned* st) {
    XcdBarrier b; b.bar = bar; b.x = xb_xcc_id(); b.st = st;
    if (threadIdx.x == 0) (void)xb_add(&bar[XB_XCNT(b.x)], 1u);
    return b;
}
__device__ __forceinline__ void xcd_barrier_complete(unsigned* bar, unsigned x, unsigned& nloc, unsigned& nx) {
    const unsigned G = gridDim.x * gridDim.y * gridDim.z;
    unsigned sum, cnt, mine, sp = 0u;
    for (;;) {
        sum = 0u; cnt = 0u; mine = 0u;
#pragma unroll 1
        for (unsigned j = 0; j < 16; ++j) { const unsigned c = xb_ld(&bar[XB_XCNT(j)]); sum += c; cnt += (c > 0u) ? 1u : 0u; mine = (j == x) ? c : mine; }
        if (sum == G) break;
        __builtin_amdgcn_s_sleep(1);
        if ((++sp & 255u) == 0u) { if (xb_ld(&bar[XB_TMO])) break; if (sp > XB_SPIN_CAP) { atomicAdd(&bar[XB_TMO], 1u); break; } }
    }
    nloc = mine > 0u ? mine : 1u; nx = cnt > 0u ? cnt : 1u;
}
__device__ __forceinline__ void xcd_barrier(const XcdBarrier& b) {
    asm volatile("s_waitcnt vmcnt(0)" ::: "memory");
    __syncthreads();
    int t0 = threadIdx.x; asm volatile("" : "+v"(t0));
    if (t0 == 0) {
        unsigned* bar = b.bar;
        __builtin_amdgcn_s_waitcnt(0);
        unsigned nloc = b.st[0], nx = b.st[1];
        if (nloc == 0u) { xcd_barrier_complete(bar, b.x, nloc, nx); b.st[0] = nloc; b.st[1] = nx; }
        const unsigned old = xb_add(&bar[XB_XSUB(b.x)], 1u);
        const unsigned gen = old / nloc;
        if (old + 1u == (gen + 1u) * nloc) {
            __builtin_amdgcn_fence(__ATOMIC_RELEASE, "agent");
            asm volatile("s_waitcnt vmcnt(0)" ::: "memory");
            const unsigned og = xb_add(&bar[XB_TOP], 1u);
            const unsigned tg = og / nx;
            if (og + 1u == (tg + 1u) * nx) xb_add(&bar[XB_TOPGEN], 1u);
            else XB_SPIN(xb_ld(&bar[XB_TOPGEN]) == tg, bar);
            __builtin_amdgcn_fence(__ATOMIC_ACQUIRE, "agent");
            xb_add(&bar[XB_XGEN(b.x)], 1u);
            asm volatile("s_waitcnt vmcnt(0)" ::: "memory");
        } else {
            XB_SPIN(xb_ld(&bar[XB_XGEN(b.x)]) == gen, bar);
            __builtin_amdgcn_fence(__ATOMIC_ACQUIRE, "agent");
            asm volatile("s_waitcnt vmcnt(0)" ::: "memory");
        }
    }
    __syncthreads();
}

struct Args { const float* in[15]; float* out; unsigned char* ws; int ph_lo, ph_hi; };

__device__ __forceinline__ float wave_sum(float v) {
#pragma unroll
    for (int o = 1; o < 64; o <<= 1) v += __shfl_xor(v, o);
    return v;
}

__device__ __forceinline__ void tr_item(const float* W, int ldw, int k0, int n0, bf16_t* dst, int dpitch, const float* gk, float sc, LAS float* scr, int lane) {
#pragma unroll
    for (int i = 0; i < 32; ++i) { const int kk = 2 * i + (lane >> 5); float v = W[(size_t)(k0 + kk) * ldw + n0 + (lane & 31)]; if (gk) v *= gk[k0 + kk]; scr[kk * 33 + (lane & 31)] = v * sc; }
    asm volatile("s_waitcnt lgkmcnt(0)" ::: "memory");
    const int c = lane & 7;
#pragma unroll
    for (int j = 0; j < 4; ++j) { const int n = (lane >> 3) + 8 * j; const LAS float* s = scr + (8 * c) * 33 + n;
        u32x4 o; o.x = pk2(s[0 * 33], s[1 * 33]); o.y = pk2(s[2 * 33], s[3 * 33]); o.z = pk2(s[4 * 33], s[5 * 33]); o.w = pk2(s[6 * 33], s[7 * 33]);
        *(u32x4*)(dst + (size_t)n * dpitch + 8 * c) = o; }
    asm volatile("s_waitcnt lgkmcnt(0)" ::: "memory");
}
__device__ __forceinline__ int map_col(int n0) {
    if (n0 < 2048) return n0;
    if (n0 < 2080) return C_GL;
    if (n0 < 3104) return C_ZA + (n0 - 2080);
    if (n0 < 4128) return C_QB + (n0 - 3104);
    if (n0 < 4384) return C_KB + (n0 - 4128);
    if (n0 < 4640) return C_VB + (n0 - 4384);
    if (n0 < 5664) return C_ZB + (n0 - 4640);
    if (n0 < 6688) return C_MA + (n0 - 5664);
    return C_MB + (n0 - 6688);
}
constexpr int CV_IN = 16 * 241, CV_SQ = 16 * 32, CV_ITEMS = CV_IN + 3 * CV_SQ;
__device__ __forceinline__ void convert_item(const Args& args, int l, int r, bf16_t* WIN, bf16_t* WBR, bf16_t* WOUT, LAS float* scr, int lane) {
    if (r < CV_IN) { const int kb = r / 241, nb = r % 241, n0 = 32 * nb;
        tr_item(args.in[3] + (size_t)l * DM * IN_DIM, IN_DIM, 64 * kb, n0, WIN + (size_t)l * WIN_L + (size_t)map_col(n0) * DM + 64 * kb, DM, args.in[2] + l * DM, n0 < 512 ? 0.08838834764831845f : 1.f, scr, lane);
        return; }
    r -= CV_IN;
    const int which = r / CV_SQ; r %= CV_SQ; const int kb = r / 32, nb = r % 32;
    if (which == 0) tr_item(args.in[11] + (size_t)l * DM * DM, DM, 64 * kb, 32 * nb, WBR + (size_t)l * DM * 2048 + (size_t)(32 * nb) * 2048 + 64 * kb, 2048, nullptr, 1.f, scr, lane);
    else if (which == 1) tr_item(args.in[12] + (size_t)l * DM * DM, DM, 64 * kb, 32 * nb, WBR + (size_t)l * DM * 2048 + (size_t)(32 * nb) * 2048 + 1024 + 64 * kb, 2048, nullptr, 1.f, scr, lane);
    else tr_item(args.in[13] + (size_t)l * DM * DM, DM, 64 * kb, 32 * nb, WOUT + (size_t)l * DM * DM + (size_t)(32 * nb) * DM + 64 * kb, DM, nullptr, 1.f, scr, lane);
}

__device__ __forceinline__ void x_rows_to_bf16(const float* x, bf16_t* xb, float* ssp, int gw, int ngw, int lane) {
    for (int m = gw; m < NTOK; m += ngw) {
        const f32x4* xr = (const f32x4*)(x + (size_t)m * DM) + lane; f32x4 v[4]; float s = 0.f;
#pragma unroll
        for (int j = 0; j < 4; ++j) { v[j] = xr[64 * j]; s += (v[j].x * v[j].x + v[j].y * v[j].y) + (v[j].z * v[j].z + v[j].w * v[j].w); }
        s = wave_sum(s);
        u32x2* o8 = (u32x2*)(xb + (size_t)m * DM) + lane;
#pragma unroll
        for (int j = 0; j < 4; ++j) { u32x2 w; w.x = pk2(v[j].x, v[j].y); w.y = pk2(v[j].z, v[j].w); o8[64 * j] = w; }
        if (lane < 16) ssp[(size_t)m * 16 + lane] = (lane == 0) ? s : 0.f;
    }
}

constexpr int PL_GL = 0, PL_TOT = 8192, PL_QF = 12288, PL_KF = PL_QF + 17408, PL_QB = PL_KF + 17408, PL_KB = PL_QB + 17408, PL_VT = PL_KB + 17408, PL_A = PL_VT + 36864, PL_END = PL_A + 9216;
static_assert(PL_END <= RING_BYTES, "prep LDS");
struct PrepIn { u32x4 gl[2]; u32x4 v[4]; };
struct PrepW { u32x4 wfrag; float bf, bb; };
__device__ __forceinline__ void gla_prep_loadw(PrepW& w, const float* wgf, const float* bgf, const float* wgb, const float* bgb, int h) {
    int tid = threadIdx.x; asm volatile("" : "+v"(tid)); const int c = tid & 127, lane = tid & 63, wave = tid >> 6, l32 = lane & 31, hh = lane >> 5, dir = wave >> 2, cb = wave & 3;
    const float* wg = (dir ? wgb : wgf) + (size_t)(8 * hh) * 512 + h * 128 + 32 * cb + l32;
    float t[8];
#pragma unroll
    for (int j = 0; j < 8; ++j) t[j] = wg[j * 512];
    w.wfrag = (u32x4){pk2(t[0], t[1]), pk2(t[2], t[3]), pk2(t[4], t[5]), pk2(t[6], t[7])};
    w.bf = bgf[h * 128 + c]; w.bb = bgb[h * 128 + c];
}
__device__ __forceinline__ void gla_prep_load(PrepIn& in, const bf16_t* proj, int gc, int h) {
    int tid = threadIdx.x; asm volatile("" : "+v"(tid));
    const int row0 = gc * 64;
    { const int lane = tid & 63, l32 = lane & 31, hh = lane >> 5, dir = tid >> 8;
#pragma unroll
      for (int tb = 0; tb < 2; ++tb) in.gl[tb] = *(const u32x4*)(proj + (size_t)(row0 + 32 * tb + l32) * LDP + C_GL + 16 * dir + 8 * hh); }
#pragma unroll
    for (int i = 0; i < 4; ++i) { const int idx = tid + 512 * i, t = idx & 63, dv = (idx >> 6) * 8; in.v[i] = *(const u32x4*)(proj + (size_t)(row0 + t) * LDP + C_VA + h * 256 + dv); }
}
__device__ __forceinline__ void gla_prep_tile(LAS unsigned char* lds, const PrepIn& in, const PrepW& pw, int gc, int h, bf16_t* proj,
                                              float* ef, float* eb, bf16_t* kltf, bf16_t* kltb, bf16_t* vtg, bf16_t* pst, int rmask) {
    int tid = threadIdx.x; asm volatile("" : "+v"(tid));
    const int lane = tid & 63, wave = tid >> 6, c = tid & 127, s = tid >> 7, l32 = lane & 31, hh = lane >> 5;
    const int row0 = gc * 64;
    LAS float* TOT = (LAS float*)(lds + PL_TOT);
    LAS bf16_t* QFl = (LAS bf16_t*)(lds + PL_QF); LAS bf16_t* KFl = (LAS bf16_t*)(lds + PL_KF); LAS bf16_t* QBl = (LAS bf16_t*)(lds + PL_QB); LAS bf16_t* KBl = (LAS bf16_t*)(lds + PL_KB);
    LAS bf16_t* VTl = (LAS bf16_t*)(lds + PL_VT); LAS bf16_t* Al = (LAS bf16_t*)(lds + PL_A);
    { LAS float* ZL = (LAS float*)(lds + PL_QF);
      const int dir = wave >> 2, cb = wave & 3;
#pragma unroll
      for (int tb = 0; tb < 2; ++tb) { const f32x16 z = MFMA32(__builtin_bit_cast(bf16x8, in.gl[tb]), __builtin_bit_cast(bf16x8, pw.wfrag), f32x16{});
#pragma unroll
          for (int r = 0; r < 16; ++r) ZL[(dir * 64 + 32 * tb + crow(r, hh)) * 128 + 32 * cb + l32] = z[r]; } }
#pragma unroll
    for (int i = 0; i < 4; ++i) { const int idx = tid + 512 * i, t = idx & 63, dv = (idx >> 6) * 8;
        const u32x4 v = in.v[i];
        VTl[(dv + 0) * 72 + t] = (bf16_t)(v.x & 0xffffu); VTl[(dv + 1) * 72 + t] = (bf16_t)(v.x >> 16);
        VTl[(dv + 2) * 72 + t] = (bf16_t)(v.y & 0xffffu); VTl[(dv + 3) * 72 + t] = (bf16_t)(v.y >> 16);
        VTl[(dv + 4) * 72 + t] = (bf16_t)(v.z & 0xffffu); VTl[(dv + 5) * 72 + t] = (bf16_t)(v.z >> 16);
        VTl[(dv + 6) * 72 + t] = (bf16_t)(v.w & 0xffffu); VTl[(dv + 7) * 72 + t] = (bf16_t)(v.w >> 16); }
    const float bfv = pw.bf, bbv = pw.bb;
    bf16_t qraw[16], kraw[16];
#pragma unroll
    for (int j = 0; j < 16; ++j) { qraw[j] = proj[(size_t)(row0 + 16 * s + j) * LDP + C_QA + h * 128 + c]; kraw[j] = proj[(size_t)(row0 + 16 * s + j) * LDP + C_KA + h * 128 + c]; }
    LDS_BARRIER();
    float pf[16], sb[16];
#pragma unroll
    for (int j = 0; j < 16; ++j) { const int t = 16 * s + j; const LAS float* ZL = (const LAS float*)(lds + PL_QF);
        const float zf = bfv + ZL[t * 128 + c], zb = bbv + ZL[(64 + t) * 128 + c];
        pf[j] = logsig(zf) * (1.f / 16.f); sb[j] = logsig(zb) * (1.f / 16.f); }
#pragma unroll
    for (int j = 1; j < 16; ++j) pf[j] += pf[j - 1];
#pragma unroll
    for (int j = 14; j >= 0; --j) sb[j] += sb[j + 1];
    TOT[(0 * 4 + s) * 128 + c] = pf[15]; TOT[(1 * 4 + s) * 128 + c] = sb[0];
    LDS_BARRIER();
    float offf = 0.f, allf = 0.f, offb = 0.f, allb = 0.f;
#pragma unroll
    for (int s2 = 0; s2 < 4; ++s2) { const float a = TOT[(0 * 4 + s2) * 128 + c], b = TOT[(1 * 4 + s2) * 128 + c]; allf += a; allb += b; if (s2 < s) offf += a; if (s2 > s) offb += b; }
    const float etf = fexp(allf), etb = fexp(allb);
    if (s == 0) { ef[(size_t)(gc * 4 + h) * 128 + c] = etf; eb[(size_t)(gc * 4 + h) * 128 + c] = etb; }
    unsigned klf[8], klb[8];
#pragma unroll
    for (int j = 0; j < 16; j += 2) {
        float o_klf[2], o_klb[2];
#pragma unroll
        for (int e = 0; e < 2; ++e) { const int t = 16 * s + j + e;
            const float q = bf2f(qraw[j + e]), k = bf2f(kraw[j + e]);
            const float bfw = offf + pf[j + e], bbw = offb + sb[j + e];
            const float Ef = fexp(bfw), Eb = fexp(bbw), rEf = __builtin_amdgcn_rcpf(Ef), rEb = __builtin_amdgcn_rcpf(Eb);
            const bf16_t qsf = f2bf(q * Ef), ksf = f2bf(k * rEf), qsb = f2bf(q * Eb), ksb = f2bf(k * rEb);
            o_klf[e] = k * (rEf * etf); o_klb[e] = k * (rEb * etb);
            pst[(size_t)((row0 + t) & rmask) * LDP + C_QA + h * 128 + c] = qsf; pst[(size_t)((row0 + t) & rmask) * LDP + C_KA + h * 128 + c] = qsb;
            QFl[t * 136 + c] = qsf; KFl[t * 136 + c] = ksf; QBl[t * 136 + c] = qsb; KBl[t * 136 + c] = ksb; }
        klf[j >> 1] = pk2(o_klf[0], o_klf[1]); klb[j >> 1] = pk2(o_klb[0], o_klb[1]);
    }
    { u32x4* d = (u32x4*)(kltf + ((size_t)(gc * 4 + h) * 128 + c) * 64 + 16 * s); d[0] = (u32x4){klf[0], klf[1], klf[2], klf[3]}; d[1] = (u32x4){klf[4], klf[5], klf[6], klf[7]};
      u32x4* d2 = (u32x4*)(kltb + ((size_t)(gc * 4 + h) * 128 + c) * 64 + 16 * s); d2[0] = (u32x4){klb[0], klb[1], klb[2], klb[3]}; d2[1] = (u32x4){klb[4], klb[5], klb[6], klb[7]}; }
    LDS_BARRIER();
    { const int dir = wave >> 2, bi = (wave >> 1) & 1, bj = wave & 1;
      const LAS bf16_t* Qt = dir ? QBl : QFl; const LAS bf16_t* Kt = dir ? KBl : KFl;
      f32x16 acc = f32x16{};
#pragma unroll
      for (int ks = 0; ks < 8; ++ks) { const bf16x8 a = *(const LAS bf16x8*)(Qt + (32 * bi + l32) * 136 + 16 * ks + 8 * hh); const bf16x8 b = *(const LAS bf16x8*)(Kt + (32 * bj + l32) * 136 + 16 * ks + 8 * hh); acc = MFMA32(a, b, acc); }
      const int jj = 32 * bj + l32;
#pragma unroll
      for (int r = 0; r < 16; ++r) { const int ii = 32 * bi + crow(r, hh); const bool keep = dir ? (jj > ii) : (jj <= ii); if (keep) Al[ii * 72 + jj] = f2bf(acc[r]); } }
    LDS_BARRIER();
    {
#pragma unroll
      for (int tb = 0; tb < 2; ++tb) { f32x16 acc = f32x16{};
#pragma unroll
        for (int ks = 0; ks < 4; ++ks) { const bf16x8 a = *(const LAS bf16x8*)(VTl + (32 * wave + l32) * 72 + 16 * ks + 8 * hh); const bf16x8 b = *(const LAS bf16x8*)(Al + (32 * tb + l32) * 72 + 16 * ks + 8 * hh); acc = MFMA32(a, b, acc); }
        bf16_t* op = pst + (size_t)((row0 + 32 * tb + l32) & rmask) * LDP + C_VA + h * 256 + 32 * wave + 4 * hh;
#pragma unroll
        for (int g = 0; g < 4; ++g) { u32x2 w; w.x = pk2(acc[4 * g], acc[4 * g + 1]); w.y = pk2(acc[4 * g + 2], acc[4 * g + 3]); *(u32x2*)(op + 8 * g) = w; } }
#pragma unroll
      for (int i = 0; i < 4; ++i) { const int idx = tid + 512 * i, dv = idx >> 3, tg = idx & 7;
        *(u32x4*)(vtg + ((size_t)(gc * 4 + h) * 256 + dv) * 64 + 8 * tg) = *(const LAS u32x4*)(VTl + dv * 72 + 8 * tg); } }
    LDS_BARRIER();
}

template <int NB>
__device__ __forceinline__ void qk_norm_items(bf16_t* proj, int it0, int itstride, int nitems, int T, const float* qg, const float* kg, const float* tabc, const float* tabs, int lane, bf16_t* pst, int rmask) {
    const int li = lane & 15, d0 = 4 * li, half = li >> 3, within = li & 7; const bool first = within < 4;
    bf16_t* p[NB]; bf16_t* pw[NB]; u32x2 u[NB]; f32x4 c4[NB], s4[NB]; bool isq[NB], ok[NB];
#pragma unroll
    for (int i = 0; i < NB; ++i) { const int it = it0 + i * itstride; ok[i] = it < nitems; const int itc = ok[i] ? it : 0; const int row = itc, grp = 4; isq[i] = false;
        p[i] = proj + (size_t)row * LDP + (grp < 4 ? C_QB + 256 * grp : C_KB) + 4 * lane; pw[i] = pst + (size_t)(row & rmask) * LDP + (grp < 4 ? C_QB + 256 * grp : C_KB) + 4 * lane; u[i] = *(const u32x2*)p[i];
        const int t = row % T; const int pos = half ? (t & 63) : (t >> 6);
        c4[i] = *(const f32x4*)(tabc + pos * 16 + 4 * (within & 3)); s4[i] = *(const f32x4*)(tabs + pos * 16 + 4 * (within & 3)); }
    const f32x4 gq = *(const f32x4*)(qg + d0), gk = *(const f32x4*)(kg + d0);
#pragma unroll
    for (int i = 0; i < NB; ++i) {
        float x[4] = {bflo(u[i].x), bfhi(u[i].x), bflo(u[i].y), bfhi(u[i].y)};
        float ss = (x[0] * x[0] + x[1] * x[1]) + (x[2] * x[2] + x[3] * x[3]);
        ss += __shfl_xor(ss, 1); ss += __shfl_xor(ss, 2); ss += __shfl_xor(ss, 4); ss += __shfl_xor(ss, 8);
        const float rs = __builtin_amdgcn_rsqf(ss * (1.f / 64.f) + EPS);
        const f32x4 g4 = isq[i] ? gq : gk; const float sc = isq[i] ? C2 : 1.f;
        float o[4];
#pragma unroll
        for (int e = 0; e < 4; ++e) { const float xn = x[e] * rs * g4[e]; const float pr = __shfl_xor(xn, 4);
            o[e] = (first ? (xn * c4[i][e] - pr * s4[i][e]) : (xn * c4[i][e] + pr * s4[i][e])) * sc; }
        u32x2 w; w.x = pk2(o[0], o[1]); w.y = pk2(o[2], o[3]); if (ok[i]) *(u32x2*)pw[i] = w;
    }
}

constexpr int CH_CB = 36864, CH_OFFK = 17408, CH_OFFE = 17408 + 18432;
__device__ __forceinline__ void gla_chain(LAS unsigned char* lds, int ci, int nchunk, bf16_t* proj, const bf16_t* kltf, const bf16_t* kltb, const bf16_t* vtg, const float* ef, const float* eb, bf16_t* ob, bf16_t* of2, unsigned* done, bf16_t* dry = nullptr) {
    int tid = threadIdx.x; asm volatile("" : "+v"(tid));
    const int lane = tid & 63, wave = __builtin_amdgcn_readfirstlane(tid >> 6);
    const int dir = ci & 1, bh = ci >> 1, b = bh >> 2, h = bh & 3, l32 = lane & 31, hh = lane >> 5;
    const bf16_t* klt = dir ? kltb : kltf; const float* ee = dir ? eb : ef;
    const int qcol = (dir ? C_KA : C_QA) + h * 128;
    const int qt0 = tid >> 4, qc0 = tid & 15;
    const int kd0 = tid >> 3, kc0 = tid & 7;
    f32x16 S[4];
#pragma unroll
    for (int i = 0; i < 4; ++i) S[i] = f32x16{};
#define CH_GC(st) (b * nchunk + (dir ? (nchunk - 1 - (st)) : (st)))
#define CH_CLAMP(st) ((st) < nchunk ? (st) : nchunk - 1)
#define CH_LOAD_T(SET, st) do { const int gc_ = CH_GC(CH_CLAMP(st)); \
        q0##SET = *(const u32x4*)(proj + (size_t)(gc_ * 64 + qt0) * LDP + qcol + qc0 * 8); q1##SET = *(const u32x4*)(proj + (size_t)(gc_ * 64 + qt0 + 32) * LDP + qcol + qc0 * 8); \
        const bf16_t* kb_ = klt + (size_t)(gc_ * 4 + h) * 128 * 64; \
        k0##SET = *(const u32x4*)(kb_ + (size_t)kd0 * 64 + kc0 * 8); k1##SET = *(const u32x4*)(kb_ + (size_t)(kd0 + 64) * 64 + kc0 * 8); \
        if (tid < 32) en##SET = *(const f32x4*)(ee + (size_t)(gc_ * 4 + h) * 128 + tid * 4); } while (0)
#define CH_LOAD_V(SET, st) do { const int gc_ = CH_GC(CH_CLAMP(st)); _Pragma("unroll") for (int ks = 0; ks < 4; ++ks) vf##SET[ks] = *(const bf16x8*)(vtg + ((size_t)(gc_ * 4 + h) * 256 + 32 * wave + l32) * 64 + 16 * ks + 8 * hh); } while (0)
#define CH_STAGE(SET, buf) do { *(LAS u32x4*)((buf) + qt0 * 272 + qc0 * 16) = q0##SET; *(LAS u32x4*)((buf) + (qt0 + 32) * 272 + qc0 * 16) = q1##SET; \
        *(LAS u32x4*)((buf) + CH_OFFK + kd0 * 144 + kc0 * 16) = k0##SET; *(LAS u32x4*)((buf) + CH_OFFK + (kd0 + 64) * 144 + kc0 * 16) = k1##SET; \
        if (tid < 32) *(LAS f32x4*)((buf) + CH_OFFE + tid * 16) = en##SET; } while (0)
    u32x4 q0A, q1A, k0A, k1A, q0B, q1B, k0B, k1B; f32x4 enA = (f32x4){0.f, 0.f, 0.f, 0.f}, enB = enA; bf16x8 vfA[4], vfB[4];
    CH_LOAD_T(A, 0); CH_LOAD_V(A, 0);
    CH_STAGE(A, lds);
    CH_LOAD_T(B, 1); CH_LOAD_V(B, 1);
    __syncthreads();
#define CH_LDQ(bufi, blk_) do { _Pragma("unroll") for (int s_ = 0; s_ < 2; ++s_) _Pragma("unroll") for (int tb_ = 0; tb_ < 2; ++tb_) { \
        const LAS unsigned char* qp_ = cur + (32 * tb_ + l32) * 272 + (32 * (blk_) + 16 * s_ + 4 * hh) * 2; \
        const u32x2 lo_ = *(const LAS u32x2*)qp_, hi_ = *(const LAS u32x2*)(qp_ + 16); qv[bufi][s_][tb_] = (u32x4){lo_.x, lo_.y, hi_.x, hi_.y}; } } while (0)
#define CH_LDE(bufi, blk_) do { _Pragma("unroll") for (int g_ = 0; g_ < 4; ++g_) evv[bufi][g_] = *(const LAS f32x4*)(cur + CH_OFFE + (32 * (blk_) + 8 * g_ + 4 * hh) * 4); } while (0)
#define CH_LDK(bufi, blk_) do { _Pragma("unroll") for (int ks_ = 0; ks_ < 4; ++ks_) kfv[bufi][ks_] = *(const LAS bf16x8*)(cur + CH_OFFK + (32 * (blk_) + l32) * 144 + (16 * ks_ + 8 * hh) * 2); } while (0)
#define CH_STEP(st, CUR, NXT) do { \
        const int gc = CH_GC(st), row0 = gc * 64; \
        LAS unsigned char* cur = lds + ((st) & 1) * CH_CB; LAS unsigned char* nxt = lds + (((st) + 1) & 1) * CH_CB; \
        CH_LOAD_T(CUR, (st) + 2); \
        f32x16 ot[2]; ot[0] = f32x16{}; ot[1] = f32x16{}; \
        u32x4 qv[2][2][2]; bf16x8 kfv[2][4]; \
        CH_LDQ(0, 0); \
        _Pragma("unroll") for (int blk = 0; blk < 4; ++blk) { \
            if (blk < 3) { CH_LDQ((blk + 1) & 1, blk + 1); } else { CH_LDK(0, 0); } \
            __builtin_amdgcn_sched_barrier(0); \
            _Pragma("unroll") for (int s = 0; s < 2; ++s) { \
                u32x4 pa; pa.x = pk2(S[blk][8 * s + 0], S[blk][8 * s + 1]); pa.y = pk2(S[blk][8 * s + 2], S[blk][8 * s + 3]); pa.z = pk2(S[blk][8 * s + 4], S[blk][8 * s + 5]); pa.w = pk2(S[blk][8 * s + 6], S[blk][8 * s + 7]); \
                const bf16x8 sa = __builtin_bit_cast(bf16x8, pa); \
                _Pragma("unroll") for (int tb = 0; tb < 2; ++tb) ot[tb] = MFMA32(sa, __builtin_bit_cast(bf16x8, qv[blk & 1][s][tb]), ot[tb]); } \
            __builtin_amdgcn_sched_barrier(0); } \
        _Pragma("unroll") for (int blk = 0; blk < 4; ++blk) _Pragma("unroll") for (int g = 0; g < 4; ++g) { const f32x4 ev = *(const LAS f32x4*)(cur + CH_OFFE + (32 * blk + 8 * g + 4 * hh) * 4); \
            S[blk][4 * g] *= ev[0]; S[blk][4 * g + 1] *= ev[1]; S[blk][4 * g + 2] *= ev[2]; S[blk][4 * g + 3] *= ev[3]; } \
        __builtin_amdgcn_sched_barrier(0); \
        _Pragma("unroll") for (int blk = 0; blk < 4; ++blk) { \
            if (blk < 3) { CH_LDK((blk + 1) & 1, blk + 1); } \
            __builtin_amdgcn_sched_barrier(0); \
            _Pragma("unroll") for (int ks = 0; ks < 4; ++ks) S[blk] = MFMA32(kfv[blk & 1][ks], vf##CUR[ks], S[blk]); \
            __builtin_amdgcn_sched_barrier(0); } \
        CH_LOAD_V(CUR, (st) + 2); \
        { bf16_t* obase = dry ? dry : (dir ? ob : of2); const int rmk = dry ? 4095 : -1; \
          _Pragma("unroll") for (int tb = 0; tb < 2; ++tb) { bf16_t* op = obase + (size_t)((row0 + 32 * tb + l32) & rmk) * DM + h * 256 + 32 * wave + 4 * hh; \
            _Pragma("unroll") for (int g = 0; g < 4; ++g) { u32x2 w; w.x = pk2(ot[tb][4 * g], ot[tb][4 * g + 1]); w.y = pk2(ot[tb][4 * g + 2], ot[tb][4 * g + 3]); *(u32x2*)(op + 8 * g) = w; } } } \
        CH_STAGE(NXT, nxt); \
        LDS_BARRIER(); } while (0)
    for (int step = 0; step < nchunk; step += 2) {
        CH_STEP(step, A, B);
        CH_STEP(step + 1, B, A);
    }
    if (done) {
        asm volatile("s_waitcnt vmcnt(0)" ::: "memory");
        __syncthreads();
        if (tid == 0) { __builtin_amdgcn_fence(__ATOMIC_RELEASE, "agent"); asm volatile("s_waitcnt vmcnt(0)" ::: "memory"); (void)xb_add(done + 64 * b, 1u); }
    }
#undef CH_GC
#undef CH_CLAMP
#undef CH_LOAD_T
#undef CH_LOAD_V
#undef CH_STAGE
#undef CH_STEP
#undef CH_LDQ
#undef CH_LDE
#undef CH_LDK
}

template <int NB>
__device__ __forceinline__ void ua_items(bf16_t* proj, const bf16_t* ob, const bf16_t* of2, int it0, int itstride, const float* gn, int lane, bf16_t* pst, int rmask) {
    u32x2 a[NB], b[NB], f[NB], z[NB]; bf16_t* zp[NB]; bool ok[NB];
#pragma unroll
    for (int i = 0; i < NB; ++i) { const int itr = it0 + i * itstride; ok[i] = itr < NTOK * 4; const int it = ok[i] ? itr : 0, row = it >> 2, h = it & 3;
        a[i] = *(const u32x2*)(proj + (size_t)row * LDP + C_VA + h * 256 + 4 * lane); b[i] = *(const u32x2*)(ob + (size_t)row * DM + h * 256 + 4 * lane); f[i] = *(const u32x2*)(of2 + (size_t)row * DM + h * 256 + 4 * lane);
        zp[i] = pst + (size_t)(row & rmask) * LDP + C_ZA + h * 256 + 4 * lane; z[i] = *(const u32x2*)(proj + (size_t)row * LDP + C_ZA + h * 256 + 4 * lane); }
    const f32x4 g4 = *(const f32x4*)(gn + 4 * lane);
#pragma unroll
    for (int i = 0; i < NB; ++i) {
        float o[4] = {bflo(a[i].x) + bflo(b[i].x) + bflo(f[i].x), bfhi(a[i].x) + bfhi(b[i].x) + bfhi(f[i].x), bflo(a[i].y) + bflo(b[i].y) + bflo(f[i].y), bfhi(a[i].y) + bfhi(b[i].y) + bfhi(f[i].y)};
        const float ss = wave_sum((o[0] * o[0] + o[1] * o[1]) + (o[2] * o[2] + o[3] * o[3]));
        const float rs = __builtin_amdgcn_rsqf(ss * (1.f / 256.f) + EPS);
        u32x2 w; w.x = pk2(o[0] * rs * g4[0] * silu(bflo(z[i].x)), o[1] * rs * g4[1] * silu(bfhi(z[i].x))); w.y = pk2(o[2] * rs * g4[2] * silu(bflo(z[i].y)), o[3] * rs * g4[3] * silu(bfhi(z[i].y)));
        if (ok[i]) *(u32x2*)zp[i] = w;
    }
}

__global__ void __launch_bounds__(512, 2) hybrid_fwd(Args args) {
    extern __shared__ __attribute__((aligned(16))) unsigned char lds[];
    LAS unsigned char* L = (LAS unsigned char*)lds;
    volatile LAS int* MISC = (volatile LAS int*)(L + MISC_OFF);
    cg::grid_group grid = cg::this_grid();
    if (threadIdx.x < 32) MISC[threadIdx.x] = 0;
    __syncthreads();
    const XcdBarrier xbar = xcd_barrier_post((unsigned*)(args.ws + WS_CTL) + 4096, (volatile LAS unsigned*)(MISC + 8));
    for (int ph = args.ph_lo; ph < args.ph_hi; ++ph) {
        int tid = threadIdx.x; asm volatile("" : "+v"(tid));
        const int lane = tid & 63, wave = __builtin_amdgcn_readfirstlane(tid >> 6);
        int G = gridDim.x, bid = blockIdx.x; asm volatile("" : "+s"(G), "+s"(bid));
        const int gw = bid * 8 + wave, ngw = G * 8;
        size_t zoff = 0; asm volatile("" : "+s"(zoff));
        unsigned char* ws = args.ws + zoff;
#define AIN(i) (args.in[i])
        float* aout = args.out;
        unsigned* ctl = (unsigned*)(ws + WS_CTL);
        float* tabc = (float*)(ws + WS_TAB); float* tabs = tabc + 1024;
        bf16_t* WIN = (bf16_t*)(ws + WS_WIN); bf16_t* WBR = (bf16_t*)(ws + WS_WBR); bf16_t* WOUT = (bf16_t*)(ws + WS_WOUT);
        bf16_t* proj = (bf16_t*)(ws + WS_PROJ); bf16_t* xb = (bf16_t*)(ws + WS_XB); float* ssp = (float*)(ws + WS_SSP);
        float* ef = (float*)(ws + WS_EF); float* eb = (float*)(ws + WS_EB);
        bf16_t* kltf = (bf16_t*)(ws + WS_KLTF); bf16_t* kltb = (bf16_t*)(ws + WS_KLTB); bf16_t* vtg = (bf16_t*)(ws + WS_VT); bf16_t* of2 = (bf16_t*)(ws + WS_OF2);
        if (ph == 0) {
          {
            LAS float* scr = (LAS float*)(L + wave * 16384);
            for (int it = gw; it < CV_ITEMS; it += ngw) convert_item(args, 0, it, WIN, WBR, WOUT, scr, lane);
            for (int i = bid * 512 + tid; i < DEPTH * 224 * 128; i += G * 512) { const int l = i / (224 * 128), r = i % (224 * 128);
                *(u32x4*)(WIN + (size_t)l * WIN_L + (size_t)IN_DIM * DM + (size_t)r * 8) = (u32x4){0u, 0u, 0u, 0u}; }
            for (int i = bid * 512 + tid; i < 1024; i += G * 512) { const int pos = i >> 4, fi = i & 15;
                const float inv = __builtin_amdgcn_exp2f(-(float)fi * (13.287712379549449f / 16.f)); const float ang = (float)pos * inv;
                float rev = ang * 0.15915494309189535f; rev -= floorf(rev);
                tabc[i] = __builtin_amdgcn_cosf(rev); tabs[i] = __builtin_amdgcn_sinf(rev); }
            x_rows_to_bf16(AIN(0), xb, ssp, gw, ngw, lane);
          }
        } else if (ph == 25 || ph == 50) {
            const int grp = ph == 50; float* xo = aout + (size_t)grp * NTOK * DM; const float* gf = AIN(14);
            for (int m0 = gw; m0 < NTOK; m0 += 2 * ngw) { const int m1 = (m0 + ngw < NTOK) ? m0 + ngw : m0;
                f32x4* xr0 = (f32x4*)(xo + (size_t)m0 * DM) + lane; f32x4* xr1 = (f32x4*)(xo + (size_t)m1 * DM) + lane; f32x4 v0[4], v1[4]; float s0 = 0.f, s1 = 0.f;
#pragma unroll
                for (int j = 0; j < 4; ++j) { v0[j] = xr0[64 * j]; v1[j] = xr1[64 * j]; }
#pragma unroll
                for (int j = 0; j < 4; ++j) { s0 += (v0[j].x * v0[j].x + v0[j].y * v0[j].y) + (v0[j].z * v0[j].z + v0[j].w * v0[j].w); s1 += (v1[j].x * v1[j].x + v1[j].y * v1[j].y) + (v1[j].z * v1[j].z + v1[j].w * v1[j].w); }
                const float rs0 = __builtin_amdgcn_rsqf(wave_sum(s0) * (1.f / 1024.f) + EPS), rs1 = __builtin_amdgcn_rsqf(wave_sum(s1) * (1.f / 1024.f) + EPS);
#pragma unroll
                for (int j = 0; j < 4; ++j) { const f32x4 g4 = *((const f32x4*)gf + lane + 64 * j); xr0[64 * j] = v0[j] * rs0 * g4; if (m1 != m0) xr1[64 * j] = v1[j] * rs1 * g4; } }
            if (grp == 0) x_rows_to_bf16(AIN(1), xb, ssp, gw, ngw, lane);
        } else {
            const int q = (ph < 25) ? ph - 1 : ph - 26; const int grp = ph > 25, l = q / 6, sub = q % 6;
            const int T = grp ? 2048 : 4096, nB = grp ? 8 : 4, nchunk = T / 64;
            float* xres = aout + (size_t)grp * NTOK * DM;
            if (sub == 0) {
                pg8::Gemm g{xb, WIN + (size_t)l * WIN_L, DM, DM, DM, 0}; pg8::StaticOrder S; S.init(NTOK, LDP, G, bid);
                pg8::EpiProj E{proj, ssp};
                pg8::gemm_phase<pg8::EpiProj>(L, g, S, E);
            } else if (sub == 1) {
                { PrepIn pin; gla_prep_load(pin, proj, bid >> 2, bid & 3); PrepW pw; int hcur = bid & 3; gla_prep_loadw(pw, AIN(4) + (size_t)l * 16 * 512, AIN(5) + l * 512, AIN(6) + (size_t)l * 16 * 512, AIN(7) + l * 512, hcur);
                  for (int tile = bid; tile < 1024; tile += G) { PrepIn pnx; const int tn = (tile + G < 1024) ? tile + G : tile; gla_prep_load(pnx, proj, tn >> 2, tn & 3);
                    if ((tile & 3) != hcur) { hcur = tile & 3; gla_prep_loadw(pw, AIN(4) + (size_t)l * 16 * 512, AIN(5) + l * 512, AIN(6) + (size_t)l * 16 * 512, AIN(7) + l * 512, hcur); }
                    gla_prep_tile(L, pin, pw, tile >> 2, tile & 3, proj, ef, eb, kltf, kltb, vtg, proj, -1);
                    pin = pnx; } }
                for (int it = gw; it < NTOK; it += 8 * ngw) qk_norm_items<8>(proj, it, ngw, NTOK, T, AIN(9) + l * 64, AIN(10) + l * 64, tabc, tabs, lane, proj, -1);
            } else if (sub == 2) {
                const int nchain = nB * 4 * 2, nqb = T / 256, natt = nB * 16 * nqb, nua = NTOK * 4 / 64, ncv = (grp == 0 && l < 3) ? (CV_ITEMS + 7) / 8 : 0, total = nchain + natt + nua + ncv;
                unsigned* done = ctl + 8192 + 64 * ((grp * 4 + l) * 8);
                if (tid == 0) MISC[2] = 0;
                unsigned* ctr = ctl + 64 * (grp * 4 + l);
                if (tid == 0) MISC[0] = (int)atomicAdd(ctr, 1u);
                for (;;) {
                    __syncthreads();
                    const int idx = MISC[0];
                    __syncthreads();
                    if (idx >= total) break;
                    int nxti = 0; if (tid == 0) nxti = (int)atomicAdd(ctr, 1u);
                    if (idx >= nchain + natt && idx < nchain + natt + nua) {
                        const int j = idx - nchain - natt, bq = (j * 16) / T;
                        if (tid == 0 && !((MISC[2] >> bq) & 1)) {
                            unsigned sp = 0; while (xb_ld(done + 64 * bq) < 8u) { __builtin_amdgcn_s_sleep(2); if (++sp > (1u << 24)) break; }
                            __builtin_amdgcn_fence(__ATOMIC_ACQUIRE, "agent"); asm volatile("s_waitcnt vmcnt(0)" ::: "memory");
                            MISC[2] = MISC[2] | (1 << bq); }
                        __syncthreads();
                        { int ln = threadIdx.x; asm volatile("" : "+v"(ln)); const int wv = __builtin_amdgcn_readfirstlane(ln >> 6); ln &= 63;
                          ua_items<8>(proj, xb, of2, 64 * j + wv, 8, AIN(8) + l * 256, ln, proj, -1); }
                        if (tid == 0) MISC[0] = nxti; continue; }
                    if (idx >= nchain + natt + nua) { int ln = threadIdx.x; asm volatile("" : "+v"(ln)); const int wv = __builtin_amdgcn_readfirstlane(ln >> 6); ln &= 63; const int r = (idx - nchain - natt - nua) * 8 + wv; if (r < CV_ITEMS) convert_item(args, l + 1, r, WIN, WBR, WOUT, (LAS float*)(L + wv * 16384), ln); if (tid == 0) MISC[0] = nxti; continue; }
                    if (idx < nchain) gla_chain(L, idx, nchunk, proj, kltf, kltb, vtg, ef, eb, xb, of2, done);
                    else
                    {
 const int u = idx - nchain; const int g4 = u & 3, qb = (u >> 2) % nqb, bk = (u >> 2) / nqb, kvh = bk & 3, b = bk >> 2, hq = kvh * 4 + g4;
                        const size_t rb = (size_t)b * T;
                        attn_body::attn_unit<8>((const attn_body::bf16*)(proj + (rb + (size_t)qb * 256) * LDP + C_QB + hq * 64), (const attn_body::bf16*)(proj + rb * LDP + C_KB + kvh * 64),
                                                (const attn_body::bf16*)(proj + rb * LDP + C_VB + kvh * 64), (attn_body::bf16*)(proj + (rb + (size_t)qb * 256) * LDP + C_ZB + hq * 64), T / 64, (char*)lds, AIN(9) + l * 64, tabc, tabs, qb * 256);
                    }
                    if (tid == 0) MISC[0] = nxti;
                }
            } else if (sub == 3) {
            } else if (sub == 4) {
                pg8::StaticOrder S; S.init(NTOK, DM, G, bid);
                { pg8::Gemm g{proj + C_ZA, WBR + (size_t)l * DM * 2048, LDP, 2048, DM, 2048}; pg8::PairOrder S2{S}; pg8::EpiBranchPair E{proj};
                  pg8::gemm_phase<pg8::EpiBranchPair, true, pg8::PairOrder>(L, g, S2, E); }
            } else {
                pg8::Gemm g{proj + C_MA, WOUT + (size_t)l * DM * DM, LDP, DM, DM, 0}; pg8::StaticOrder S; S.init(NTOK, DM, G, bid);
                pg8::EpiOut E{l == 0 ? AIN(grp) : xres, xres, xb, ssp, -1};
                pg8::gemm_phase<pg8::EpiOut>(L, g, S, E);
            }
        }
        { const int qq = (ph < 25) ? ph - 1 : ph - 26; const bool empty = ph != 0 && ph != 25 && ph != 50 && (qq % 6) == 3;
          if (ph + 1 < args.ph_hi && !empty) { if (args.ph_hi > NPHASE) grid.sync(); else xcd_barrier(xbar); } }
    }
}

extern "C" void kernel_launch(void* const* d_in, const int* in_sizes, int n_in, void* d_out, int out_size, void* d_ws, size_t ws_size, hipStream_t stream) {
    static int grid = 0;
    if (grid == 0) {
        if (n_in != 15 || ws_size < WS_END || out_size != 2 * NTOK * DM) { fprintf(stderr, "kernel_launch: unexpected shapes (n_in %d, ws %zu, out %d)\n", n_in, ws_size, out_size); grid = -1; return; }
        if (hipFuncSetAttribute((const void*)hybrid_fwd, hipFuncAttributeMaxDynamicSharedMemorySize, LDS_BYTES) != hipSuccess) { fprintf(stderr, "kernel_launch: hipFuncSetAttribute failed\n"); grid = -1; return; }
        int dev = 0, cus = 0, per_cu = 0;
        hipGetDevice(&dev); hipDeviceGetAttribute(&cus, hipDeviceAttributeMultiprocessorCount, dev);
        hipOccupancyMaxActiveBlocksPerMultiprocessor(&per_cu, (const void*)hybrid_fwd, 512, LDS_BYTES);
        if (per_cu < 1) { fprintf(stderr, "kernel_launch: occupancy query says %d blocks per CU\n", per_cu); (void)hipGetLastError(); }
        grid = cus;
    }
    if (grid < 0) return;
    (void)hipMemsetAsync((char*)d_ws + WS_CTL, 0, CTL_BYTES, stream);
    Args a{};
    for (int i = 0; i < 15; ++i) a.in[i] = (const float*)d_in[i];
    a.out = (float*)d_out; a.ws = (unsigned char*)d_ws; a.ph_lo = 0; a.ph_hi = NPHASE;
    void* kargs[] = {&a};
    hipError_t e = hipLaunchCooperativeKernel((const void*)hybrid_fwd, dim3(grid), dim3(512), kargs, LDS_BYTES, stream);
    if (e != hipSuccess) fprintf(stderr, "kernel_launch: cooperative launch failed: %s (grid %d)\n", hipGetErrorString(e), grid);
}
```

```cpp
#include <hip/hip_runtime.h>
#include <hip/hip_cooperative_groups.h>
#include <hip/hip_bf16.h>
#include <cstdio>
#include <cstdint>
#include <cmath>
namespace cg = cooperative_groups;

#define LAS __attribute__((address_space(3)))
#define GAS __attribute__((address_space(1)))
typedef unsigned short bf16_t;
typedef short bf16x8 __attribute__((ext_vector_type(8)));
typedef float f32x4 __attribute__((ext_vector_type(4)));
typedef float f32x2 __attribute__((ext_vector_type(2)));
typedef float f32x16 __attribute__((ext_vector_type(16)));
typedef unsigned u32x4 __attribute__((ext_vector_type(4)));
typedef unsigned u32x2 __attribute__((ext_vector_type(2)));
typedef __bf16 bf16x2_t __attribute__((ext_vector_type(2)));

constexpr int DM = 1024, NTOK = 16384, DEPTH = 4, IN_DIM = 7712, LDP = 7936;
constexpr int C_QA = 0, C_KA = 512, C_VA = 1024, C_QB = 2048, C_KB = 3072, C_VB = 3328, C_ZA = 3584, C_ZB = 4608, C_MA = 5632, C_MB = 6656, C_GL = 7680;
constexpr float EPS = 1e-6f;
constexpr float C2 = 0.125f * 1.4426950408889634f;
constexpr float LN2 = 0.6931471805599453f, LOG2E = 1.4426950408889634f;

constexpr size_t MiB = 1u << 20;
constexpr size_t WS_CTL = 0, CTL_BYTES = 65536;
constexpr size_t WS_TAB = 1 * MiB;
constexpr size_t WS_WIN = 2 * MiB;
constexpr size_t WIN_L = (size_t)LDP * 1024;
constexpr size_t WS_WBR = 64 * MiB;
constexpr size_t WS_WOUT = 80 * MiB;
constexpr size_t WS_PROJ = 88 * MiB;
constexpr size_t WS_XB = 336 * MiB;
constexpr size_t WS_SSP = 368 * MiB;
constexpr size_t WS_EF = 369 * MiB;
constexpr size_t WS_EB = WS_EF + 512 * 1024;
constexpr size_t WS_KLTF = 370 * MiB;
constexpr size_t WS_KLTB = 386 * MiB;
constexpr size_t WS_VT = 402 * MiB;
constexpr size_t WS_OF2 = 434 * MiB;
constexpr size_t WS_END = 466 * MiB;

constexpr int LDS_BYTES = 147456, RING_BYTES = 131072, MISC_OFF = 131072 + 512;
constexpr int NPHASE = 51;

__device__ __forceinline__ unsigned pk2(float lo, float hi) { f32x2 v = {lo, hi}; bf16x2_t b = __builtin_convertvector(v, bf16x2_t); return __builtin_bit_cast(unsigned, b); }
__device__ __forceinline__ float bflo(unsigned u) { return __builtin_bit_cast(float, u << 16); }
__device__ __forceinline__ float bfhi(unsigned u) { return __builtin_bit_cast(float, u & 0xffff0000u); }
__device__ __forceinline__ float bf2f(bf16_t v) { return __builtin_bit_cast(float, ((unsigned)v) << 16); }
__device__ __forceinline__ bf16_t f2bf(float f) { return (bf16_t)(pk2(f, 0.f) & 0xffffu); }
__device__ __forceinline__ float fexp(float x) { return __builtin_amdgcn_exp2f(x * LOG2E); }
__device__ __forceinline__ float sigm(float x) { return __builtin_amdgcn_rcpf(1.f + fexp(-x)); }
__device__ __forceinline__ float silu(float x) { return x * sigm(x); }
__device__ __forceinline__ float logsig(float z) { return fminf(z, 0.f) - LN2 * __builtin_amdgcn_logf(1.f + fexp(-fabsf(z))); }
__device__ __forceinline__ int crow(int r, int hi) { return (r & 3) + 8 * (r >> 2) + 4 * hi; }
#define LDS_BARRIER() do { asm volatile("s_waitcnt lgkmcnt(0)" ::: "memory"); __builtin_amdgcn_s_barrier(); } while (0)
#define MFMA32(a, b, c) __builtin_amdgcn_mfma_f32_32x32x16_bf16((a), (b), (c), 0, 0, 0)

namespace pg8 {
constexpr int BM = 256, BK = 64, HALF = 128, HTB = HALF * BK * 2, NXCD = 8, WGM = 8;
__host__ __device__ __forceinline__ int lds_byte(int r, int c) { const int st = (r >> 4) * 2 + (c >> 5), rr = r & 15, cc = c & 31, ob = rr * 64 + cc * 2; return st * 1024 + (ob ^ (((ob >> 9) & 1) << 5)); }
__host__ __device__ __forceinline__ void stage_rc(int b, int& R, int& C) { const int st = b / 1024, sb = b % 1024, swz = sb ^ (((sb >> 9) & 1) << 5); R = (st >> 1) * 16 + swz / 64; C = (st & 1) * 32 + (swz % 64) / 2; }
__host__ __device__ __forceinline__ int perm32(int rho) { const int n = rho >> 4, i = rho & 15; return 8 * (i >> 2) + 4 * n + (i & 3); }
struct Unit { int pm, pn, sel; };
struct Gemm { const bf16_t* A; const bf16_t* Bt; int lda, ldb, K; int selstep; };
struct StaticOrder {
    int nM, nN, nwg, G, c;
    __device__ void init(int M, int N, int G_, int c_) { nM = M / BM; nN = N / BM; nwg = nM * nN; G = G_; c = c_; }
    __device__ bool next(int i, Unit& u) const {
        const long L = (long)i * G + c; if (L >= nwg) return false;
        int wgid = (int)L; { const int q = nwg / NXCD, r = nwg % NXCD, xcd = wgid % NXCD, off = wgid / NXCD; wgid = (xcd < r ? xcd * (q + 1) : r * (q + 1) + (xcd - r) * q) + off; }
        const int nig = WGM * nN, gid = wgid / nig, fm = gid * WGM, gsz = (nM - fm) < WGM ? (nM - fm) : WGM;
        u.pm = fm + ((wgid % nig) % gsz); u.pn = (wgid % nig) / gsz; u.sel = 0; return true;
    }
};
struct PairOrder {
    StaticOrder b;
    __device__ bool next(int i, Unit& u) const { const bool ok = b.next(i >> 1, u); u.sel = i & 1; return ok; }
};
template <class Epi, bool ALIGN_EPI = true, class Sched = StaticOrder>
__device__ __forceinline__ void gemm_phase(LAS unsigned char* lds, const Gemm g, const Sched& S, const Epi& E) {
    int tid = threadIdx.x; asm volatile("" : "+v"(tid));
    const int wid = __builtin_amdgcn_readfirstlane(tid >> 6), lane = tid & 63, wr = wid >> 2, wc = wid & 3, fr = lane & 15, fq = lane >> 4;
    const int K = g.K, nt = K / BK;
    unsigned voffA[2], voffB[2];
#pragma unroll
    for (int i = 0; i < 2; ++i) { int R, C; stage_rc(tid * 16 + i * 8192, R, C); const int Rb = (R & ~31) + perm32(R & 31);
        voffA[i] = (unsigned)(R * g.lda + C) * 2u; voffB[i] = (unsigned)(Rb * g.ldb + C) * 2u; }
    const size_t kstep = (size_t)(BK * 2);
    const size_t hstepA = (size_t)HALF * g.lda * 2, hstepB = (size_t)HALF * g.ldb * 2;
    const size_t tstepA = 2 * hstepA, tstepB = 2 * hstepB;
    const unsigned ldsw = (unsigned)wid * 1024u;
    const int aoff = lds_byte(wr * 64 + fr, fq * 8), boff = lds_byte(wc * 32 + fr, fq * 8);
#define PG8_SA(b, h) (((b) * 2 + (h)) * HTB)
#define PG8_SB(b, h) ((4 + (b) * 2 + (h)) * HTB)
#define PG8_STAGE(bufoff, gbase, voff) do { _Pragma("unroll") for (int _i = 0; _i < 2; ++_i) \
        __builtin_amdgcn_global_load_lds((const unsigned*)((const char*)(gbase) + (voff)[_i]), (LAS unsigned*)(lds + (bufoff) + ldsw + _i * 8192), 16, 0, 0); } while (0)
#define PG8_LDA(dst, b, h) do { _Pragma("unroll") for (int m = 0; m < 4; ++m) _Pragma("unroll") for (int k = 0; k < 2; ++k) dst[m][k] = *(const LAS bf16x8*)(lds + PG8_SA(b, h) + aoff + m * 2048 + k * 1024); } while (0)
#define PG8_LDB(dst, b, h) do { _Pragma("unroll") for (int n = 0; n < 2; ++n) _Pragma("unroll") for (int k = 0; k < 2; ++k) dst[n][k] = *(const LAS bf16x8*)(lds + PG8_SB(b, h) + boff + n * 2048 + k * 1024); } while (0)
#define PG8_MMA(ai, bj, At, Bt) do { __builtin_amdgcn_s_setprio(1); _Pragma("unroll") for (int m = 0; m < 4; ++m) _Pragma("unroll") for (int n = 0; n < 2; ++n) _Pragma("unroll") for (int k = 0; k < 2; ++k) \
        acc[ai][bj][m][n] = __builtin_amdgcn_mfma_f32_16x16x32_bf16(Bt[n][k], At[m][k], acc[ai][bj][m][n], 0, 0, 0); __builtin_amdgcn_s_setprio(0); } while (0)
#define PG8_WAIT_V(n) asm volatile("s_waitcnt vmcnt(" #n ")" ::: "memory")
#define PG8_WAIT_L(n) asm volatile("s_waitcnt lgkmcnt(" #n ")" ::: "memory")
#define PG8_BAR __builtin_amdgcn_s_barrier()
#define PG8_SCHED __builtin_amdgcn_sched_barrier(0)
    Unit cur, nxt; int ui = 0;
    if (!S.next(0, cur)) return;
    f32x4 acc[2][2][4][2];
#pragma unroll
    for (int a = 0; a < 2; ++a)
#pragma unroll
        for (int b = 0; b < 2; ++b)
#pragma unroll
            for (int m = 0; m < 4; ++m)
#pragma unroll
                for (int n = 0; n < 2; ++n) acc[a][b][m][n] = (f32x4){0.f, 0.f, 0.f, 0.f};
    bf16x8 At[4][2], B0[2][2], B1[2][2];
    const char* cA = (const char*)g.A + (size_t)cur.pm * tstepA + (size_t)cur.sel * g.selstep; const char* cB = (const char*)g.Bt + (size_t)cur.pn * tstepB + (size_t)cur.sel * g.selstep;
    PG8_STAGE(PG8_SB(0, 0), cB, voffB); PG8_STAGE(PG8_SB(0, 1), cB + hstepB, voffB); PG8_STAGE(PG8_SA(0, 0), cA, voffA); PG8_STAGE(PG8_SA(0, 1), cA + hstepA, voffA);
    if (wr == 1) PG8_BAR;
    PG8_WAIT_V(2); PG8_BAR;
    PG8_STAGE(PG8_SB(1, 0), cB + kstep, voffB); PG8_STAGE(PG8_SA(1, 0), cA + kstep, voffA); PG8_STAGE(PG8_SB(1, 1), cB + hstepB + kstep, voffB);
    PG8_WAIT_V(6); PG8_BAR;
    for (;;) {
        const bool has_next = S.next(ui + 1, nxt);
        const char* nA = has_next ? (const char*)g.A + (size_t)nxt.pm * tstepA + (size_t)nxt.sel * g.selstep : cA; const char* nB = has_next ? (const char*)g.Bt + (size_t)nxt.pn * tstepB + (size_t)nxt.sel * g.selstep : cB;
        for (int t = 0; t < nt; t += 2) {
            const bool last = (t == nt - 2);
            const char* a1 = cA + (size_t)(t + 1) * kstep;
            const char* a2 = last ? nA : cA + (size_t)(t + 2) * kstep; const char* b2 = last ? nB : cB + (size_t)(t + 2) * kstep;
            const char* a3 = a2 + kstep; const char* b3 = b2 + kstep;
            PG8_LDB(B0, 0, 0); PG8_LDB(B1, 0, 1); PG8_SCHED; PG8_LDA(At, 0, 0); PG8_STAGE(PG8_SA(1, 1), a1 + hstepA, voffA);
            PG8_WAIT_V(8); PG8_WAIT_L(0); PG8_BAR; PG8_MMA(0, 0, At, B0); PG8_MMA(0, 1, At, B1); PG8_BAR; PG8_SCHED;
            PG8_LDA(At, 0, 1); PG8_STAGE(PG8_SB(0, 0), b2, voffB); PG8_STAGE(PG8_SB(0, 1), b2 + hstepB, voffB); PG8_STAGE(PG8_SA(0, 0), a2, voffA);
            PG8_WAIT_V(8); PG8_WAIT_L(0); PG8_BAR; PG8_MMA(1, 0, At, B0); PG8_MMA(1, 1, At, B1); PG8_BAR; PG8_SCHED;
            PG8_LDB(B0, 1, 0); PG8_LDB(B1, 1, 1); PG8_SCHED; PG8_LDA(At, 1, 0); PG8_STAGE(PG8_SA(0, 1), a2 + hstepA, voffA);
            PG8_WAIT_V(8); PG8_WAIT_L(0); PG8_BAR; PG8_MMA(0, 0, At, B0); PG8_MMA(0, 1, At, B1); PG8_BAR; PG8_SCHED;
            PG8_LDA(At, 1, 1); PG8_STAGE(PG8_SB(1, 0), b3, voffB); PG8_STAGE(PG8_SB(1, 1), b3 + hstepB, voffB); PG8_STAGE(PG8_SA(1, 0), a3, voffA);
            PG8_WAIT_V(8); PG8_WAIT_L(0); PG8_BAR; PG8_MMA(1, 0, At, B0); PG8_MMA(1, 1, At, B1); PG8_BAR; PG8_SCHED;
        }
        if constexpr (ALIGN_EPI) { if (wr == 0) PG8_BAR; }
        E(acc, cur, wr, wc, fr, fq);
        if (!has_next) break;
#pragma unroll
        for (int a = 0; a < 2; ++a)
#pragma unroll
            for (int b = 0; b < 2; ++b)
#pragma unroll
                for (int m = 0; m < 4; ++m)
#pragma unroll
                    for (int n = 0; n < 2; ++n) acc[a][b][m][n] = (f32x4){0.f, 0.f, 0.f, 0.f};
        cur = nxt; cA = nA; cB = nB; ++ui;
        if constexpr (ALIGN_EPI) { if (wr == 1) PG8_BAR; }
    }
    PG8_WAIT_V(0);
    if constexpr (!ALIGN_EPI) { if (wr == 0) PG8_BAR; }
    PG8_BAR;
#undef PG8_SA
#undef PG8_SB
#undef PG8_STAGE
#undef PG8_LDA
#undef PG8_LDB
#undef PG8_MMA
#undef PG8_WAIT_V
#undef PG8_WAIT_L
#undef PG8_BAR
#undef PG8_SCHED
}

struct EpiProj {
    bf16_t* O; const float* ssp;
    __device__ __forceinline__ void operator()(const f32x4 (&acc)[2][2][4][2], const Unit& u, int wr, int wc, int fr, int fq) const {
        const int row0 = u.pm * BM + wr * 64 + fr, col0 = u.pn * BM + wc * 32 + 8 * fq;
#pragma unroll
        for (int ai = 0; ai < 2; ++ai)
#pragma unroll
            for (int m = 0; m < 4; ++m) {
                const int row = row0 + ai * HALF + m * 16;
                const f32x4* sp = (const f32x4*)(ssp + (size_t)row * 16);
                const f32x4 s4 = (sp[0] + sp[1]) + (sp[2] + sp[3]);
                const float rs = __builtin_amdgcn_rsqf(((s4[0] + s4[1]) + (s4[2] + s4[3])) * (1.f / 1024.f) + EPS);
                bf16_t* rowp = O + (size_t)row * LDP + col0;
#pragma unroll
                for (int bj = 0; bj < 2; ++bj) { const f32x4 v0 = acc[ai][bj][m][0] * rs, v1 = acc[ai][bj][m][1] * rs;
                    u32x4 w; w.x = pk2(v0[0], v0[1]); w.y = pk2(v0[2], v0[3]); w.z = pk2(v1[0], v1[1]); w.w = pk2(v1[2], v1[3]);
                    *(u32x4*)(rowp + bj * HALF) = w; }
            }
    }
};
template <int SECOND> struct EpiBranch {
    bf16_t* P; bf16_t* W; int rmask;
    __device__ __forceinline__ void operator()(const f32x4 (&acc)[2][2][4][2], const Unit& u, int wr, int wc, int fr, int fq) const {
        const int row0 = u.pm * BM + wr * 64 + fr, col0 = u.pn * BM + wc * 32 + 8 * fq;
#pragma unroll
        for (int ai = 0; ai < 2; ++ai)
#pragma unroll
            for (int m = 0; m < 4; ++m) {
                bf16_t* rowp = P + (size_t)(row0 + ai * HALF + m * 16) * LDP + col0; bf16_t* roww = W + (size_t)((row0 + ai * HALF + m * 16) & rmask) * LDP + col0;
#pragma unroll
                for (int bj = 0; bj < 2; ++bj) {
                    const u32x4 a = *(const u32x4*)(rowp + C_MA + bj * HALF);
                    float ma[8] = {bflo(a.x), bfhi(a.x), bflo(a.y), bfhi(a.y), bflo(a.z), bfhi(a.z), bflo(a.w), bfhi(a.w)};
                    float o[8];
                    if (SECOND) {
                        const u32x4 b = *(const u32x4*)(rowp + C_MB + bj * HALF);
                        float mb[8] = {bflo(b.x), bfhi(b.x), bflo(b.y), bfhi(b.y), bflo(b.z), bfhi(b.z), bflo(b.w), bfhi(b.w)};
#pragma unroll
                        for (int e = 0; e < 8; ++e) o[e] = ma[e] + acc[ai][bj][m][e >> 2][e & 3] * sigm(mb[e]);
                    } else {
#pragma unroll
                        for (int e = 0; e < 8; ++e) o[e] = acc[ai][bj][m][e >> 2][e & 3] * sigm(ma[e]);
                    }
                    u32x4 w; w.x = pk2(o[0], o[1]); w.y = pk2(o[2], o[3]); w.z = pk2(o[4], o[5]); w.w = pk2(o[6], o[7]);
                    *(u32x4*)(roww + C_MA + bj * HALF) = w;
                }
            }
    }
};
struct EpiBranchPair {
    bf16_t* P;
    __device__ __forceinline__ void operator()(const f32x4 (&acc)[2][2][4][2], const Unit& u, int wr, int wc, int fr, int fq) const {
        if (u.sel == 0) { EpiBranch<0> e{P, P, -1}; e(acc, u, wr, wc, fr, fq); } else { EpiBranch<1> e{P, P, -1}; e(acc, u, wr, wc, fr, fq); }
    }
};
struct EpiOut {
    const float* xold; float* xnew; bf16_t* xb; float* ssp; int rmask;
    __device__ __forceinline__ void operator()(const f32x4 (&acc)[2][2][4][2], const Unit& u, int wr, int wc, int fr, int fq) const {
        const int row0 = u.pm * BM + wr * 64 + fr, col0 = u.pn * BM + wc * 32 + 8 * fq;
#pragma unroll
        for (int ai = 0; ai < 2; ++ai)
#pragma unroll
            for (int m = 0; m < 4; ++m) {
                const int row = row0 + ai * HALF + m * 16;
                float ss = 0.f;
#pragma unroll
                for (int bj = 0; bj < 2; ++bj) {
                    const size_t off = (size_t)row * DM + col0 + bj * HALF, offw = (size_t)(row & rmask) * DM + col0 + bj * HALF;
                    const f32x4 x0 = *(const f32x4*)(xold + off), x1 = *(const f32x4*)(xold + off + 4);
                    const f32x4 v0 = x0 + acc[ai][bj][m][0], v1 = x1 + acc[ai][bj][m][1];
                    *(f32x4*)(xnew + offw) = v0; *(f32x4*)(xnew + offw + 4) = v1;
                    u32x4 w; w.x = pk2(v0[0], v0[1]); w.y = pk2(v0[2], v0[3]); w.z = pk2(v1[0], v1[1]); w.w = pk2(v1[2], v1[3]);
                    *(u32x4*)(xb + offw) = w;
                    ss += (v0[0] * v0[0] + v0[1] * v0[1]) + (v0[2] * v0[2] + v0[3] * v0[3]) + (v1[0] * v1[0] + v1[1] * v1[1]) + (v1[2] * v1[2] + v1[3] * v1[3]);
                }
                ss += __shfl_xor(ss, 16); ss += __shfl_xor(ss, 32);
                if (fq == 0) ssp[(size_t)(row & rmask) * 16 + u.pn * 4 + wc] = ss;
            }
    }
};
}

namespace attn_body {
using bf16 = __hip_bfloat16;
using s16x4 = __attribute__((ext_vector_type(4))) short;
constexpr int D = 64, P = LDP;
constexpr int NW = 8, QBLK = 32, QB = QBLK * NW, KVBLK = 64;
#define SBAR() __builtin_amdgcn_sched_barrier(0)
constexpr int NSLOT = 3, SLOTB = 8192;
constexpr int LDS_K = 0, LDS_V = NSLOT * SLOTB, LDS_WS = 2 * NSLOT * SLOTB, LDS_OST = LDS_WS + NW * 64 * 4, ATT_LDS_BYTES = LDS_OST + NW * 4096;
__device__ __forceinline__ void glds16(const void* gsrc, unsigned lds_dst) { unsigned keep;
  asm volatile("s_mov_b32 %0, m0\n\ts_mov_b32 m0, %2\n\ts_nop 0\n\tglobal_load_lds_dwordx4 %1, off\n\ts_mov_b32 m0, %0" : "=&s"(keep) : "v"(gsrc), "s"(lds_dst) : "memory"); }
__device__ __forceinline__ float max3f(float a, float b, float c) { float r; asm("v_max3_f32 %0, %1, %2, %3" : "=v"(r) : "v"(a), "v"(b), "v"(c)); return r; }
__device__ __forceinline__ float max2f(float a, float b) { float r; asm("v_max_f32_e32 %0, %1, %2" : "=v"(r) : "v"(a), "v"(b)); return r; }
__device__ __forceinline__ float fadd_s(float a, float b) { float r; asm("v_add_f32_e32 %0, %1, %2" : "=v"(r) : "v"(a), "v"(b)); return r; }
__device__ __forceinline__ float fsub_s(float a, float b) { float r; asm("v_sub_f32_e32 %0, %1, %2" : "=v"(r) : "v"(a), "v"(b)); return r; }
__device__ __forceinline__ unsigned cvtpk_s(float lo, float hi) { return pk2(lo, hi); }
#define WAIT_BAR(N) asm volatile("s_waitcnt vmcnt(" #N ") lgkmcnt(0)\n\ts_barrier" ::: "memory")
__device__ __forceinline__ void qkt(f32x16& p0, f32x16& p1, const char* Kslot, const bf16x8* qr, const f32x16& negm, int r32, int hi) {
  const char* kb = Kslot + hi * 1024 + r32 * 16;
  #pragma unroll
  for (int d0 = 0; d0 < 4; ++d0) {
    const bf16x8 b0 = *reinterpret_cast<const bf16x8*>(kb + d0 * 2048);
    const bf16x8 b1 = *reinterpret_cast<const bf16x8*>(kb + d0 * 2048 + 512);
    if (d0 == 0) { p0 = MFMA32(b0, qr[0], negm); p1 = MFMA32(b1, qr[0], negm); }
    else { p0 = MFMA32(b0, qr[d0], p0); p1 = MFMA32(b1, qr[d0], p1); } }
}
typedef __attribute__((address_space(3))) const char* lds_cptr;
typedef short v4i16_t __attribute__((ext_vector_type(4)));
__device__ __forceinline__ void kload8(bf16x8* kf, lds_cptr kp) {
  kf[0] = *(const LAS bf16x8*)(kp);        kf[1] = *(const LAS bf16x8*)(kp + 512);
  kf[2] = *(const LAS bf16x8*)(kp + 2048); kf[3] = *(const LAS bf16x8*)(kp + 2560);
  kf[4] = *(const LAS bf16x8*)(kp + 4096); kf[5] = *(const LAS bf16x8*)(kp + 4608);
  kf[6] = *(const LAS bf16x8*)(kp + 6144); kf[7] = *(const LAS bf16x8*)(kp + 6656);
}
__device__ __forceinline__ void kload2(bf16x8* kf, lds_cptr kp, int j) { kf[2 * j] = *(const LAS bf16x8*)(kp + j * 2048); kf[2 * j + 1] = *(const LAS bf16x8*)(kp + j * 2048 + 512); }
__device__ __forceinline__ s16x4 vtr(lds_cptr p) { return __builtin_bit_cast(s16x4, __builtin_amdgcn_ds_read_tr16_b64_v4i16((LAS v4i16_t*)p)); }
__device__ __forceinline__ float rowmax(const f32x16& p0, const f32x16& p1) {
  float a = max3f(p0[0], p0[1], p1[0]), b = max3f(p0[2], p0[3], p1[1]); a = max3f(a, p1[2], p1[3]);
  #pragma unroll
  for (int r = 4; r < 16; r += 4) { a = max3f(a, p0[r], p0[r + 1]); b = max3f(b, p0[r + 2], p0[r + 3]); a = max3f(a, p1[r], p1[r + 1]); b = max3f(b, p1[r + 2], p1[r + 3]); }
  const float m = max2f(a, b);
  auto rr = __builtin_amdgcn_permlane32_swap(__float_as_uint(m), __float_as_uint(m), false, false);
  return max2f(__uint_as_float(rr[0]), __uint_as_float(rr[1]));
}
__device__ __forceinline__ void pv(f32x16* o, int vb, bf16x8 pa0, bf16x8 pa1, bf16x8 pa2, bf16x8 pa3) {
  #pragma unroll
  for (int d0 = 0; d0 < 2; ++d0) { s16x4 lo[4], hi[4];
    #pragma unroll
    for (int ks = 0; ks < 4; ++ks) {
      asm volatile("ds_read_b64_tr_b16 %0,%1 offset:%c2" : "=&v"(lo[ks]) : "v"(vb), "i"(d0 * 4096 + ks * 1024) : "memory");
      asm volatile("ds_read_b64_tr_b16 %0,%1 offset:%c2" : "=&v"(hi[ks]) : "v"(vb), "i"(d0 * 4096 + ks * 1024 + 512) : "memory"); }
    asm volatile("s_waitcnt lgkmcnt(0)" ::: "memory"); SBAR();
    #define PK(k) (bf16x8){lo[k][0], lo[k][1], lo[k][2], lo[k][3], hi[k][0], hi[k][1], hi[k][2], hi[k][3]}
    o[d0] = MFMA32(pa0, PK(0), o[d0]);
    o[d0] = MFMA32(pa1, PK(1), o[d0]);
    o[d0] = MFMA32(pa2, PK(2), o[d0]);
    o[d0] = MFMA32(pa3, PK(3), o[d0]);
    #undef PK
  }
}
template <int THRL> __device__ __forceinline__ void attn_unit(const bf16* Qu, const bf16* __restrict__ Kh, const bf16* __restrict__ Vh, bf16* Zu, int NT, char* shm, const float* qg, const float* tabc, const float* tabs, int t0) {
  int tid = threadIdx.x; asm volatile("" : "+v"(tid));
  const int lane = tid & 63, r32 = lane & 31, hi = lane >> 5; const int wid = __builtin_amdgcn_readfirstlane(tid >> 6);
  const bf16* Qw = Qu + (long)(wid * QBLK) * P;
  const unsigned lds0 = (unsigned)(uintptr_t)shm;
  float* wsf = (float*)(shm + LDS_WS) + wid * 64;
  const bf16* ksrc = Kh + (long)lane * P + wid * 8;
  const bf16* vsrc = Vh + (long)(16 * (wid & 3) + (lane >> 2)) * P + (wid >> 2) * 32 + (lane & 3) * 8;
  const unsigned kdst = lds0 + LDS_K + wid * 1024, vdst = lds0 + LDS_V + wid * 1024;
  #define DMA_K(t, slot) glds16(ksrc + (long)(t) * KVBLK * P, (unsigned)__builtin_amdgcn_readfirstlane(kdst + (slot)))
  #define DMA_V(t, slot) glds16(vsrc + (long)(t) * KVBLK * P, (unsigned)__builtin_amdgcn_readfirstlane(vdst + (slot)))
  const int vb0 = (int)(lds0 + LDS_V) + ((lane >> 4) & 1) * 32 + (lane & 3) * 8 + (4 * hi + ((lane & 15) >> 2)) * 64;
  const char* Kbase = shm + LDS_K; bf16x8 kf[8];
  const lds_cptr shm3 = (lds_cptr)shm; const lds_cptr kp0 = shm3 + LDS_K + hi * 1024 + r32 * 16; const lds_cptr vp0 = shm3 + LDS_V + ((lane >> 4) & 1) * 32 + (lane & 3) * 8 + (4 * hi + ((lane & 15) >> 2)) * 64;
  DMA_K(0, 0); DMA_V(0, 0); DMA_K(1, SLOTB);
  bf16x8 qr[4];
  #pragma unroll
  for (int d0 = 0; d0 < 4; ++d0) qr[d0] = *reinterpret_cast<const bf16x8*>(&Qw[(long)r32 * P + d0 * 16 + hi * 8]);
  {
    float x[4][8]; float ss = 0.f;
    #pragma unroll
    for (int d0 = 0; d0 < 4; ++d0) { const u32x4 u = __builtin_bit_cast(u32x4, qr[d0]);
      x[d0][0] = bflo(u.x); x[d0][1] = bfhi(u.x); x[d0][2] = bflo(u.y); x[d0][3] = bfhi(u.y); x[d0][4] = bflo(u.z); x[d0][5] = bfhi(u.z); x[d0][6] = bflo(u.w); x[d0][7] = bfhi(u.w);
      #pragma unroll
      for (int j = 0; j < 8; ++j) ss += x[d0][j] * x[d0][j]; }
    { auto rr = __builtin_amdgcn_permlane32_swap(__float_as_uint(ss), __float_as_uint(ss), false, false); ss = __uint_as_float(rr[0]) + __uint_as_float(rr[1]); }
    const float rs = __builtin_amdgcn_rsqf(ss * (1.f / 64.f) + EPS) * C2;
    const int tq = t0 + wid * QBLK + r32, pr = tq >> 6, pc = tq & 63;
    #pragma unroll
    for (int d0 = 0; d0 < 4; ++d0) { const f32x4 g0 = *(const f32x4*)(qg + 16 * d0 + 8 * hi), g1 = *(const f32x4*)(qg + 16 * d0 + 8 * hi + 4);
      #pragma unroll
      for (int j = 0; j < 4; ++j) { x[d0][j] *= rs * g0[j]; x[d0][4 + j] *= rs * g1[j]; } }
    #pragma unroll
    for (int ax = 0; ax < 2; ++ax) { const int pos = ax ? pc : pr;
      const f32x4 c0 = *(const f32x4*)(tabc + pos * 16 + 8 * hi), c1 = *(const f32x4*)(tabc + pos * 16 + 8 * hi + 4), s0 = *(const f32x4*)(tabs + pos * 16 + 8 * hi), s1 = *(const f32x4*)(tabs + pos * 16 + 8 * hi + 4);
      #pragma unroll
      for (int j = 0; j < 8; ++j) { const float cc = j < 4 ? c0[j & 3] : c1[j & 3], sn = j < 4 ? s0[j & 3] : s1[j & 3];
        const float a = x[2 * ax][j], b = x[2 * ax + 1][j]; x[2 * ax][j] = a * cc - b * sn; x[2 * ax + 1][j] = b * cc + a * sn; } }
    #pragma unroll
    for (int d0 = 0; d0 < 4; ++d0) { u32x4 u; u.x = pk2(x[d0][0], x[d0][1]); u.y = pk2(x[d0][2], x[d0][3]); u.z = pk2(x[d0][4], x[d0][5]); u.w = pk2(x[d0][6], x[d0][7]); qr[d0] = __builtin_bit_cast(bf16x8, u); }
  }
  float mhat = 0.f, l_reg = 0.f; f32x16 o[2]; o[0] = f32x16{}; o[1] = f32x16{}; f32x16 negm = f32x16{}; asm volatile("" : "+v"(negm));
  bool resc = false;
  #define START(P0, P1) do { const float rm = rowmax(P0, P1); resc = false; \
    { const float dl = rm; mhat = fadd_s(mhat, dl); \
      _Pragma("unroll") for (int r = 0; r < 16; ++r) { P0[r] = fsub_s(P0[r], dl); P1[r] = fsub_s(P1[r], dl); } \
      _Pragma("unroll") for (int r = 0; r < 16; ++r) negm[r] = -mhat; asm volatile("" : "+v"(negm)); } \
    _Pragma("unroll") for (int r = 0; r < 16; ++r) P0[r] = __builtin_amdgcn_exp2f(P0[r]); } while (0)
  #define RESC() do { if (resc) { asm volatile("s_waitcnt lgkmcnt(0)" ::: "memory"); \
      _Pragma("unroll") for (int d_ = 0; d_ < 2; ++d_) _Pragma("unroll") for (int r = 0; r < 16; ++r) o[d_][r] *= wsf[crow(r, hi)]; } } while (0)
  f32x16 pA0, pA1, pB0, pB1;
  int sl_prev = 0, sl_cur = 0, sl_next = SLOTB;
  #define ROT() do { sl_prev = sl_cur; sl_cur = sl_next; sl_next = (sl_next == (NSLOT - 1) * SLOTB) ? 0 : sl_next + SLOTB; } while (0)
  DMA_K(2, 2 * SLOTB);
  WAIT_BAR(3);
  qkt(pA0, pA1, Kbase, qr, negm, r32, hi); asm volatile("s_nop 15\n\ts_nop 7" : "+v"(pA0), "+v"(pA1));
  START(pA0, pA1);
  _Pragma("unroll") for (int r = 0; r < 16; ++r) pA1[r] = __builtin_amdgcn_exp2f(pA1[r]);
  WAIT_BAR(0);
  DMA_K(3, 0); DMA_V(1, SLOTB);
  ROT();
  kload8(kf, kp0 + sl_cur);
  WAIT_BAR(2);
  s16x4 vlo[8], vhi[8]; u32x4 pw0, pw1, pw2, pw3;
  #define PKW(Pq, B) cvtpk_s(Pq[B], Pq[B + 1])
  #define PAF(k) __builtin_bit_cast(bf16x8, pw##k)
  #define VFR(i) (bf16x8){vlo[i][0], vlo[i][1], vlo[i][2], vlo[i][3], vhi[i][0], vhi[i][1], vhi[i][2], vhi[i][3]}
  #define PIN(x) asm volatile("" : "+v"(x))
  #define MX3(a, b, c) __builtin_fmaxf(__builtin_fmaxf((a), (b)), (c))
  #define GAPA(MF, A0, A1, A2, A3, W0, W1, PW) do { MF; sacc += A0; sacc += A1; sacc += A2; sacc += A3; PIN(sacc); W0; W1; PIN(PW); SBAR(); } while (0)
  #define EX(v) __builtin_amdgcn_exp2f(v)
  #define GAPB(MF, X, B) do { MF; X[B] = EX(X[B]); X[B + 1] = EX(X[B + 1]); X[B + 2] = EX(X[B + 2]); X[B + 3] = EX(X[B + 3]); PIN(X); SBAR(); } while (0)
  #define VRD(i) do { vlo[i] = vtr(vp_ + (((i) >> 2) * 4096 + ((i) & 3) * 1024)); vhi[i] = vtr(vp_ + (((i) >> 2) * 4096 + ((i) & 3) * 1024 + 512)); } while (0)
  #define KRD(G, j) do { if (G) { kload2(kf, kp0 + sl_next, j); SBAR(); } } while (0)
  #define STEP(C0, C1, P0, P1, t, GK, GV, GL) do { SBAR(); \
    const lds_cptr vp_ = vp0 + sl_prev; \
    VRD(0); SBAR(); float sacc = (P0[0] + P0[1]); \
    GAPA(C0 = MFMA32(kf[0], qr[0], negm), P0[2], P0[3], P0[4], P0[5],     pw0[0] = PKW(P0, 0), pw0[1] = PKW(P0, 2), pw0); \
    VRD(4); SBAR(); GAPA(C1 = MFMA32(kf[1], qr[0], negm), P0[6], P0[7], P0[8], P0[9],     pw0[2] = PKW(P0, 4), pw0[3] = PKW(P0, 6), pw0); \
    VRD(1); SBAR(); GAPA(C0 = MFMA32(kf[2], qr[1], C0),   P0[10], P0[11], P0[12], P0[13], pw1[0] = PKW(P0, 8), pw1[1] = PKW(P0, 10), pw1); \
    VRD(5); SBAR(); GAPA(C1 = MFMA32(kf[3], qr[1], C1),   P0[14], P0[15], P1[0], P1[1],   pw1[2] = PKW(P0, 12), pw1[3] = PKW(P0, 14), pw1); \
    VRD(2); SBAR(); GAPA(C0 = MFMA32(kf[4], qr[2], C0),   P1[2], P1[3], P1[4], P1[5],     pw2[0] = PKW(P1, 0), pw2[1] = PKW(P1, 2), pw2); \
    VRD(6); SBAR(); GAPA(C1 = MFMA32(kf[5], qr[2], C1),   P1[6], P1[7], P1[8], P1[9],     pw2[2] = PKW(P1, 4), pw2[3] = PKW(P1, 6), pw2); \
    VRD(3); SBAR(); GAPA(C0 = MFMA32(kf[6], qr[3], C0),   P1[10], P1[11], P1[12], P1[13], pw3[0] = PKW(P1, 8), pw3[1] = PKW(P1, 10), pw3); \
    VRD(7); SBAR(); GAPA(C1 = MFMA32(kf[7], qr[3], C1),   P1[14], P1[15], 0.f, 0.f,       pw3[2] = PKW(P1, 12), pw3[3] = PKW(P1, 14), pw3); \
    l_reg += sacc; \
    if (GK) { DMA_K((t) + 3, sl_cur); } if (GV) { DMA_V((t) + 1, sl_next); } \
    { float a = MX3(C0[0], C0[1], C1[0]), b = MX3(C0[2], C0[3], C1[1]); a = MX3(a, C1[2], C1[3]); \
      _Pragma("unroll") for (int r = 4; r < 16; r += 4) { a = MX3(a, C0[r], C0[r + 1]); b = MX3(b, C0[r + 2], C0[r + 3]); a = MX3(a, C1[r], C1[r + 1]); b = MX3(b, C1[r + 2], C1[r + 3]); } \
      float rm = __builtin_fmaxf(a, b); { auto rr = __builtin_amdgcn_permlane32_swap(__float_as_uint(rm), __float_as_uint(rm), false, false); rm = __builtin_fmaxf(__uint_as_float(rr[0]), __uint_as_float(rr[1])); } \
      resc = false; \
      if (__builtin_expect(__any(rm > (float)THRL), 0)) { const float dl = __builtin_fmaxf(rm, 0.f); mhat += dl; \
        _Pragma("unroll") for (int r = 0; r < 16; ++r) { C0[r] -= dl; C1[r] -= dl; } \
        _Pragma("unroll") for (int r = 0; r < 16; ++r) negm[r] = -mhat; asm volatile("" : "+v"(negm)); \
        const float f = __builtin_amdgcn_exp2f(-dl); l_reg *= f; if (hi == 0) wsf[r32] = f; resc = true; } } \
    SBAR(); \
    GAPB(o[0] = MFMA32(PAF(0), VFR(0), o[0]), C0, 0); \
    GAPB(o[1] = MFMA32(PAF(0), VFR(4), o[1]), C0, 4); \
    KRD(GL, 0); GAPB(o[0] = MFMA32(PAF(1), VFR(1), o[0]), C0, 8); \
    KRD(GL, 1); GAPB(o[1] = MFMA32(PAF(1), VFR(5), o[1]), C0, 12); \
    KRD(GL, 2); GAPB(o[0] = MFMA32(PAF(2), VFR(2), o[0]), C1, 0); \
    KRD(GL, 3); GAPB(o[1] = MFMA32(PAF(2), VFR(6), o[1]), C1, 4); \
    GAPB(o[0] = MFMA32(PAF(3), VFR(3), o[0]), C1, 8); \
    GAPB(o[1] = MFMA32(PAF(3), VFR(7), o[1]), C1, 12); \
    } while (0)
  int t = 1;
  for (; t + 5 < NT; t += 2) {
    STEP(pB0, pB1, pA0, pA1, t, true, true, true);     WAIT_BAR(2); RESC(); ROT();
    STEP(pA0, pA1, pB0, pB1, t + 1, true, true, true); WAIT_BAR(2); RESC(); ROT();
  }
  #define ENDW(tt) do { if ((tt) + 3 < NT) { WAIT_BAR(2); } else if ((tt) + 2 < NT) { WAIT_BAR(1); } else { WAIT_BAR(0); } } while (0)
  for (; t + 1 < NT; t += 2) {
    STEP(pB0, pB1, pA0, pA1, t, (t + 3 < NT), (t + 1 < NT), (t + 1 < NT));       ENDW(t);     RESC(); ROT();
    STEP(pA0, pA1, pB0, pB1, t + 1, (t + 4 < NT), (t + 2 < NT), (t + 2 < NT));   ENDW(t + 1); RESC(); ROT();
  }
  STEP(pB0, pB1, pA0, pA1, NT - 1, false, false, false); RESC();
  { float sacc = pB0[0] + pB0[1]; _Pragma("unroll") for (int r = 2; r < 16; ++r) sacc += pB0[r]; _Pragma("unroll") for (int r = 0; r < 16; ++r) sacc += pB1[r]; l_reg += sacc;
    pw0 = (u32x4){PKW(pB0, 0), PKW(pB0, 2), PKW(pB0, 4), PKW(pB0, 6)}; pw1 = (u32x4){PKW(pB0, 8), PKW(pB0, 10), PKW(pB0, 12), PKW(pB0, 14)}; pw2 = (u32x4){PKW(pB1, 0), PKW(pB1, 2), PKW(pB1, 4), PKW(pB1, 6)}; pw3 = (u32x4){PKW(pB1, 8), PKW(pB1, 10), PKW(pB1, 12), PKW(pB1, 14)};
    SBAR(); pv(o, vb0 + sl_cur, PAF(0), PAF(1), PAF(2), PAF(3)); }
  #undef PKW
  #undef PAF
  #undef VFR
  #undef PIN
  #undef MX3
  #undef GAPA
  #undef GAPB
  #undef EX
  #undef VRD
  #undef KRD
  #undef STEP
  #undef ENDW
  { auto rr = __builtin_amdgcn_permlane32_swap(__float_as_uint(l_reg), __float_as_uint(l_reg), false, false); l_reg = __uint_as_float(rr[0]) + __uint_as_float(rr[1]); }
  if (hi == 0) wsf[32 + r32] = l_reg; asm volatile("s_waitcnt lgkmcnt(0)" ::: "memory");
  float rli[16];
  #pragma unroll
  for (int r = 0; r < 16; ++r) rli[r] = __builtin_amdgcn_rcpf(wsf[32 + crow(r, hi)]);
  bf16* Zw = Zu + (long)(wid * QBLK) * P;
  { bf16* stg = (bf16*)(shm + LDS_OST) + wid * 2048;
    #pragma unroll
    for (int r = 0; r < 16; ++r) { const int orow = crow(r, hi);
      #pragma unroll
      for (int d0 = 0; d0 < 2; ++d0) stg[orow * 64 + d0 * 32 + r32] = __float2bfloat16(o[d0][r] * rli[r]); }
    asm volatile("s_waitcnt lgkmcnt(0)" ::: "memory");
    #pragma unroll
    for (int i = 0; i < 4; ++i) { const int row = i * 8 + (lane >> 3), ch = lane & 7; const u32x4 v = *(const u32x4*)(stg + row * 64 + ch * 8);
      u32x4* zp = (u32x4*)(Zw + (long)row * P + ch * 8); const u32x4 z = *zp; u32x4 w;
      w.x = pk2(bflo(v.x) * silu(bflo(z.x)), bfhi(v.x) * silu(bfhi(z.x))); w.y = pk2(bflo(v.y) * silu(bflo(z.y)), bfhi(v.y) * silu(bfhi(z.y)));
      w.z = pk2(bflo(v.z) * silu(bflo(z.z)), bfhi(v.z) * silu(bfhi(z.z))); w.w = pk2(bflo(v.w) * silu(bflo(z.w)), bfhi(v.w) * silu(bfhi(z.w)));
      *zp = w; } }
  asm volatile("s_waitcnt vmcnt(0) lgkmcnt(0)\n\ts_barrier" ::: "memory");
  #undef DMA_K
  #undef DMA_V
  #undef START
  #undef RESC
  #undef ROT
}
#undef SBAR
#undef WAIT_BAR
}

#define XB_TMO      128
#define XB_XCNT(j)  (256  + 64 * (j))
#define XB_XSUB(j)  (1280 + 64 * (j))
#define XB_XGEN(j)  (2304 + 64 * (j))
#define XB_TOP      3328
#define XB_TOPGEN   3392
#define XCD_BAR_WORDS 3456
#define XB_SPIN_CAP (1u << 20)
__device__ __forceinline__ unsigned xb_ld(unsigned* p)              { return __hip_atomic_load(p, __ATOMIC_RELAXED, __HIP_MEMORY_SCOPE_AGENT); }
__device__ __forceinline__ unsigned xb_add(unsigned* p, unsigned v) { return __hip_atomic_fetch_add(p, v, __ATOMIC_RELAXED, __HIP_MEMORY_SCOPE_AGENT); }
__device__ __forceinline__ unsigned xb_xcc_id() { return (unsigned)__builtin_amdgcn_s_getreg((3 << 11) | 20) & 0xFu; }
#define XB_SPIN(cond, bar) do { unsigned _sp = 0; while (cond) { __builtin_amdgcn_s_sleep(1); \
    if ((++_sp & 255u) == 0u) { if (xb_ld(&(bar)[XB_TMO])) break; if (_sp > XB_SPIN_CAP) { atomicAdd(&(bar)[XB_TMO], 1u); break; } } } } while (0)
struct XcdBarrier { unsigned* bar; unsigned x; volatile LAS unsigned* st; };
__device__ __forceinline__ XcdBarrier xcd_barrier_post(unsigned* bar, volatile LAS unsigned* st) {
    XcdBarrier b; b.bar = bar; b.x = xb_xcc_id(); b.st = st;
    if (threadIdx.x == 0) (void)xb_add(&bar[XB_XCNT(b.x)], 1u);
    return b;
}
__device__ __forceinline__ void xcd_barrier_complete(unsigned* bar, unsigned x, unsigned& nloc, unsigned& nx) {
    const unsigned G = gridDim.x * gridDim.y * gridDim.z;
    unsigned sum, cnt, mine, sp = 0u;
    for (;;) {
        sum = 0u; cnt = 0u; mine = 0u;
#pragma unroll 1
        for (unsigned j = 0; j < 16; ++j) { const unsigned c = xb_ld(&bar[XB_XCNT(j)]); sum += c; cnt += (c > 0u) ? 1u : 0u; mine = (j == x) ? c : mine; }
        if (sum == G) break;
        __builtin_amdgcn_s_sleep(1);
        if ((++sp & 255u) == 0u) { if (xb_ld(&bar[XB_TMO])) break; if (sp > XB_SPIN_CAP) { atomicAdd(&bar[XB_TMO], 1u); break; } }
    }
    nloc = mine > 0u ? mine : 1u; nx = cnt > 0u ? cnt : 1u;
}
__device__ __forceinline__ void xcd_barrier(const XcdBarrier& b) {
    asm volatile("s_waitcnt vmcnt(0)" ::: "memory");
    __syncthreads();
    int t0 = threadIdx.x; asm volatile("" : "+v"(t0));
    if (t0 == 0) {
        unsigned* bar = b.bar;
        __builtin_amdgcn_s_waitcnt(0);
        unsigned nloc = b.st[0], nx = b.st[1];
        if (nloc == 0u) { xcd_barrier_complete(bar, b.x, nloc, nx); b.st[0] = nloc; b.st[1] = nx; }
        const unsigned old = xb_add(&bar[XB_XSUB(b.x)], 1u);
        const unsigned gen = old / nloc;
        if (old + 1u == (gen + 1u) * nloc) {
            __builtin_amdgcn_fence(__ATOMIC_RELEASE, "agent");
            asm volatile("s_waitcnt vmcnt(0)" ::: "memory");
            const unsigned og = xb_add(&bar[XB_TOP], 1u);
            const unsigned tg = og / nx;
            if (og + 1u == (tg + 1u) * nx) xb_add(&bar[XB_TOPGEN], 1u);
            else XB_SPIN(xb_ld(&bar[XB_TOPGEN]) == tg, bar);
            __builtin_amdgcn_fence(__ATOMIC_ACQUIRE, "agent");
            xb_add(&bar[XB_XGEN(b.x)], 1u);
            asm volatile("s_waitcnt vmcnt(0)" ::: "memory");
        } else {
            XB_SPIN(xb_ld(&bar[XB_XGEN(b.x)]) == gen, bar);
            __builtin_amdgcn_fence(__ATOMIC_ACQUIRE, "agent");
            asm volatile("s_waitcnt vmcnt(0)" ::: "memory");
        }
    }
    __syncthreads();
}

struct Args { const float* in[15]; float* out; unsigned char* ws; int ph_lo, ph_hi; };

__device__ __forceinline__ float wave_sum(float v) {
#pragma unroll
    for (int o = 1; o < 64; o <<= 1) v += __shfl_xor(v, o);
    return v;
}

__device__ __forceinline__ void tr_item(const float* W, int ldw, int k0, int n0, bf16_t* dst, int dpitch, const float* gk, float sc, LAS float* scr, int lane) {
    { const int kr = lane >> 3, n4 = (lane & 7) * 4; f32x4 v[8];
#pragma unroll
      for (int i = 0; i < 8; ++i) v[i] = *(const f32x4*)(W + (size_t)(k0 + 8 * i + kr) * ldw + n0 + n4);
#pragma unroll
      for (int i = 0; i < 8; ++i) { const int kk = 8 * i + kr; const float g = (gk ? gk[k0 + kk] : 1.f) * sc;
          scr[kk * 33 + n4] = v[i][0] * g; scr[kk * 33 + n4 + 1] = v[i][1] * g; scr[kk * 33 + n4 + 2] = v[i][2] * g; scr[kk * 33 + n4 + 3] = v[i][3] * g; } }
    asm volatile("s_waitcnt lgkmcnt(0)" ::: "memory");
    const int c = lane & 7;
#pragma unroll
    for (int j = 0; j < 4; ++j) { const int n = (lane >> 3) + 8 * j; const LAS float* s = scr + (8 * c) * 33 + n;
        u32x4 o; o.x = pk2(s[0 * 33], s[1 * 33]); o.y = pk2(s[2 * 33], s[3 * 33]); o.z = pk2(s[4 * 33], s[5 * 33]); o.w = pk2(s[6 * 33], s[7 * 33]);
        *(u32x4*)(dst + (size_t)n * dpitch + 8 * c) = o; }
    asm volatile("s_waitcnt lgkmcnt(0)" ::: "memory");
}
__device__ __forceinline__ int map_col(int n0) {
    if (n0 < 2048) return n0;
    if (n0 < 2080) return C_GL;
    if (n0 < 3104) return C_ZA + (n0 - 2080);
    if (n0 < 4128) return C_QB + (n0 - 3104);
    if (n0 < 4384) return C_KB + (n0 - 4128);
    if (n0 < 4640) return C_VB + (n0 - 4384);
    if (n0 < 5664) return C_ZB + (n0 - 4640);
    if (n0 < 6688) return C_MA + (n0 - 5664);
    return C_MB + (n0 - 6688);
}
constexpr int CV_IN = 16 * 241, CV_SQ = 16 * 32, CV_ITEMS = CV_IN + 3 * CV_SQ;
__device__ __forceinline__ void convert_item(const Args& args, int l, int r, bf16_t* WIN, bf16_t* WBR, bf16_t* WOUT, LAS float* scr, int lane) {
    if (r < CV_IN) { const int kb = r / 241, nb = r % 241, n0 = 32 * nb;
        tr_item(args.in[3] + (size_t)l * DM * IN_DIM, IN_DIM, 64 * kb, n0, WIN + (size_t)l * WIN_L + (size_t)map_col(n0) * DM + 64 * kb, DM, args.in[2] + l * DM, n0 < 512 ? 0.08838834764831845f : 1.f, scr, lane);
        return; }
    r -= CV_IN;
    const int which = r / CV_SQ; r %= CV_SQ; const int kb = r / 32, nb = r % 32;
    if (which == 0) tr_item(args.in[11] + (size_t)l * DM * DM, DM, 64 * kb, 32 * nb, WBR + (size_t)l * DM * 2048 + (size_t)(32 * nb) * 2048 + 64 * kb, 2048, nullptr, 1.f, scr, lane);
    else if (which == 1) tr_item(args.in[12] + (size_t)l * DM * DM, DM, 64 * kb, 32 * nb, WBR + (size_t)l * DM * 2048 + (size_t)(32 * nb) * 2048 + 1024 + 64 * kb, 2048, nullptr, 1.f, scr, lane);
    else tr_item(args.in[13] + (size_t)l * DM * DM, DM, 64 * kb, 32 * nb, WOUT + (size_t)l * DM * DM + (size_t)(32 * nb) * DM + 64 * kb, DM, nullptr, 1.f, scr, lane);
}

__device__ __forceinline__ void x_rows_to_bf16(const float* x, bf16_t* xb, float* ssp, int gw, int ngw, int lane) {
    for (int m = gw; m < NTOK; m += ngw) {
        const f32x4* xr = (const f32x4*)(x + (size_t)m * DM) + lane; f32x4 v[4]; float s = 0.f;
#pragma unroll
        for (int j = 0; j < 4; ++j) { v[j] = xr[64 * j]; s += (v[j].x * v[j].x + v[j].y * v[j].y) + (v[j].z * v[j].z + v[j].w * v[j].w); }
        s = wave_sum(s);
        u32x2* o8 = (u32x2*)(xb + (size_t)m * DM) + lane;
#pragma unroll
        for (int j = 0; j < 4; ++j) { u32x2 w; w.x = pk2(v[j].x, v[j].y); w.y = pk2(v[j].z, v[j].w); o8[64 * j] = w; }
        if (lane < 16) ssp[(size_t)m * 16 + lane] = (lane == 0) ? s : 0.f;
    }
}

constexpr int PL_GL = 0, PL_TOT = 8192, PL_QF = 12288, PL_KF = PL_QF + 17408, PL_QB = PL_KF + 17408, PL_KB = PL_QB + 17408, PL_VT = PL_KB + 17408, PL_A = PL_VT + 36864, PL_END = PL_A + 9216;
static_assert(PL_END <= RING_BYTES, "prep LDS");
struct PrepIn { u32x4 gl[2]; u32x4 v[4]; };
struct PrepW { u32x4 wfrag; float bf, bb; };
__device__ __forceinline__ void gla_prep_loadw(PrepW& w, const float* wgf, const float* bgf, const float* wgb, const float* bgb, int h) {
    int tid = threadIdx.x; asm volatile("" : "+v"(tid)); const int c = tid & 127, lane = tid & 63, wave = tid >> 6, l32 = lane & 31, hh = lane >> 5, dir = wave >> 2, cb = wave & 3;
    const float* wg = (dir ? wgb : wgf) + (size_t)(8 * hh) * 512 + h * 128 + 32 * cb + l32;
    float t[8];
#pragma unroll
    for (int j = 0; j < 8; ++j) t[j] = wg[j * 512];
    w.wfrag = (u32x4){pk2(t[0], t[1]), pk2(t[2], t[3]), pk2(t[4], t[5]), pk2(t[6], t[7])};
    w.bf = bgf[h * 128 + c]; w.bb = bgb[h * 128 + c];
}
__device__ __forceinline__ void gla_prep_load(PrepIn& in, const bf16_t* proj, int gc, int h) {
    int tid = threadIdx.x; asm volatile("" : "+v"(tid));
    const int row0 = gc * 64;
    { const int lane = tid & 63, l32 = lane & 31, hh = lane >> 5, dir = tid >> 8;
#pragma unroll
      for (int tb = 0; tb < 2; ++tb) in.gl[tb] = *(const u32x4*)(proj + (size_t)(row0 + 32 * tb + l32) * LDP + C_GL + 16 * dir + 8 * hh); }
#pragma unroll
    for (int i = 0; i < 4; ++i) { const int idx = tid + 512 * i, t = idx & 63, dv = (idx >> 6) * 8; in.v[i] = *(const u32x4*)(proj + (size_t)(row0 + t) * LDP + C_VA + h * 256 + dv); }
}
__device__ __forceinline__ void gla_prep_tile(LAS unsigned char* lds, const PrepIn& in, const PrepW& pw, int gc, int h, bf16_t* proj,
                                              float* ef, float* eb, bf16_t* kltf, bf16_t* kltb, bf16_t* vtg, bf16_t* pst, int rmask) {
    int tid = threadIdx.x; asm volatile("" : "+v"(tid));
    const int lane = tid & 63, wave = tid >> 6, c = tid & 127, s = tid >> 7, l32 = lane & 31, hh = lane >> 5;
    const int row0 = gc * 64;
    LAS float* TOT = (LAS float*)(lds + PL_TOT);
    LAS bf16_t* QFl = (LAS bf16_t*)(lds + PL_QF); LAS bf16_t* KFl = (LAS bf16_t*)(lds + PL_KF); LAS bf16_t* QBl = (LAS bf16_t*)(lds + PL_QB); LAS bf16_t* KBl = (LAS bf16_t*)(lds + PL_KB);
    LAS bf16_t* VTl = (LAS bf16_t*)(lds + PL_VT); LAS bf16_t* Al = (LAS bf16_t*)(lds + PL_A);
    { LAS float* ZL = (LAS float*)(lds + PL_QF);
      const int dir = wave >> 2, cb = wave & 3;
#pragma unroll
      for (int tb = 0; tb < 2; ++tb) { const f32x16 z = MFMA32(__builtin_bit_cast(bf16x8, in.gl[tb]), __builtin_bit_cast(bf16x8, pw.wfrag), f32x16{});
#pragma unroll
          for (int r = 0; r < 16; ++r) ZL[(dir * 64 + 32 * tb + crow(r, hh)) * 128 + 32 * cb + l32] = z[r]; } }
#pragma unroll
    for (int i = 0; i < 4; ++i) { const int idx = tid + 512 * i, t = idx & 63, dv = (idx >> 6) * 8;
        const u32x4 v = in.v[i];
        VTl[(dv + 0) * 72 + t] = (bf16_t)(v.x & 0xffffu); VTl[(dv + 1) * 72 + t] = (bf16_t)(v.x >> 16);
        VTl[(dv + 2) * 72 + t] = (bf16_t)(v.y & 0xffffu); VTl[(dv + 3) * 72 + t] = (bf16_t)(v.y >> 16);
        VTl[(dv + 4) * 72 + t] = (bf16_t)(v.z & 0xffffu); VTl[(dv + 5) * 72 + t] = (bf16_t)(v.z >> 16);
        VTl[(dv + 6) * 72 + t] = (bf16_t)(v.w & 0xffffu); VTl[(dv + 7) * 72 + t] = (bf16_t)(v.w >> 16); }
    const float bfv = pw.bf, bbv = pw.bb;
    bf16_t qraw[16], kraw[16];
#pragma unroll
    for (int j = 0; j < 16; ++j) { qraw[j] = proj[(size_t)(row0 + 16 * s + j) * LDP + C_QA + h * 128 + c]; kraw[j] = proj[(size_t)(row0 + 16 * s + j) * LDP + C_KA + h * 128 + c]; }
    LDS_BARRIER();
    float pf[16], sb[16];
#pragma unroll
    for (int j = 0; j < 16; ++j) { const int t = 16 * s + j; const LAS float* ZL = (const LAS float*)(lds + PL_QF);
        const float zf = bfv + ZL[t * 128 + c], zb = bbv + ZL[(64 + t) * 128 + c];
        pf[j] = logsig(zf) * (1.f / 16.f); sb[j] = logsig(zb) * (1.f / 16.f); }
#pragma unroll
    for (int j = 1; j < 16; ++j) pf[j] += pf[j - 1];
#pragma unroll
    for (int j = 14; j >= 0; --j) sb[j] += sb[j + 1];
    TOT[(0 * 4 + s) * 128 + c] = pf[15]; TOT[(1 * 4 + s) * 128 + c] = sb[0];
    LDS_BARRIER();
    float offf = 0.f, allf = 0.f, offb = 0.f, allb = 0.f;
#pragma unroll
    for (int s2 = 0; s2 < 4; ++s2) { const float a = TOT[(0 * 4 + s2) * 128 + c], b = TOT[(1 * 4 + s2) * 128 + c]; allf += a; allb += b; if (s2 < s) offf += a; if (s2 > s) offb += b; }
    const float etf = fexp(allf), etb = fexp(allb);
    if (s == 0) { ef[(size_t)(gc * 4 + h) * 128 + c] = etf; eb[(size_t)(gc * 4 + h) * 128 + c] = etb; }
    unsigned klf[8], klb[8];
#pragma unroll
    for (int j = 0; j < 16; j += 2) {
        float o_klf[2], o_klb[2];
#pragma unroll
        for (int e = 0; e < 2; ++e) { const int t = 16 * s + j + e;
            const float q = bf2f(qraw[j + e]), k = bf2f(kraw[j + e]);
            const float bfw = offf + pf[j + e], bbw = offb + sb[j + e];
            const float Ef = fexp(bfw), Eb = fexp(bbw), rEf = __builtin_amdgcn_rcpf(Ef), rEb = __builtin_amdgcn_rcpf(Eb);
            const bf16_t qsf = f2bf(q * Ef), ksf = f2bf(k * rEf), qsb = f2bf(q * Eb), ksb = f2bf(k * rEb);
            o_klf[e] = k * (rEf * etf); o_klb[e] = k * (rEb * etb);
            pst[(size_t)((row0 + t) & rmask) * LDP + C_QA + h * 128 + c] = qsf; pst[(size_t)((row0 + t) & rmask) * LDP + C_KA + h * 128 + c] = qsb;
            QFl[t * 136 + c] = qsf; KFl[t * 136 + c] = ksf; QBl[t * 136 + c] = qsb; KBl[t * 136 + c] = ksb; }
        klf[j >> 1] = pk2(o_klf[0], o_klf[1]); klb[j >> 1] = pk2(o_klb[0], o_klb[1]);
    }
    { u32x4* d = (u32x4*)(kltf + ((size_t)(gc * 4 + h) * 128 + c) * 64 + 16 * s); d[0] = (u32x4){klf[0], klf[1], klf[2], klf[3]}; d[1] = (u32x4){klf[4], klf[5], klf[6], klf[7]};
      u32x4* d2 = (u32x4*)(kltb + ((size_t)(gc * 4 + h) * 128 + c) * 64 + 16 * s); d2[0] = (u32x4){klb[0], klb[1], klb[2], klb[3]}; d2[1] = (u32x4){klb[4], klb[5], klb[6], klb[7]}; }
    LDS_BARRIER();
    { const int dir = wave >> 2, bi = (wave >> 1) & 1, bj = wave & 1;
      const LAS bf16_t* Qt = dir ? QBl : QFl; const LAS bf16_t* Kt = dir ? KBl : KFl;
      f32x16 acc = f32x16{};
#pragma unroll
      for (int ks = 0; ks < 8; ++ks) { const bf16x8 a = *(const LAS bf16x8*)(Qt + (32 * bi + l32) * 136 + 16 * ks + 8 * hh); const bf16x8 b = *(const LAS bf16x8*)(Kt + (32 * bj + l32) * 136 + 16 * ks + 8 * hh); acc = MFMA32(a, b, acc); }
      const int jj = 32 * bj + l32;
#pragma unroll
      for (int r = 0; r < 16; ++r) { const int ii = 32 * bi + crow(r, hh); const bool keep = dir ? (jj > ii) : (jj <= ii); if (keep) Al[ii * 72 + jj] = f2bf(acc[r]); } }
    LDS_BARRIER();
    {
#pragma unroll
      for (int tb = 0; tb < 2; ++tb) { f32x16 acc = f32x16{};
#pragma unroll
        for (int ks = 0; ks < 4; ++ks) { const bf16x8 a = *(const LAS bf16x8*)(VTl + (32 * wave + l32) * 72 + 16 * ks + 8 * hh); const bf16x8 b = *(const LAS bf16x8*)(Al + (32 * tb + l32) * 72 + 16 * ks + 8 * hh); acc = MFMA32(a, b, acc); }
        bf16_t* op = pst + (size_t)((row0 + 32 * tb + l32) & rmask) * LDP + C_VA + h * 256 + 32 * wave + 4 * hh;
#pragma unroll
        for (int g = 0; g < 4; ++g) { u32x2 w; w.x = pk2(acc[4 * g], acc[4 * g + 1]); w.y = pk2(acc[4 * g + 2], acc[4 * g + 3]); *(u32x2*)(op + 8 * g) = w; } }
#pragma unroll
      for (int i = 0; i < 4; ++i) { const int idx = tid + 512 * i, dv = idx >> 3, tg = idx & 7;
        *(u32x4*)(vtg + ((size_t)(gc * 4 + h) * 256 + dv) * 64 + 8 * tg) = *(const LAS u32x4*)(VTl + dv * 72 + 8 * tg); } }
    LDS_BARRIER();
}

template <int NB>
__device__ __forceinline__ void qk_norm_items(bf16_t* proj, int it0, int itstride, int nitems, int T, const float* qg, const float* kg, const float* tabc, const float* tabs, int lane, bf16_t* pst, int rmask) {
    const int li = lane & 15, d0 = 4 * li, half = li >> 3, within = li & 7; const bool first = within < 4;
    bf16_t* p[NB]; bf16_t* pw[NB]; u32x2 u[NB]; f32x4 c4[NB], s4[NB]; bool isq[NB], ok[NB];
#pragma unroll
    for (int i = 0; i < NB; ++i) { const int it = it0 + i * itstride; ok[i] = it < nitems; const int itc = ok[i] ? it : 0; const int row = itc, grp = 4; isq[i] = false;
        p[i] = proj + (size_t)row * LDP + (grp < 4 ? C_QB + 256 * grp : C_KB) + 4 * lane; pw[i] = pst + (size_t)(row & rmask) * LDP + (grp < 4 ? C_QB + 256 * grp : C_KB) + 4 * lane; u[i] = *(const u32x2*)p[i];
        const int t = row % T; const int pos = half ? (t & 63) : (t >> 6);
        c4[i] = *(const f32x4*)(tabc + pos * 16 + 4 * (within & 3)); s4[i] = *(const f32x4*)(tabs + pos * 16 + 4 * (within & 3)); }
    const f32x4 gq = *(const f32x4*)(qg + d0), gk = *(const f32x4*)(kg + d0);
#pragma unroll
    for (int i = 0; i < NB; ++i) {
        float x[4] = {bflo(u[i].x), bfhi(u[i].x), bflo(u[i].y), bfhi(u[i].y)};
        float ss = (x[0] * x[0] + x[1] * x[1]) + (x[2] * x[2] + x[3] * x[3]);
        ss += __shfl_xor(ss, 1); ss += __shfl_xor(ss, 2); ss += __shfl_xor(ss, 4); ss += __shfl_xor(ss, 8);
        const float rs = __builtin_amdgcn_rsqf(ss * (1.f / 64.f) + EPS);
        const f32x4 g4 = isq[i] ? gq : gk; const float sc = isq[i] ? C2 : 1.f;
        float o[4];
#pragma unroll
        for (int e = 0; e < 4; ++e) { const float xn = x[e] * rs * g4[e]; const float pr = __shfl_xor(xn, 4);
            o[e] = (first ? (xn * c4[i][e] - pr * s4[i][e]) : (xn * c4[i][e] + pr * s4[i][e])) * sc; }
        u32x2 w; w.x = pk2(o[0], o[1]); w.y = pk2(o[2], o[3]); if (ok[i]) *(u32x2*)pw[i] = w;
    }
}

constexpr int CH_CB = 36864, CH_OFFK = 17408, CH_OFFE = 17408 + 18432;
__device__ __forceinline__ void gla_chain(LAS unsigned char* lds, int ci, int nchunk, bf16_t* proj, const bf16_t* kltf, const bf16_t* kltb, const bf16_t* vtg, const float* ef, const float* eb, bf16_t* ob, bf16_t* of2, unsigned* done, bf16_t* dry = nullptr) {
    int tid = threadIdx.x; asm volatile("" : "+v"(tid));
    const int lane = tid & 63, wave = __builtin_amdgcn_readfirstlane(tid >> 6);
    const int dir = ci & 1, bh = ci >> 1, b = bh >> 2, h = bh & 3, l32 = lane & 31, hh = lane >> 5;
    const bf16_t* klt = dir ? kltb : kltf; const float* ee = dir ? eb : ef;
    const int qcol = (dir ? C_KA : C_QA) + h * 128;
    const int qt0 = tid >> 4, qc0 = tid & 15;
    const int kd0 = tid >> 3, kc0 = tid & 7;
    f32x16 S[4];
#pragma unroll
    for (int i = 0; i < 4; ++i) S[i] = f32x16{};
#define CH_GC(st) (b * nchunk + (dir ? (nchunk - 1 - (st)) : (st)))
#define CH_CLAMP(st) ((st) < nchunk ? (st) : nchunk - 1)
#define CH_LOAD_T(SET, st) do { const int gc_ = CH_GC(CH_CLAMP(st)); \
        q0##SET = *(const u32x4*)(proj + (size_t)(gc_ * 64 + qt0) * LDP + qcol + qc0 * 8); q1##SET = *(const u32x4*)(proj + (size_t)(gc_ * 64 + qt0 + 32) * LDP + qcol + qc0 * 8); \
        const bf16_t* kb_ = klt + (size_t)(gc_ * 4 + h) * 128 * 64; \
        k0##SET = *(const u32x4*)(kb_ + (size_t)kd0 * 64 + kc0 * 8); k1##SET = *(const u32x4*)(kb_ + (size_t)(kd0 + 64) * 64 + kc0 * 8); \
        if (tid < 32) en##SET = *(const f32x4*)(ee + (size_t)(gc_ * 4 + h) * 128 + tid * 4); } while (0)
#define CH_LOAD_V(SET, st) do { const int gc_ = CH_GC(CH_CLAMP(st)); _Pragma("unroll") for (int ks = 0; ks < 4; ++ks) vf##SET[ks] = *(const bf16x8*)(vtg + ((size_t)(gc_ * 4 + h) * 256 + 32 * wave + l32) * 64 + 16 * ks + 8 * hh); } while (0)
#define CH_STAGE(SET, buf) do { *(LAS u32x4*)((buf) + qt0 * 272 + qc0 * 16) = q0##SET; *(LAS u32x4*)((buf) + (qt0 + 32) * 272 + qc0 * 16) = q1##SET; \
        *(LAS u32x4*)((buf) + CH_OFFK + kd0 * 144 + kc0 * 16) = k0##SET; *(LAS u32x4*)((buf) + CH_OFFK + (kd0 + 64) * 144 + kc0 * 16) = k1##SET; \
        if (tid < 32) *(LAS f32x4*)((buf) + CH_OFFE + tid * 16) = en##SET; } while (0)
    u32x4 q0A, q1A, k0A, k1A, q0B, q1B, k0B, k1B; f32x4 enA = (f32x4){0.f, 0.f, 0.f, 0.f}, enB = enA; bf16x8 vfA[4], vfB[4];
    CH_LOAD_T(A, 0); CH_LOAD_V(A, 0);
    CH_STAGE(A, lds);
    CH_LOAD_T(B, 1); CH_LOAD_V(B, 1);
    __syncthreads();
#define CH_LDQ(bufi, blk_) do { _Pragma("unroll") for (int s_ = 0; s_ < 2; ++s_) _Pragma("unroll") for (int tb_ = 0; tb_ < 2; ++tb_) { \
        const LAS unsigned char* qp_ = cur + (32 * tb_ + l32) * 272 + (32 * (blk_) + 16 * s_ + 4 * hh) * 2; \
        const u32x2 lo_ = *(const LAS u32x2*)qp_, hi_ = *(const LAS u32x2*)(qp_ + 16); qv[bufi][s_][tb_] = (u32x4){lo_.x, lo_.y, hi_.x, hi_.y}; } } while (0)
#define CH_LDE(bufi, blk_) do { _Pragma("unroll") for (int g_ = 0; g_ < 4; ++g_) evv[bufi][g_] = *(const LAS f32x4*)(cur + CH_OFFE + (32 * (blk_) + 8 * g_ + 4 * hh) * 4); } while (0)
#define CH_LDK(bufi, blk_) do { _Pragma("unroll") for (int ks_ = 0; ks_ < 4; ++ks_) kfv[bufi][ks_] = *(const LAS bf16x8*)(cur + CH_OFFK + (32 * (blk_) + l32) * 144 + (16 * ks_ + 8 * hh) * 2); } while (0)
#define CH_STEP(st, CUR, NXT) do { \
        const int gc = CH_GC(st), row0 = gc * 64; \
        LAS unsigned char* cur = lds + ((st) & 1) * CH_CB; LAS unsigned char* nxt = lds + (((st) + 1) & 1) * CH_CB; \
        CH_LOAD_T(CUR, (st) + 2); \
        f32x16 ot[2]; ot[0] = f32x16{}; ot[1] = f32x16{}; \
        u32x4 qv[2][2][2]; bf16x8 kfv[2][4]; \
        CH_LDQ(0, 0); \
        _Pragma("unroll") for (int blk = 0; blk < 4; ++blk) { \
            if (blk < 3) { CH_LDQ((blk + 1) & 1, blk + 1); } else { CH_LDK(0, 0); } \
            __builtin_amdgcn_sched_barrier(0); \
            _Pragma("unroll") for (int s = 0; s < 2; ++s) { \
                u32x4 pa; pa.x = pk2(S[blk][8 * s + 0], S[blk][8 * s + 1]); pa.y = pk2(S[blk][8 * s + 2], S[blk][8 * s + 3]); pa.z = pk2(S[blk][8 * s + 4], S[blk][8 * s + 5]); pa.w = pk2(S[blk][8 * s + 6], S[blk][8 * s + 7]); \
                const bf16x8 sa = __builtin_bit_cast(bf16x8, pa); \
                _Pragma("unroll") for (int tb = 0; tb < 2; ++tb) ot[tb] = MFMA32(sa, __builtin_bit_cast(bf16x8, qv[blk & 1][s][tb]), ot[tb]); } \
            __builtin_amdgcn_sched_barrier(0); } \
        _Pragma("unroll") for (int blk = 0; blk < 4; ++blk) _Pragma("unroll") for (int g = 0; g < 4; ++g) { const f32x4 ev = *(const LAS f32x4*)(cur + CH_OFFE + (32 * blk + 8 * g + 4 * hh) * 4); \
            S[blk][4 * g] *= ev[0]; S[blk][4 * g + 1] *= ev[1]; S[blk][4 * g + 2] *= ev[2]; S[blk][4 * g + 3] *= ev[3]; } \
        __builtin_amdgcn_sched_barrier(0); \
        _Pragma("unroll") for (int blk = 0; blk < 4; ++blk) { \
            if (blk < 3) { CH_LDK((blk + 1) & 1, blk + 1); } \
            __builtin_amdgcn_sched_barrier(0); \
            _Pragma("unroll") for (int ks = 0; ks < 4; ++ks) S[blk] = MFMA32(kfv[blk & 1][ks], vf##CUR[ks], S[blk]); \
            __builtin_amdgcn_sched_barrier(0); } \
        CH_LOAD_V(CUR, (st) + 2); \
        { bf16_t* obase = dry ? dry : (dir ? ob : of2); const int rmk = dry ? 4095 : -1; \
          _Pragma("unroll") for (int tb = 0; tb < 2; ++tb) { bf16_t* op = obase + (size_t)((row0 + 32 * tb + l32) & rmk) * DM + h * 256 + 32 * wave + 4 * hh; \
            _Pragma("unroll") for (int g = 0; g < 4; ++g) { u32x2 w; w.x = pk2(ot[tb][4 * g], ot[tb][4 * g + 1]); w.y = pk2(ot[tb][4 * g + 2], ot[tb][4 * g + 3]); *(u32x2*)(op + 8 * g) = w; } } } \
        CH_STAGE(NXT, nxt); \
        LDS_BARRIER(); } while (0)
    for (int step = 0; step < nchunk; step += 2) {
        CH_STEP(step, A, B);
        CH_STEP(step + 1, B, A);
    }
    if (done) {
        asm volatile("s_waitcnt vmcnt(0)" ::: "memory");
        __syncthreads();
        if (tid == 0) { __builtin_amdgcn_fence(__ATOMIC_RELEASE, "agent"); asm volatile("s_waitcnt vmcnt(0)" ::: "memory"); (void)xb_add(done + 64 * b, 1u); }
    }
#undef CH_GC
#undef CH_CLAMP
#undef CH_LOAD_T
#undef CH_LOAD_V
#undef CH_STAGE
#undef CH_STEP
#undef CH_LDQ
#undef CH_LDE
#undef CH_LDK
}

template <int NB>
__device__ __forceinline__ void ua_items(bf16_t* proj, const bf16_t* ob, const bf16_t* of2, int it0, int itstride, const float* gn, int lane, bf16_t* pst, int rmask) {
    u32x2 a[NB], b[NB], f[NB], z[NB]; bf16_t* zp[NB]; bool ok[NB];
#pragma unroll
    for (int i = 0; i < NB; ++i) { const int itr = it0 + i * itstride; ok[i] = itr < NTOK * 4; const int it = ok[i] ? itr : 0, row = it >> 2, h = it & 3;
        a[i] = *(const u32x2*)(proj + (size_t)row * LDP + C_VA + h * 256 + 4 * lane); b[i] = *(const u32x2*)(ob + (size_t)row * DM + h * 256 + 4 * lane); f[i] = *(const u32x2*)(of2 + (size_t)row * DM + h * 256 + 4 * lane);
        zp[i] = pst + (size_t)(row & rmask) * LDP + C_ZA + h * 256 + 4 * lane; z[i] = *(const u32x2*)(proj + (size_t)row * LDP + C_ZA + h * 256 + 4 * lane); }
    const f32x4 g4 = *(const f32x4*)(gn + 4 * lane);
#pragma unroll
    for (int i = 0; i < NB; ++i) {
        float o[4] = {bflo(a[i].x) + bflo(b[i].x) + bflo(f[i].x), bfhi(a[i].x) + bfhi(b[i].x) + bfhi(f[i].x), bflo(a[i].y) + bflo(b[i].y) + bflo(f[i].y), bfhi(a[i].y) + bfhi(b[i].y) + bfhi(f[i].y)};
        const float ss = wave_sum((o[0] * o[0] + o[1] * o[1]) + (o[2] * o[2] + o[3] * o[3]));
        const float rs = __builtin_amdgcn_rsqf(ss * (1.f / 256.f) + EPS);
        u32x2 w; w.x = pk2(o[0] * rs * g4[0] * silu(bflo(z[i].x)), o[1] * rs * g4[1] * silu(bfhi(z[i].x))); w.y = pk2(o[2] * rs * g4[2] * silu(bflo(z[i].y)), o[3] * rs * g4[3] * silu(bfhi(z[i].y)));
        if (ok[i]) *(u32x2*)zp[i] = w;
    }
}

__global__ void __launch_bounds__(512, 2) hybrid_fwd(Args args) {
    extern __shared__ __attribute__((aligned(16))) unsigned char lds[];
    LAS unsigned char* L = (LAS unsigned char*)lds;
    volatile LAS int* MISC = (volatile LAS int*)(L + MISC_OFF);
    cg::grid_group grid = cg::this_grid();
    if (threadIdx.x < 32) MISC[threadIdx.x] = 0;
    __syncthreads();
    const XcdBarrier xbar = xcd_barrier_post((unsigned*)(args.ws + WS_CTL) + 4096, (volatile LAS unsigned*)(MISC + 8));
    for (int ph = args.ph_lo; ph < args.ph_hi; ++ph) {
        int tid = threadIdx.x; asm volatile("" : "+v"(tid));
        const int lane = tid & 63, wave = __builtin_amdgcn_readfirstlane(tid >> 6);
        int G = gridDim.x, bid = blockIdx.x; asm volatile("" : "+s"(G), "+s"(bid));
        const int gw = bid * 8 + wave, ngw = G * 8;
        size_t zoff = 0; asm volatile("" : "+s"(zoff));
        unsigned char* ws = args.ws + zoff;
#define AIN(i) (args.in[i])
        float* aout = args.out;
        unsigned* ctl = (unsigned*)(ws + WS_CTL);
        float* tabc = (float*)(ws + WS_TAB); float* tabs = tabc + 1024;
        bf16_t* WIN = (bf16_t*)(ws + WS_WIN); bf16_t* WBR = (bf16_t*)(ws + WS_WBR); bf16_t* WOUT = (bf16_t*)(ws + WS_WOUT);
        bf16_t* proj = (bf16_t*)(ws + WS_PROJ); bf16_t* xb = (bf16_t*)(ws + WS_XB); float* ssp = (float*)(ws + WS_SSP);
        float* ef = (float*)(ws + WS_EF); float* eb = (float*)(ws + WS_EB);
        bf16_t* kltf = (bf16_t*)(ws + WS_KLTF); bf16_t* kltb = (bf16_t*)(ws + WS_KLTB); bf16_t* vtg = (bf16_t*)(ws + WS_VT); bf16_t* of2 = (bf16_t*)(ws + WS_OF2);
        if (ph == 0) {
          {
            LAS float* scr = (LAS float*)(L + wave * 16384);
            for (int it = gw; it < CV_ITEMS; it += ngw) convert_item(args, 0, it, WIN, WBR, WOUT, scr, lane);
            for (int i = bid * 512 + tid; i < DEPTH * 224 * 128; i += G * 512) { const int l = i / (224 * 128), r = i % (224 * 128);
                *(u32x4*)(WIN + (size_t)l * WIN_L + (size_t)IN_DIM * DM + (size_t)r * 8) = (u32x4){0u, 0u, 0u, 0u}; }
            for (int i = bid * 512 + tid; i < 1024; i += G * 512) { const int pos = i >> 4, fi = i & 15;
                const float inv = __builtin_amdgcn_exp2f(-(float)fi * (13.287712379549449f / 16.f)); const float ang = (float)pos * inv;
                float rev = ang * 0.15915494309189535f; rev -= floorf(rev);
                tabc[i] = __builtin_amdgcn_cosf(rev); tabs[i] = __builtin_amdgcn_sinf(rev); }
            x_rows_to_bf16(AIN(0), xb, ssp, gw, ngw, lane);
          }
        } else if (ph == 25 || ph == 50) {
            const int grp = ph == 50; float* xo = aout + (size_t)grp * NTOK * DM; const float* gf = AIN(14);
            for (int m0 = gw; m0 < NTOK; m0 += 2 * ngw) { const int m1 = (m0 + ngw < NTOK) ? m0 + ngw : m0;
                f32x4* xr0 = (f32x4*)(xo + (size_t)m0 * DM) + lane; f32x4* xr1 = (f32x4*)(xo + (size_t)m1 * DM) + lane; f32x4 v0[4], v1[4]; float s0 = 0.f, s1 = 0.f;
#pragma unroll
                for (int j = 0; j < 4; ++j) { v0[j] = xr0[64 * j]; v1[j] = xr1[64 * j]; }
#pragma unroll
                for (int j = 0; j < 4; ++j) { s0 += (v0[j].x * v0[j].x + v0[j].y * v0[j].y) + (v0[j].z * v0[j].z + v0[j].w * v0[j].w); s1 += (v1[j].x * v1[j].x + v1[j].y * v1[j].y) + (v1[j].z * v1[j].z + v1[j].w * v1[j].w); }
                const float rs0 = __builtin_amdgcn_rsqf(wave_sum(s0) * (1.f / 1024.f) + EPS), rs1 = __builtin_amdgcn_rsqf(wave_sum(s1) * (1.f / 1024.f) + EPS);
#pragma unroll
                for (int j = 0; j < 4; ++j) { const f32x4 g4 = *((const f32x4*)gf + lane + 64 * j); xr0[64 * j] = v0[j] * rs0 * g4; if (m1 != m0) xr1[64 * j] = v1[j] * rs1 * g4; } }
            if (grp == 0) x_rows_to_bf16(AIN(1), xb, ssp, gw, ngw, lane);
        } else {
            const int q = (ph < 25) ? ph - 1 : ph - 26; const int grp = ph > 25, l = q / 6, sub = q % 6;
            const int T = grp ? 2048 : 4096, nB = grp ? 8 : 4, nchunk = T / 64;
            float* xres = aout + (size_t)grp * NTOK * DM;
            if (sub == 0) {
                pg8::Gemm g{xb, WIN + (size_t)l * WIN_L, DM, DM, DM, 0}; pg8::StaticOrder S; S.init(NTOK, LDP, G, bid);
                pg8::EpiProj E{proj, ssp};
                pg8::gemm_phase<pg8::EpiProj>(L, g, S, E);
            } else if (sub == 1) {
                { PrepIn pin; gla_prep_load(pin, proj, bid >> 2, bid & 3); PrepW pw; int hcur = bid & 3; gla_prep_loadw(pw, AIN(4) + (size_t)l * 16 * 512, AIN(5) + l * 512, AIN(6) + (size_t)l * 16 * 512, AIN(7) + l * 512, hcur);
                  for (int tile = bid; tile < 1024; tile += G) { PrepIn pnx; const int tn = (tile + G < 1024) ? tile + G : tile; gla_prep_load(pnx, proj, tn >> 2, tn & 3);
                    if ((tile & 3) != hcur) { hcur = tile & 3; gla_prep_loadw(pw, AIN(4) + (size_t)l * 16 * 512, AIN(5) + l * 512, AIN(6) + (size_t)l * 16 * 512, AIN(7) + l * 512, hcur); }
                    gla_prep_tile(L, pin, pw, tile >> 2, tile & 3, proj, ef, eb, kltf, kltb, vtg, proj, -1);
                    pin = pnx; } }
                for (int it = gw; it < NTOK; it += 8 * ngw) qk_norm_items<8>(proj, it, ngw, NTOK, T, AIN(9) + l * 64, AIN(10) + l * 64, tabc, tabs, lane, proj, -1);
            } else if (sub == 2) {
                const int nchain = nB * 4 * 2, nqb = T / 256, natt = nB * 16 * nqb, nua = NTOK * 4 / 64, ncv = (grp == 0 && l < 3) ? (CV_ITEMS + 7) / 8 : 0, total = nchain + natt + nua + ncv;
                unsigned* done = ctl + 8192 + 64 * ((grp * 4 + l) * 8);
                if (tid == 0) MISC[2] = 0;
                unsigned* ctr = ctl + 64 * (grp * 4 + l);
                if (tid == 0) MISC[0] = (int)atomicAdd(ctr, 1u);
                for (;;) {
                    __syncthreads();
                    const int idx = MISC[0];
                    __syncthreads();
                    if (idx >= total) break;
                    int nxti = 0; if (tid == 0) nxti = (int)atomicAdd(ctr, 1u);
                    if (idx >= nchain + natt && idx < nchain + natt + nua) {
                        const int j = idx - nchain - natt, bq = (j * 16) / T;
                        if (tid == 0 && !((MISC[2] >> bq) & 1)) {
                            unsigned sp = 0; while (xb_ld(done + 64 * bq) < 8u) { __builtin_amdgcn_s_sleep(2); if (++sp > (1u << 24)) break; }
                            __builtin_amdgcn_fence(__ATOMIC_ACQUIRE, "agent"); asm volatile("s_waitcnt vmcnt(0)" ::: "memory");
                            MISC[2] = MISC[2] | (1 << bq); }
                        __syncthreads();
                        { int ln = threadIdx.x; asm volatile("" : "+v"(ln)); const int wv = __builtin_amdgcn_readfirstlane(ln >> 6); ln &= 63;
                          ua_items<8>(proj, xb, of2, 64 * j + wv, 8, AIN(8) + l * 256, ln, proj, -1); }
                        if (tid == 0) MISC[0] = nxti; continue; }
                    if (idx >= nchain + natt + nua) { int ln = threadIdx.x; asm volatile("" : "+v"(ln)); const int wv = __builtin_amdgcn_readfirstlane(ln >> 6); ln &= 63; const int r = (idx - nchain - natt - nua) * 8 + wv; if (r < CV_ITEMS) convert_item(args, l + 1, r, WIN, WBR, WOUT, (LAS float*)(L + wv * 16384), ln); if (tid == 0) MISC[0] = nxti; continue; }
                    if (idx < nchain) gla_chain(L, idx, nchunk, proj, kltf, kltb, vtg, ef, eb, xb, of2, done);
                    else
                    {
 const int u = idx - nchain; const int g4 = u & 3, qb = (u >> 2) % nqb, bk = (u >> 2) / nqb, kvh = bk & 3, b = bk >> 2, hq = kvh * 4 + g4;
                        const size_t rb = (size_t)b * T;
                        attn_body::attn_unit<8>((const attn_body::bf16*)(proj + (rb + (size_t)qb * 256) * LDP + C_QB + hq * 64), (const attn_body::bf16*)(proj + rb * LDP + C_KB + kvh * 64),
                                                (const attn_body::bf16*)(proj + rb * LDP + C_VB + kvh * 64), (attn_body::bf16*)(proj + (rb + (size_t)qb * 256) * LDP + C_ZB + hq * 64), T / 64, (char*)lds, AIN(9) + l * 64, tabc, tabs, qb * 256);
                    }
                    if (tid == 0) MISC[0] = nxti;
                }
            } else if (sub == 3) {
            } else if (sub == 4) {
                pg8::StaticOrder S; S.init(NTOK, DM, G, bid);
                { pg8::Gemm g{proj + C_ZA, WBR + (size_t)l * DM * 2048, LDP, 2048, DM, 2048}; pg8::PairOrder S2{S}; pg8::EpiBranchPair E{proj};
                  pg8::gemm_phase<pg8::EpiBranchPair, true, pg8::PairOrder>(L, g, S2, E); }
            } else {
                pg8::Gemm g{proj + C_MA, WOUT + (size_t)l * DM * DM, LDP, DM, DM, 0}; pg8::StaticOrder S; S.init(NTOK, DM, G, bid);
                pg8::EpiOut E{l == 0 ? AIN(grp) : xres, xres, xb, ssp, -1};
                pg8::gemm_phase<pg8::EpiOut>(L, g, S, E);
            }
        }
        { const int qq = (ph < 25) ? ph - 1 : ph - 26; const bool empty = ph != 0 && ph != 25 && ph != 50 && (qq % 6) == 3;
          if (ph + 1 < args.ph_hi && !empty) { if (args.ph_hi > NPHASE) grid.sync(); else xcd_barrier(xbar); } }
    }
}

extern "C" void kernel_launch(void* const* d_in, const int* in_sizes, int n_in, void* d_out, int out_size, void* d_ws, size_t ws_size, hipStream_t stream) {
    static int grid = 0;
    if (grid == 0) {
        if (n_in != 15 || ws_size < WS_END || out_size != 2 * NTOK * DM) { fprintf(stderr, "kernel_launch: unexpected shapes (n_in %d, ws %zu, out %d)\n", n_in, ws_size, out_size); grid = -1; return; }
        if (hipFuncSetAttribute((const void*)hybrid_fwd, hipFuncAttributeMaxDynamicSharedMemorySize, LDS_BYTES) != hipSuccess) { fprintf(stderr, "kernel_launch: hipFuncSetAttribute failed\n"); grid = -1; return; }
        int dev = 0, cus = 0, per_cu = 0;
        hipGetDevice(&dev); hipDeviceGetAttribute(&cus, hipDeviceAttributeMultiprocessorCount, dev);
        hipOccupancyMaxActiveBlocksPerMultiprocessor(&per_cu, (const void*)hybrid_fwd, 512, LDS_BYTES);
        if (per_cu < 1) { fprintf(stderr, "kernel_launch: occupancy query says %d blocks per CU\n", per_cu); (void)hipGetLastError(); }
        grid = cus;
    }
    if (grid < 0) return;
    (void)hipMemsetAsync((char*)d_ws + WS_CTL, 0, CTL_BYTES, stream);
    Args a{};
    for (int i = 0; i < 15; ++i) a.in[i] = (const float*)d_in[i];
    a.out = (float*)d_out; a.ws = (unsigned char*)d_ws; a.ph_lo = 0; a.ph_hi = NPHASE;
    void* kargs[] = {&a};
    hipError_t e = hipLaunchCooperativeKernel((const void*)hybrid_fwd, dim3(grid), dim3(512), kargs, LDS_BYTES, stream);
    if (e != hipSuccess) fprintf(stderr, "kernel_launch: cooperative launch failed: %s (grid %d)\n", hipGetErrorString(e), grid);
}
```

```cpp
#include <hip/hip_runtime.h>
#include <hip/hip_cooperative_groups.h>
#include <hip/hip_bf16.h>
#include <cstdio>
#include <cstdint>
#include <cmath>
namespace cg = cooperative_groups;

#define LAS __attribute__((address_space(3)))
#define GAS __attribute__((address_space(1)))
typedef unsigned short bf16_t;
typedef short bf16x8 __attribute__((ext_vector_type(8)));
typedef float f32x4 __attribute__((ext_vector_type(4)));
typedef float f32x2 __attribute__((ext_vector_type(2)));
typedef float f32x16 __attribute__((ext_vector_type(16)));
typedef unsigned u32x4 __attribute__((ext_vector_type(4)));
typedef unsigned u32x2 __attribute__((ext_vector_type(2)));
typedef __bf16 bf16x2_t __attribute__((ext_vector_type(2)));

constexpr int DM = 1024, NTOK = 16384, DEPTH = 4, IN_DIM = 7712, LDP = 7936;
constexpr int C_QA = 0, C_KA = 512, C_VA = 1024, C_QB = 2048, C_KB = 3072, C_VB = 3328, C_ZA = 3584, C_ZB = 4608, C_MA = 5632, C_MB = 6656, C_GL = 7680;
constexpr float EPS = 1e-6f;
constexpr float C2 = 0.125f * 1.4426950408889634f;
constexpr float LN2 = 0.6931471805599453f, LOG2E = 1.4426950408889634f;

constexpr size_t MiB = 1u << 20;
constexpr size_t WS_CTL = 0, CTL_BYTES = 65536;
constexpr size_t WS_TAB = 1 * MiB;
constexpr size_t WS_WIN = 2 * MiB;
constexpr size_t WIN_L = (size_t)LDP * 1024;
constexpr size_t WS_WBR = 64 * MiB;
constexpr size_t WS_WOUT = 80 * MiB;
constexpr size_t WS_PROJ = 88 * MiB;
constexpr size_t WS_XB = 336 * MiB;
constexpr size_t WS_SSP = 368 * MiB;
constexpr size_t WS_EF = 369 * MiB;
constexpr size_t WS_EB = WS_EF + 512 * 1024;
constexpr size_t WS_KLTF = 370 * MiB;
constexpr size_t WS_KLTB = 386 * MiB;
constexpr size_t WS_VT = 402 * MiB;
constexpr size_t WS_OF2 = 434 * MiB;
constexpr size_t WS_END = 466 * MiB;

constexpr int LDS_BYTES = 147456, RING_BYTES = 131072, MISC_OFF = 131072 + 512;
constexpr int NPHASE = 51;

__device__ __forceinline__ unsigned pk2(float lo, float hi) { f32x2 v = {lo, hi}; bf16x2_t b = __builtin_convertvector(v, bf16x2_t); return __builtin_bit_cast(unsigned, b); }
__device__ __forceinline__ float bflo(unsigned u) { return __builtin_bit_cast(float, u << 16); }
__device__ __forceinline__ float bfhi(unsigned u) { return __builtin_bit_cast(float, u & 0xffff0000u); }
__device__ __forceinline__ float bf2f(bf16_t v) { return __builtin_bit_cast(float, ((unsigned)v) << 16); }
__device__ __forceinline__ bf16_t f2bf(float f) { return (bf16_t)(pk2(f, 0.f) & 0xffffu); }
__device__ __forceinline__ float fexp(float x) { return __builtin_amdgcn_exp2f(x * LOG2E); }
__device__ __forceinline__ float sigm(float x) { return __builtin_amdgcn_rcpf(1.f + fexp(-x)); }
__device__ __forceinline__ float silu(float x) { return x * sigm(x); }
__device__ __forceinline__ float logsig(float z) { return fminf(z, 0.f) - LN2 * __builtin_amdgcn_logf(1.f + fexp(-fabsf(z))); }
__device__ __forceinline__ int crow(int r, int hi) { return (r & 3) + 8 * (r >> 2) + 4 * hi; }
#define LDS_BARRIER() do { asm volatile("s_waitcnt lgkmcnt(0)" ::: "memory"); __builtin_amdgcn_s_barrier(); } while (0)
#define MFMA32(a, b, c) __builtin_amdgcn_mfma_f32_32x32x16_bf16((a), (b), (c), 0, 0, 0)

namespace pg8 {
constexpr int BM = 256, BK = 64, HALF = 128, HTB = HALF * BK * 2, NXCD = 8, WGM = 8;
__host__ __device__ __forceinline__ int lds_byte(int r, int c) { const int st = (r >> 4) * 2 + (c >> 5), rr = r & 15, cc = c & 31, ob = rr * 64 + cc * 2; return st * 1024 + (ob ^ (((ob >> 9) & 1) << 5)); }
__host__ __device__ __forceinline__ void stage_rc(int b, int& R, int& C) { const int st = b / 1024, sb = b % 1024, swz = sb ^ (((sb >> 9) & 1) << 5); R = (st >> 1) * 16 + swz / 64; C = (st & 1) * 32 + (swz % 64) / 2; }
__host__ __device__ __forceinline__ int perm32(int rho) { const int n = rho >> 4, i = rho & 15; return 8 * (i >> 2) + 4 * n + (i & 3); }
struct Unit { int pm, pn, sel; };
struct Gemm { const bf16_t* A; const bf16_t* Bt; int lda, ldb, K; int selstep; };
struct StaticOrder {
    int nM, nN, nwg, G, c;
    __device__ void init(int M, int N, int G_, int c_) { nM = M / BM; nN = N / BM; nwg = nM * nN; G = G_; c = c_; }
    __device__ bool next(int i, Unit& u) const {
        const long L = (long)i * G + c; if (L >= nwg) return false;
        int wgid = (int)L; { const int q = nwg / NXCD, r = nwg % NXCD, xcd = wgid % NXCD, off = wgid / NXCD; wgid = (xcd < r ? xcd * (q + 1) : r * (q + 1) + (xcd - r) * q) + off; }
        const int nig = WGM * nN, gid = wgid / nig, fm = gid * WGM, gsz = (nM - fm) < WGM ? (nM - fm) : WGM;
        u.pm = fm + ((wgid % nig) % gsz); u.pn = (wgid % nig) / gsz; u.sel = 0; return true;
    }
};
struct PairOrder {
    StaticOrder b;
    __device__ bool next(int i, Unit& u) const { const bool ok = b.next(i >> 1, u); u.sel = i & 1; return ok; }
};
template <class Epi, bool ALIGN_EPI = true, class Sched = StaticOrder>
__device__ __forceinline__ void gemm_phase(LAS unsigned char* lds, const Gemm g, const Sched& S, const Epi& E) {
    int tid = threadIdx.x; asm volatile("" : "+v"(tid));
    const int wid = __builtin_amdgcn_readfirstlane(tid >> 6), lane = tid & 63, wr = wid >> 2, wc = wid & 3, fr = lane & 15, fq = lane >> 4;
    const int K = g.K, nt = K / BK;
    unsigned voffA[2], voffB[2];
#pragma unroll
    for (int i = 0; i < 2; ++i) { int R, C; stage_rc(tid * 16 + i * 8192, R, C); const int Rb = (R & ~31) + perm32(R & 31);
        voffA[i] = (unsigned)(R * g.lda + C) * 2u; voffB[i] = (unsigned)(Rb * g.ldb + C) * 2u; }
    const size_t kstep = (size_t)(BK * 2);
    const size_t hstepA = (size_t)HALF * g.lda * 2, hstepB = (size_t)HALF * g.ldb * 2;
    const size_t tstepA = 2 * hstepA, tstepB = 2 * hstepB;
    const unsigned ldsw = (unsigned)wid * 1024u;
    const int aoff = lds_byte(wr * 64 + fr, fq * 8), boff = lds_byte(wc * 32 + fr, fq * 8);
#define PG8_SA(b, h) (((b) * 2 + (h)) * HTB)
#define PG8_SB(b, h) ((4 + (b) * 2 + (h)) * HTB)
#define PG8_STAGE(bufoff, gbase, voff) do { _Pragma("unroll") for (int _i = 0; _i < 2; ++_i) \
        __builtin_amdgcn_global_load_lds((const unsigned*)((const char*)(gbase) + (voff)[_i]), (LAS unsigned*)(lds + (bufoff) + ldsw + _i * 8192), 16, 0, 0); } while (0)
#define PG8_LDA(dst, b, h) do { _Pragma("unroll") for (int m = 0; m < 4; ++m) _Pragma("unroll") for (int k = 0; k < 2; ++k) dst[m][k] = *(const LAS bf16x8*)(lds + PG8_SA(b, h) + aoff + m * 2048 + k * 1024); } while (0)
#define PG8_LDB(dst, b, h) do { _Pragma("unroll") for (int n = 0; n < 2; ++n) _Pragma("unroll") for (int k = 0; k < 2; ++k) dst[n][k] = *(const LAS bf16x8*)(lds + PG8_SB(b, h) + boff + n * 2048 + k * 1024); } while (0)
#define PG8_MMA(ai, bj, At, Bt) do { __builtin_amdgcn_s_setprio(1); _Pragma("unroll") for (int m = 0; m < 4; ++m) _Pragma("unroll") for (int n = 0; n < 2; ++n) _Pragma("unroll") for (int k = 0; k < 2; ++k) \
        acc[ai][bj][m][n] = __builtin_amdgcn_mfma_f32_16x16x32_bf16(Bt[n][k], At[m][k], acc[ai][bj][m][n], 0, 0, 0); __builtin_amdgcn_s_setprio(0); } while (0)
#define PG8_WAIT_V(n) asm volatile("s_waitcnt vmcnt(" #n ")" ::: "memory")
#define PG8_WAIT_L(n) asm volatile("s_waitcnt lgkmcnt(" #n ")" ::: "memory")
#define PG8_BAR __builtin_amdgcn_s_barrier()
#define PG8_SCHED __builtin_amdgcn_sched_barrier(0)
    Unit cur, nxt; int ui = 0;
    if (!S.next(0, cur)) return;
    f32x4 acc[2][2][4][2];
#pragma unroll
    for (int a = 0; a < 2; ++a)
#pragma unroll
        for (int b = 0; b < 2; ++b)
#pragma unroll
            for (int m = 0; m < 4; ++m)
#pragma unroll
                for (int n = 0; n < 2; ++n) acc[a][b][m][n] = (f32x4){0.f, 0.f, 0.f, 0.f};
    bf16x8 At[4][2], B0[2][2], B1[2][2];
    if constexpr (Epi::HAS_PRE) E.pre(cur, 0);
    const char* cA = (const char*)g.A + (size_t)cur.pm * tstepA + (size_t)cur.sel * g.selstep; const char* cB = (const char*)g.Bt + (size_t)cur.pn * tstepB + (size_t)cur.sel * g.selstep;
    PG8_STAGE(PG8_SB(0, 0), cB, voffB); PG8_STAGE(PG8_SB(0, 1), cB + hstepB, voffB); PG8_STAGE(PG8_SA(0, 0), cA, voffA); PG8_STAGE(PG8_SA(0, 1), cA + hstepA, voffA);
    if (wr == 1) PG8_BAR;
    PG8_WAIT_V(2); PG8_BAR;
    PG8_STAGE(PG8_SB(1, 0), cB + kstep, voffB); PG8_STAGE(PG8_SA(1, 0), cA + kstep, voffA); PG8_STAGE(PG8_SB(1, 1), cB + hstepB + kstep, voffB);
    PG8_WAIT_V(6); PG8_BAR;
    for (;;) {
        const bool has_next = S.next(ui + 1, nxt);
        const char* nA = has_next ? (const char*)g.A + (size_t)nxt.pm * tstepA + (size_t)nxt.sel * g.selstep : cA; const char* nB = has_next ? (const char*)g.Bt + (size_t)nxt.pn * tstepB + (size_t)nxt.sel * g.selstep : cB;
        for (int t = 0; t < nt; t += 2) {
            const bool last = (t == nt - 2);
            const char* a1 = cA + (size_t)(t + 1) * kstep;
            const char* a2 = last ? nA : cA + (size_t)(t + 2) * kstep; const char* b2 = last ? nB : cB + (size_t)(t + 2) * kstep;
            const char* a3 = a2 + kstep; const char* b3 = b2 + kstep;
            PG8_LDB(B0, 0, 0); PG8_LDB(B1, 0, 1); PG8_SCHED; PG8_LDA(At, 0, 0); PG8_STAGE(PG8_SA(1, 1), a1 + hstepA, voffA);
            PG8_WAIT_V(8); PG8_WAIT_L(0); PG8_BAR; PG8_MMA(0, 0, At, B0); PG8_MMA(0, 1, At, B1); PG8_BAR; PG8_SCHED;
            PG8_LDA(At, 0, 1); PG8_STAGE(PG8_SB(0, 0), b2, voffB); PG8_STAGE(PG8_SB(0, 1), b2 + hstepB, voffB); PG8_STAGE(PG8_SA(0, 0), a2, voffA);
            PG8_WAIT_V(8); PG8_WAIT_L(0); PG8_BAR; PG8_MMA(1, 0, At, B0); PG8_MMA(1, 1, At, B1); PG8_BAR; PG8_SCHED;
            PG8_LDB(B0, 1, 0); PG8_LDB(B1, 1, 1); PG8_SCHED; PG8_LDA(At, 1, 0); PG8_STAGE(PG8_SA(0, 1), a2 + hstepA, voffA);
            PG8_WAIT_V(8); PG8_WAIT_L(0); PG8_BAR; PG8_MMA(0, 0, At, B0); PG8_MMA(0, 1, At, B1); PG8_BAR; PG8_SCHED;
            PG8_LDA(At, 1, 1); PG8_STAGE(PG8_SB(1, 0), b3, voffB); PG8_STAGE(PG8_SB(1, 1), b3 + hstepB, voffB); PG8_STAGE(PG8_SA(1, 0), a3, voffA);
            PG8_WAIT_V(8); PG8_WAIT_L(0); PG8_BAR; PG8_MMA(1, 0, At, B0); PG8_MMA(1, 1, At, B1); PG8_BAR; PG8_SCHED;
        }
        if constexpr (ALIGN_EPI) { if (wr == 0) PG8_BAR; }
        if constexpr (Epi::HAS_PRE) { if (has_next) E.pre(nxt, (ui + 1) & 1); E(acc, cur, wr, wc, fr, fq, ui & 1); } else E(acc, cur, wr, wc, fr, fq);
        if (!has_next) break;
#pragma unroll
        for (int a = 0; a < 2; ++a)
#pragma unroll
            for (int b = 0; b < 2; ++b)
#pragma unroll
                for (int m = 0; m < 4; ++m)
#pragma unroll
                    for (int n = 0; n < 2; ++n) acc[a][b][m][n] = (f32x4){0.f, 0.f, 0.f, 0.f};
        cur = nxt; cA = nA; cB = nB; ++ui;
        if constexpr (ALIGN_EPI) { if (wr == 1) PG8_BAR; }
    }
    PG8_WAIT_V(0);
    if constexpr (!ALIGN_EPI) { if (wr == 0) PG8_BAR; }
    PG8_BAR;
#undef PG8_SA
#undef PG8_SB
#undef PG8_STAGE
#undef PG8_LDA
#undef PG8_LDB
#undef PG8_MMA
#undef PG8_WAIT_V
#undef PG8_WAIT_L
#undef PG8_BAR
#undef PG8_SCHED
}

struct EpiProj {
    static constexpr bool HAS_PRE = true;
    bf16_t* O; const float* ssp; LAS float* stash;
    __device__ __forceinline__ void pre(const Unit& u, int buf) const {
        int t = threadIdx.x; asm volatile("" : "+v"(t));
        if (t < 256) { const f32x4* sp = (const f32x4*)(ssp + (size_t)(u.pm * BM + t) * 16);
            const f32x4 s4 = (sp[0] + sp[1]) + (sp[2] + sp[3]);
            stash[buf * 256 + t] = __builtin_amdgcn_rsqf(((s4[0] + s4[1]) + (s4[2] + s4[3])) * (1.f / 1024.f) + EPS); }
    }
    __device__ __forceinline__ void operator()(const f32x4 (&acc)[2][2][4][2], const Unit& u, int wr, int wc, int fr, int fq, int buf) const {
        const int rl0 = wr * 64 + fr, col0 = u.pn * BM + wc * 32 + 8 * fq;
#pragma unroll
        for (int ai = 0; ai < 2; ++ai)
#pragma unroll
            for (int m = 0; m < 4; ++m) {
                const int rl = rl0 + ai * HALF + m * 16;
                const float rs = stash[buf * 256 + rl];
                bf16_t* rowp = O + (size_t)(u.pm * BM + rl) * LDP + col0;
#pragma unroll
                for (int bj = 0; bj < 2; ++bj) { const f32x4 v0 = acc[ai][bj][m][0] * rs, v1 = acc[ai][bj][m][1] * rs;
                    u32x4 w; w.x = pk2(v0[0], v0[1]); w.y = pk2(v0[2], v0[3]); w.z = pk2(v1[0], v1[1]); w.w = pk2(v1[2], v1[3]);
                    *(u32x4*)(rowp + bj * HALF) = w; }
            }
    }
};

template <int SECOND> struct EpiBranch {
    static constexpr bool HAS_PRE = false;
    bf16_t* P; bf16_t* W; int rmask;
    __device__ __forceinline__ void operator()(const f32x4 (&acc)[2][2][4][2], const Unit& u, int wr, int wc, int fr, int fq) const {
        const int row0 = u.pm * BM + wr * 64 + fr, col0 = u.pn * BM + wc * 32 + 8 * fq;
#pragma unroll
        for (int ai = 0; ai < 2; ++ai)
#pragma unroll
            for (int m = 0; m < 4; ++m) {
                bf16_t* rowp = P + (size_t)(row0 + ai * HALF + m * 16) * LDP + col0; bf16_t* roww = W + (size_t)((row0 + ai * HALF + m * 16) & rmask) * LDP + col0;
#pragma unroll
                for (int bj = 0; bj < 2; ++bj) {
                    const u32x4 a = *(const u32x4*)(rowp + C_MA + bj * HALF);
                    float ma[8] = {bflo(a.x), bfhi(a.x), bflo(a.y), bfhi(a.y), bflo(a.z), bfhi(a.z), bflo(a.w), bfhi(a.w)};
                    float o[8];
                    if (SECOND) {
                        const u32x4 b = *(const u32x4*)(rowp + C_MB + bj * HALF);
                        float mb[8] = {bflo(b.x), bfhi(b.x), bflo(b.y), bfhi(b.y), bflo(b.z), bfhi(b.z), bflo(b.w), bfhi(b.w)};
#pragma unroll
                        for (int e = 0; e < 8; ++e) o[e] = ma[e] + acc[ai][bj][m][e >> 2][e & 3] * sigm(mb[e]);
                    } else {
#pragma unroll
                        for (int e = 0; e < 8; ++e) o[e] = acc[ai][bj][m][e >> 2][e & 3] * sigm(ma[e]);
                    }
                    u32x4 w; w.x = pk2(o[0], o[1]); w.y = pk2(o[2], o[3]); w.z = pk2(o[4], o[5]); w.w = pk2(o[6], o[7]);
                    *(u32x4*)(roww + C_MA + bj * HALF) = w;
                }
            }
    }
};
struct EpiBranchPair {
    static constexpr bool HAS_PRE = false;
    bf16_t* P;
    __device__ __forceinline__ void operator()(const f32x4 (&acc)[2][2][4][2], const Unit& u, int wr, int wc, int fr, int fq) const {
        if (u.sel == 0) { EpiBranch<0> e{P, P, -1}; e(acc, u, wr, wc, fr, fq); } else { EpiBranch<1> e{P, P, -1}; e(acc, u, wr, wc, fr, fq); }
    }
};
struct EpiOut {
    static constexpr bool HAS_PRE = false;
    const float* xold; float* xnew; bf16_t* xb; float* ssp; int rmask;
    __device__ __forceinline__ void operator()(const f32x4 (&acc)[2][2][4][2], const Unit& u, int wr, int wc, int fr, int fq) const {
        const int row0 = u.pm * BM + wr * 64 + fr, col0 = u.pn * BM + wc * 32 + 8 * fq;
#pragma unroll
        for (int ai = 0; ai < 2; ++ai)
#pragma unroll
            for (int m = 0; m < 4; ++m) {
                const int row = row0 + ai * HALF + m * 16;
                float ss = 0.f;
#pragma unroll
                for (int bj = 0; bj < 2; ++bj) {
                    const size_t off = (size_t)row * DM + col0 + bj * HALF, offw = (size_t)(row & rmask) * DM + col0 + bj * HALF;
                    const f32x4 x0 = *(const f32x4*)(xold + off), x1 = *(const f32x4*)(xold + off + 4);
                    const f32x4 v0 = x0 + acc[ai][bj][m][0], v1 = x1 + acc[ai][bj][m][1];
                    *(f32x4*)(xnew + offw) = v0; *(f32x4*)(xnew + offw + 4) = v1;
                    u32x4 w; w.x = pk2(v0[0], v0[1]); w.y = pk2(v0[2], v0[3]); w.z = pk2(v1[0], v1[1]); w.w = pk2(v1[2], v1[3]);
                    *(u32x4*)(xb + offw) = w;
                    ss += (v0[0] * v0[0] + v0[1] * v0[1]) + (v0[2] * v0[2] + v0[3] * v0[3]) + (v1[0] * v1[0] + v1[1] * v1[1]) + (v1[2] * v1[2] + v1[3] * v1[3]);
                }
                ss += __shfl_xor(ss, 16); ss += __shfl_xor(ss, 32);
                if (fq == 0) ssp[(size_t)(row & rmask) * 16 + u.pn * 4 + wc] = ss;
            }
    }
};
}

namespace attn_body {
using bf16 = __hip_bfloat16;
using s16x4 = __attribute__((ext_vector_type(4))) short;
constexpr int D = 64, P = LDP;
constexpr int NW = 8, QBLK = 32, QB = QBLK * NW, KVBLK = 64;
#define SBAR() __builtin_amdgcn_sched_barrier(0)
constexpr int NSLOT = 3, SLOTB = 8192;
constexpr int LDS_K = 0, LDS_V = NSLOT * SLOTB, LDS_WS = 2 * NSLOT * SLOTB, LDS_OST = LDS_WS + NW * 64 * 4, ATT_LDS_BYTES = LDS_OST + NW * 4096;
__device__ __forceinline__ void glds16(const void* gsrc, unsigned lds_dst) { unsigned keep;
  asm volatile("s_mov_b32 %0, m0\n\ts_mov_b32 m0, %2\n\ts_nop 0\n\tglobal_load_lds_dwordx4 %1, off\n\ts_mov_b32 m0, %0" : "=&s"(keep) : "v"(gsrc), "s"(lds_dst) : "memory"); }
__device__ __forceinline__ float max3f(float a, float b, float c) { float r; asm("v_max3_f32 %0, %1, %2, %3" : "=v"(r) : "v"(a), "v"(b), "v"(c)); return r; }
__device__ __forceinline__ float max2f(float a, float b) { float r; asm("v_max_f32_e32 %0, %1, %2" : "=v"(r) : "v"(a), "v"(b)); return r; }
__device__ __forceinline__ float fadd_s(float a, float b) { float r; asm("v_add_f32_e32 %0, %1, %2" : "=v"(r) : "v"(a), "v"(b)); return r; }
__device__ __forceinline__ float fsub_s(float a, float b) { float r; asm("v_sub_f32_e32 %0, %1, %2" : "=v"(r) : "v"(a), "v"(b)); return r; }
__device__ __forceinline__ unsigned cvtpk_s(float lo, float hi) { return pk2(lo, hi); }
#define WAIT_BAR(N) asm volatile("s_waitcnt vmcnt(" #N ") lgkmcnt(0)\n\ts_barrier" ::: "memory")
__device__ __forceinline__ void qkt(f32x16& p0, f32x16& p1, const char* Kslot, const bf16x8* qr, const f32x16& negm, int r32, int hi) {
  const char* kb = Kslot + hi * 1024 + r32 * 16;
  #pragma unroll
  for (int d0 = 0; d0 < 4; ++d0) {
    const bf16x8 b0 = *reinterpret_cast<const bf16x8*>(kb + d0 * 2048);
    const bf16x8 b1 = *reinterpret_cast<const bf16x8*>(kb + d0 * 2048 + 512);
    if (d0 == 0) { p0 = MFMA32(b0, qr[0], negm); p1 = MFMA32(b1, qr[0], negm); }
    else { p0 = MFMA32(b0, qr[d0], p0); p1 = MFMA32(b1, qr[d0], p1); } }
}
typedef __attribute__((address_space(3))) const char* lds_cptr;
typedef short v4i16_t __attribute__((ext_vector_type(4)));
__device__ __forceinline__ void kload8(bf16x8* kf, lds_cptr kp) {
  kf[0] = *(const LAS bf16x8*)(kp);        kf[1] = *(const LAS bf16x8*)(kp + 512);
  kf[2] = *(const LAS bf16x8*)(kp + 2048); kf[3] = *(const LAS bf16x8*)(kp + 2560);
  kf[4] = *(const LAS bf16x8*)(kp + 4096); kf[5] = *(const LAS bf16x8*)(kp + 4608);
  kf[6] = *(const LAS bf16x8*)(kp + 6144); kf[7] = *(const LAS bf16x8*)(kp + 6656);
}
__device__ __forceinline__ void kload2(bf16x8* kf, lds_cptr kp, int j) { kf[2 * j] = *(const LAS bf16x8*)(kp + j * 2048); kf[2 * j + 1] = *(const LAS bf16x8*)(kp + j * 2048 + 512); }
__device__ __forceinline__ s16x4 vtr(lds_cptr p) { return __builtin_bit_cast(s16x4, __builtin_amdgcn_ds_read_tr16_b64_v4i16((LAS v4i16_t*)p)); }
__device__ __forceinline__ float rowmax(const f32x16& p0, const f32x16& p1) {
  float a = max3f(p0[0], p0[1], p1[0]), b = max3f(p0[2], p0[3], p1[1]); a = max3f(a, p1[2], p1[3]);
  #pragma unroll
  for (int r = 4; r < 16; r += 4) { a = max3f(a, p0[r], p0[r + 1]); b = max3f(b, p0[r + 2], p0[r + 3]); a = max3f(a, p1[r], p1[r + 1]); b = max3f(b, p1[r + 2], p1[r + 3]); }
  const float m = max2f(a, b);
  auto rr = __builtin_amdgcn_permlane32_swap(__float_as_uint(m), __float_as_uint(m), false, false);
  return max2f(__uint_as_float(rr[0]), __uint_as_float(rr[1]));
}
__device__ __forceinline__ void pv(f32x16* o, int vb, bf16x8 pa0, bf16x8 pa1, bf16x8 pa2, bf16x8 pa3) {
  #pragma unroll
  for (int d0 = 0; d0 < 2; ++d0) { s16x4 lo[4], hi[4];
    #pragma unroll
    for (int ks = 0; ks < 4; ++ks) {
      asm volatile("ds_read_b64_tr_b16 %0,%1 offset:%c2" : "=&v"(lo[ks]) : "v"(vb), "i"(d0 * 4096 + ks * 1024) : "memory");
      asm volatile("ds_read_b64_tr_b16 %0,%1 offset:%c2" : "=&v"(hi[ks]) : "v"(vb), "i"(d0 * 4096 + ks * 1024 + 512) : "memory"); }
    asm volatile("s_waitcnt lgkmcnt(0)" ::: "memory"); SBAR();
    #define PK(k) (bf16x8){lo[k][0], lo[k][1], lo[k][2], lo[k][3], hi[k][0], hi[k][1], hi[k][2], hi[k][3]}
    o[d0] = MFMA32(pa0, PK(0), o[d0]);
    o[d0] = MFMA32(pa1, PK(1), o[d0]);
    o[d0] = MFMA32(pa2, PK(2), o[d0]);
    o[d0] = MFMA32(pa3, PK(3), o[d0]);
    #undef PK
  }
}
template <int THRL> __device__ __forceinline__ void attn_unit(const bf16* Qu, const bf16* __restrict__ Kh, const bf16* __restrict__ Vh, bf16* Zu, int NT, char* shm, const float* qg, const float* tabc, const float* tabs, int t0) {
  int tid = threadIdx.x; asm volatile("" : "+v"(tid));
  const int lane = tid & 63, r32 = lane & 31, hi = lane >> 5; const int wid = __builtin_amdgcn_readfirstlane(tid >> 6);
  const bf16* Qw = Qu + (long)(wid * QBLK) * P;
  const unsigned lds0 = (unsigned)(uintptr_t)shm;
  float* wsf = (float*)(shm + LDS_WS) + wid * 64;
  const bf16* ksrc = Kh + (long)lane * P + wid * 8;
  const bf16* vsrc = Vh + (long)(16 * (wid & 3) + (lane >> 2)) * P + (wid >> 2) * 32 + (lane & 3) * 8;
  const unsigned kdst = lds0 + LDS_K + wid * 1024, vdst = lds0 + LDS_V + wid * 1024;
  #define DMA_K(t, slot) glds16(ksrc + (long)(t) * KVBLK * P, (unsigned)__builtin_amdgcn_readfirstlane(kdst + (slot)))
  #define DMA_V(t, slot) glds16(vsrc + (long)(t) * KVBLK * P, (unsigned)__builtin_amdgcn_readfirstlane(vdst + (slot)))
  const int vb0 = (int)(lds0 + LDS_V) + ((lane >> 4) & 1) * 32 + (lane & 3) * 8 + (4 * hi + ((lane & 15) >> 2)) * 64;
  const char* Kbase = shm + LDS_K; bf16x8 kf[8];
  const lds_cptr shm3 = (lds_cptr)shm; const lds_cptr kp0 = shm3 + LDS_K + hi * 1024 + r32 * 16; const lds_cptr vp0 = shm3 + LDS_V + ((lane >> 4) & 1) * 32 + (lane & 3) * 8 + (4 * hi + ((lane & 15) >> 2)) * 64;
  DMA_K(0, 0); DMA_V(0, 0); DMA_K(1, SLOTB);
  bf16x8 qr[4];
  #pragma unroll
  for (int d0 = 0; d0 < 4; ++d0) qr[d0] = *reinterpret_cast<const bf16x8*>(&Qw[(long)r32 * P + d0 * 16 + hi * 8]);
  {
    float x[4][8]; float ss = 0.f;
    #pragma unroll
    for (int d0 = 0; d0 < 4; ++d0) { const u32x4 u = __builtin_bit_cast(u32x4, qr[d0]);
      x[d0][0] = bflo(u.x); x[d0][1] = bfhi(u.x); x[d0][2] = bflo(u.y); x[d0][3] = bfhi(u.y); x[d0][4] = bflo(u.z); x[d0][5] = bfhi(u.z); x[d0][6] = bflo(u.w); x[d0][7] = bfhi(u.w);
      #pragma unroll
      for (int j = 0; j < 8; ++j) ss += x[d0][j] * x[d0][j]; }
    { auto rr = __builtin_amdgcn_permlane32_swap(__float_as_uint(ss), __float_as_uint(ss), false, false); ss = __uint_as_float(rr[0]) + __uint_as_float(rr[1]); }
    const float rs = __builtin_amdgcn_rsqf(ss * (1.f / 64.f) + EPS) * C2;
    const int tq = t0 + wid * QBLK + r32, pr = tq >> 6, pc = tq & 63;
    #pragma unroll
    for (int d0 = 0; d0 < 4; ++d0) { const f32x4 g0 = *(const f32x4*)(qg + 16 * d0 + 8 * hi), g1 = *(const f32x4*)(qg + 16 * d0 + 8 * hi + 4);
      #pragma unroll
      for (int j = 0; j < 4; ++j) { x[d0][j] *= rs * g0[j]; x[d0][4 + j] *= rs * g1[j]; } }
    #pragma unroll
    for (int ax = 0; ax < 2; ++ax) { const int pos = ax ? pc : pr;
      const f32x4 c0 = *(const f32x4*)(tabc + pos * 16 + 8 * hi), c1 = *(const f32x4*)(tabc + pos * 16 + 8 * hi + 4), s0 = *(const f32x4*)(tabs + pos * 16 + 8 * hi), s1 = *(const f32x4*)(tabs + pos * 16 + 8 * hi + 4);
      #pragma unroll
      for (int j = 0; j < 8; ++j) { const float cc = j < 4 ? c0[j & 3] : c1[j & 3], sn = j < 4 ? s0[j & 3] : s1[j & 3];
        const float a = x[2 * ax][j], b = x[2 * ax + 1][j]; x[2 * ax][j] = a * cc - b * sn; x[2 * ax + 1][j] = b * cc + a * sn; } }
    #pragma unroll
    for (int d0 = 0; d0 < 4; ++d0) { u32x4 u; u.x = pk2(x[d0][0], x[d0][1]); u.y = pk2(x[d0][2], x[d0][3]); u.z = pk2(x[d0][4], x[d0][5]); u.w = pk2(x[d0][6], x[d0][7]); qr[d0] = __builtin_bit_cast(bf16x8, u); }
  }
  float mhat = 0.f, l_reg = 0.f; f32x16 o[2]; o[0] = f32x16{}; o[1] = f32x16{}; f32x16 negm = f32x16{}; asm volatile("" : "+v"(negm));
  bool resc = false;
  #define START(P0, P1) do { const float rm = rowmax(P0, P1); resc = false; \
    { const float dl = rm; mhat = fadd_s(mhat, dl); \
      _Pragma("unroll") for (int r = 0; r < 16; ++r) { P0[r] = fsub_s(P0[r], dl); P1[r] = fsub_s(P1[r], dl); } \
      _Pragma("unroll") for (int r = 0; r < 16; ++r) negm[r] = -mhat; asm volatile("" : "+v"(negm)); } \
    _Pragma("unroll") for (int r = 0; r < 16; ++r) P0[r] = __builtin_amdgcn_exp2f(P0[r]); } while (0)
  #define RESC() do { if (resc) { asm volatile("s_waitcnt lgkmcnt(0)" ::: "memory"); \
      _Pragma("unroll") for (int d_ = 0; d_ < 2; ++d_) _Pragma("unroll") for (int r = 0; r < 16; ++r) o[d_][r] *= wsf[crow(r, hi)]; } } while (0)
  f32x16 pA0, pA1, pB0, pB1;
  int sl_prev = 0, sl_cur = 0, sl_next = SLOTB;
  #define ROT() do { sl_prev = sl_cur; sl_cur = sl_next; sl_next = (sl_next == (NSLOT - 1) * SLOTB) ? 0 : sl_next + SLOTB; } while (0)
  DMA_K(2, 2 * SLOTB);
  WAIT_BAR(3);
  qkt(pA0, pA1, Kbase, qr, negm, r32, hi); asm volatile("s_nop 15\n\ts_nop 7" : "+v"(pA0), "+v"(pA1));
  START(pA0, pA1);
  _Pragma("unroll") for (int r = 0; r < 16; ++r) pA1[r] = __builtin_amdgcn_exp2f(pA1[r]);
  WAIT_BAR(0);
  DMA_K(3, 0); DMA_V(1, SLOTB);
  ROT();
  kload8(kf, kp0 + sl_cur);
  WAIT_BAR(2);
  s16x4 vlo[8], vhi[8]; u32x4 pw0, pw1, pw2, pw3;
  #define PKW(Pq, B) cvtpk_s(Pq[B], Pq[B + 1])
  #define PAF(k) __builtin_bit_cast(bf16x8, pw##k)
  #define VFR(i) (bf16x8){vlo[i][0], vlo[i][1], vlo[i][2], vlo[i][3], vhi[i][0], vhi[i][1], vhi[i][2], vhi[i][3]}
  #define PIN(x) asm volatile("" : "+v"(x))
  #define MX3(a, b, c) __builtin_fmaxf(__builtin_fmaxf((a), (b)), (c))
  #define GAPA(MF, A0, A1, A2, A3, W0, W1, PW) do { MF; sacc += A0; sacc += A1; sacc += A2; sacc += A3; PIN(sacc); W0; W1; PIN(PW); SBAR(); } while (0)
  #define EX(v) __builtin_amdgcn_exp2f(v)
  #define GAPB(MF, X, B) do { MF; X[B] = EX(X[B]); X[B + 1] = EX(X[B + 1]); X[B + 2] = EX(X[B + 2]); X[B + 3] = EX(X[B + 3]); PIN(X); SBAR(); } while (0)
  #define VRD(i) do { vlo[i] = vtr(vp_ + (((i) >> 2) * 4096 + ((i) & 3) * 1024)); vhi[i] = vtr(vp_ + (((i) >> 2) * 4096 + ((i) & 3) * 1024 + 512)); } while (0)
  #define KRD(G, j) do { if (G) { kload2(kf, kp0 + sl_next, j); SBAR(); } } while (0)
  #define STEP(C0, C1, P0, P1, t, GK, GV, GL) do { SBAR(); \
    const lds_cptr vp_ = vp0 + sl_prev; \
    VRD(0); SBAR(); float sacc = (P0[0] + P0[1]); \
    GAPA(C0 = MFMA32(kf[0], qr[0], negm), P0[2], P0[3], P0[4], P0[5],     pw0[0] = PKW(P0, 0), pw0[1] = PKW(P0, 2), pw0); \
    VRD(4); SBAR(); GAPA(C1 = MFMA32(kf[1], qr[0], negm), P0[6], P0[7], P0[8], P0[9],     pw0[2] = PKW(P0, 4), pw0[3] = PKW(P0, 6), pw0); \
    VRD(1); SBAR(); GAPA(C0 = MFMA32(kf[2], qr[1], C0),   P0[10], P0[11], P0[12], P0[13], pw1[0] = PKW(P0, 8), pw1[1] = PKW(P0, 10), pw1); \
    VRD(5); SBAR(); GAPA(C1 = MFMA32(kf[3], qr[1], C1),   P0[14], P0[15], P1[0], P1[1],   pw1[2] = PKW(P0, 12), pw1[3] = PKW(P0, 14), pw1); \
    VRD(2); SBAR(); GAPA(C0 = MFMA32(kf[4], qr[2], C0),   P1[2], P1[3], P1[4], P1[5],     pw2[0] = PKW(P1, 0), pw2[1] = PKW(P1, 2), pw2); \
    VRD(6); SBAR(); GAPA(C1 = MFMA32(kf[5], qr[2], C1),   P1[6], P1[7], P1[8], P1[9],     pw2[2] = PKW(P1, 4), pw2[3] = PKW(P1, 6), pw2); \
    VRD(3); SBAR(); GAPA(C0 = MFMA32(kf[6], qr[3], C0),   P1[10], P1[11], P1[12], P1[13], pw3[0] = PKW(P1, 8), pw3[1] = PKW(P1, 10), pw3); \
    VRD(7); SBAR(); GAPA(C1 = MFMA32(kf[7], qr[3], C1),   P1[14], P1[15], 0.f, 0.f,       pw3[2] = PKW(P1, 12), pw3[3] = PKW(P1, 14), pw3); \
    l_reg += sacc; \
    if (GK) { DMA_K((t) + 3, sl_cur); } if (GV) { DMA_V((t) + 1, sl_next); } \
    { float a = MX3(C0[0], C0[1], C1[0]), b = MX3(C0[2], C0[3], C1[1]); a = MX3(a, C1[2], C1[3]); \
      _Pragma("unroll") for (int r = 4; r < 16; r += 4) { a = MX3(a, C0[r], C0[r + 1]); b = MX3(b, C0[r + 2], C0[r + 3]); a = MX3(a, C1[r], C1[r + 1]); b = MX3(b, C1[r + 2], C1[r + 3]); } \
      float rm = __builtin_fmaxf(a, b); { auto rr = __builtin_amdgcn_permlane32_swap(__float_as_uint(rm), __float_as_uint(rm), false, false); rm = __builtin_fmaxf(__uint_as_float(rr[0]), __uint_as_float(rr[1])); } \
      resc = false; \
      if (__builtin_expect(__any(rm > (float)THRL), 0)) { const float dl = __builtin_fmaxf(rm, 0.f); mhat += dl; \
        _Pragma("unroll") for (int r = 0; r < 16; ++r) { C0[r] -= dl; C1[r] -= dl; } \
        _Pragma("unroll") for (int r = 0; r < 16; ++r) negm[r] = -mhat; asm volatile("" : "+v"(negm)); \
        const float f = __builtin_amdgcn_exp2f(-dl); l_reg *= f; if (hi == 0) wsf[r32] = f; resc = true; } } \
    SBAR(); \
    GAPB(o[0] = MFMA32(PAF(0), VFR(0), o[0]), C0, 0); \
    GAPB(o[1] = MFMA32(PAF(0), VFR(4), o[1]), C0, 4); \
    KRD(GL, 0); GAPB(o[0] = MFMA32(PAF(1), VFR(1), o[0]), C0, 8); \
    KRD(GL, 1); GAPB(o[1] = MFMA32(PAF(1), VFR(5), o[1]), C0, 12); \
    KRD(GL, 2); GAPB(o[0] = MFMA32(PAF(2), VFR(2), o[0]), C1, 0); \
    KRD(GL, 3); GAPB(o[1] = MFMA32(PAF(2), VFR(6), o[1]), C1, 4); \
    GAPB(o[0] = MFMA32(PAF(3), VFR(3), o[0]), C1, 8); \
    GAPB(o[1] = MFMA32(PAF(3), VFR(7), o[1]), C1, 12); \
    } while (0)
  int t = 1;
  for (; t + 5 < NT; t += 2) {
    STEP(pB0, pB1, pA0, pA1, t, true, true, true);     WAIT_BAR(2); RESC(); ROT();
    STEP(pA0, pA1, pB0, pB1, t + 1, true, true, true); WAIT_BAR(2); RESC(); ROT();
  }
  #define ENDW(tt) do { if ((tt) + 3 < NT) { WAIT_BAR(2); } else if ((tt) + 2 < NT) { WAIT_BAR(1); } else { WAIT_BAR(0); } } while (0)
  for (; t + 1 < NT; t += 2) {
    STEP(pB0, pB1, pA0, pA1, t, (t + 3 < NT), (t + 1 < NT), (t + 1 < NT));       ENDW(t);     RESC(); ROT();
    STEP(pA0, pA1, pB0, pB1, t + 1, (t + 4 < NT), (t + 2 < NT), (t + 2 < NT));   ENDW(t + 1); RESC(); ROT();
  }
  STEP(pB0, pB1, pA0, pA1, NT - 1, false, false, false); RESC();
  { float sacc = pB0[0] + pB0[1]; _Pragma("unroll") for (int r = 2; r < 16; ++r) sacc += pB0[r]; _Pragma("unroll") for (int r = 0; r < 16; ++r) sacc += pB1[r]; l_reg += sacc;
    pw0 = (u32x4){PKW(pB0, 0), PKW(pB0, 2), PKW(pB0, 4), PKW(pB0, 6)}; pw1 = (u32x4){PKW(pB0, 8), PKW(pB0, 10), PKW(pB0, 12), PKW(pB0, 14)}; pw2 = (u32x4){PKW(pB1, 0), PKW(pB1, 2), PKW(pB1, 4), PKW(pB1, 6)}; pw3 = (u32x4){PKW(pB1, 8), PKW(pB1, 10), PKW(pB1, 12), PKW(pB1, 14)};
    SBAR(); pv(o, vb0 + sl_cur, PAF(0), PAF(1), PAF(2), PAF(3)); }
  #undef PKW
  #undef PAF
  #undef VFR
  #undef PIN
  #undef MX3
  #undef GAPA
  #undef GAPB
  #undef EX
  #undef VRD
  #undef KRD
  #undef STEP
  #undef ENDW
  { auto rr = __builtin_amdgcn_permlane32_swap(__float_as_uint(l_reg), __float_as_uint(l_reg), false, false); l_reg = __uint_as_float(rr[0]) + __uint_as_float(rr[1]); }
  if (hi == 0) wsf[32 + r32] = l_reg; asm volatile("s_waitcnt lgkmcnt(0)" ::: "memory");
  float rli[16];
  #pragma unroll
  for (int r = 0; r < 16; ++r) rli[r] = __builtin_amdgcn_rcpf(wsf[32 + crow(r, hi)]);
  bf16* Zw = Zu + (long)(wid * QBLK) * P;
  { bf16* stg = (bf16*)(shm + LDS_OST) + wid * 2048;
    #pragma unroll
    for (int r = 0; r < 16; ++r) { const int orow = crow(r, hi);
      #pragma unroll
      for (int d0 = 0; d0 < 2; ++d0) stg[orow * 64 + d0 * 32 + r32] = __float2bfloat16(o[d0][r] * rli[r]); }
    asm volatile("s_waitcnt lgkmcnt(0)" ::: "memory");
    #pragma unroll
    for (int i = 0; i < 4; ++i) { const int row = i * 8 + (lane >> 3), ch = lane & 7; const u32x4 v = *(const u32x4*)(stg + row * 64 + ch * 8);
      u32x4* zp = (u32x4*)(Zw + (long)row * P + ch * 8); const u32x4 z = *zp; u32x4 w;
      w.x = pk2(bflo(v.x) * silu(bflo(z.x)), bfhi(v.x) * silu(bfhi(z.x))); w.y = pk2(bflo(v.y) * silu(bflo(z.y)), bfhi(v.y) * silu(bfhi(z.y)));
      w.z = pk2(bflo(v.z) * silu(bflo(z.z)), bfhi(v.z) * silu(bfhi(z.z))); w.w = pk2(bflo(v.w) * silu(bflo(z.w)), bfhi(v.w) * silu(bfhi(z.w)));
      *zp = w; } }
  asm volatile("s_waitcnt vmcnt(0) lgkmcnt(0)\n\ts_barrier" ::: "memory");
  #undef DMA_K
  #undef DMA_V
  #undef START
  #undef RESC
  #undef ROT
}
#undef SBAR
#undef WAIT_BAR
}

#define XB_TMO      128
#define XB_XCNT(j)  (256  + 64 * (j))
#define XB_XSUB(j)  (1280 + 64 * (j))
#define XB_XGEN(j)  (2304 + 64 * (j))
#define XB_TOP      3328
#define XB_TOPGEN   3392
#define XCD_BAR_WORDS 3456
#define XB_SPIN_CAP (1u << 20)
__device__ __forceinline__ unsigned xb_ld(unsigned* p)              { return __hip_atomic_load(p, __ATOMIC_RELAXED, __HIP_MEMORY_SCOPE_AGENT); }
__device__ __forceinline__ unsigned xb_add(unsigned* p, unsigned v) { return __hip_atomic_fetch_add(p, v, __ATOMIC_RELAXED, __HIP_MEMORY_SCOPE_AGENT); }
__device__ __forceinline__ unsigned xb_xcc_id() { return (unsigned)__builtin_amdgcn_s_getreg((3 << 11) | 20) & 0xFu; }
#define XB_SPIN(cond, bar) do { unsigned _sp = 0; while (cond) { __builtin_amdgcn_s_sleep(1); \
    if ((++_sp & 255u) == 0u) { if (xb_ld(&(bar)[XB_TMO])) break; if (_sp > XB_SPIN_CAP) { atomicAdd(&(bar)[XB_TMO], 1u); break; } } } } while (0)
struct XcdBarrier { unsigned* bar; unsigned x; volatile LAS unsigned* st; };
__device__ __forceinline__ XcdBarrier xcd_barrier_post(unsigned* bar, volatile LAS unsigned* st) {
    XcdBarrier b; b.bar = bar; b.x = xb_xcc_id(); b.st = st;
    if (threadIdx.x == 0) (void)xb_add(&bar[XB_XCNT(b.x)], 1u);
    return b;
}
__device__ __forceinline__ void xcd_barrier_complete(unsigned* bar, unsigned x, unsigned& nloc, unsigned& nx) {
    const unsigned G = gridDim.x * gridDim.y * gridDim.z;
    unsigned sum, cnt, mine, sp = 0u;
    for (;;) {
        sum = 0u; cnt = 0u; mine = 0u;
#pragma unroll 1
        for (unsigned j = 0; j < 16; ++j) { const unsigned c = xb_ld(&bar[XB_XCNT(j)]); sum += c; cnt += (c > 0u) ? 1u : 0u; mine = (j == x) ? c : mine; }
        if (sum == G) break;
        __builtin_amdgcn_s_sleep(1);
        if ((++sp & 255u) == 0u) { if (xb_ld(&bar[XB_TMO])) break; if (sp > XB_SPIN_CAP) { atomicAdd(&bar[XB_TMO], 1u); break; } }
    }
    nloc = mine > 0u ? mine : 1u; nx = cnt > 0u ? cnt : 1u;
}
__device__ __forceinline__ void xcd_barrier(const XcdBarrier& b) {
    asm volatile("s_waitcnt vmcnt(0)" ::: "memory");
    __syncthreads();
    int t0 = threadIdx.x; asm volatile("" : "+v"(t0));
    if (t0 == 0) {
        unsigned* bar = b.bar;
        __builtin_amdgcn_s_waitcnt(0);
        unsigned nloc = b.st[0], nx = b.st[1];
        if (nloc == 0u) { xcd_barrier_complete(bar, b.x, nloc, nx); b.st[0] = nloc; b.st[1] = nx; }
        const unsigned old = xb_add(&bar[XB_XSUB(b.x)], 1u);
        const unsigned gen = old / nloc;
        if (old + 1u == (gen + 1u) * nloc) {
            __builtin_amdgcn_fence(__ATOMIC_RELEASE, "agent");
            asm volatile("s_waitcnt vmcnt(0)" ::: "memory");
            const unsigned og = xb_add(&bar[XB_TOP], 1u);
            const unsigned tg = og / nx;
            if (og + 1u == (tg + 1u) * nx) xb_add(&bar[XB_TOPGEN], 1u);
            else XB_SPIN(xb_ld(&bar[XB_TOPGEN]) == tg, bar);
            __builtin_amdgcn_fence(__ATOMIC_ACQUIRE, "agent");
            xb_add(&bar[XB_XGEN(b.x)], 1u);
            asm volatile("s_waitcnt vmcnt(0)" ::: "memory");
        } else {
            XB_SPIN(xb_ld(&bar[XB_XGEN(b.x)]) == gen, bar);
            __builtin_amdgcn_fence(__ATOMIC_ACQUIRE, "agent");
            asm volatile("s_waitcnt vmcnt(0)" ::: "memory");
        }
    }
    __syncthreads();
}

struct Args { const float* in[15]; float* out; unsigned char* ws; int ph_lo, ph_hi; };

__device__ __forceinline__ float wave_sum(float v) {
#pragma unroll
    for (int o = 1; o < 64; o <<= 1) v += __shfl_xor(v, o);
    return v;
}

__device__ __forceinline__ void tr_item(const float* W, int ldw, int k0, int n0, bf16_t* dst, int dpitch, const float* gk, float sc, LAS float* scr, int lane) {
    { const int kr = lane >> 3, n4 = (lane & 7) * 4; f32x4 v[8];
#pragma unroll
      for (int i = 0; i < 8; ++i) v[i] = *(const f32x4*)(W + (size_t)(k0 + 8 * i + kr) * ldw + n0 + n4);
#pragma unroll
      for (int i = 0; i < 8; ++i) { const int kk = 8 * i + kr; const float g = (gk ? gk[k0 + kk] : 1.f) * sc;
          scr[kk * 33 + n4] = v[i][0] * g; scr[kk * 33 + n4 + 1] = v[i][1] * g; scr[kk * 33 + n4 + 2] = v[i][2] * g; scr[kk * 33 + n4 + 3] = v[i][3] * g; } }
    asm volatile("s_waitcnt lgkmcnt(0)" ::: "memory");
    const int c = lane & 7;
#pragma unroll
    for (int j = 0; j < 4; ++j) { const int n = (lane >> 3) + 8 * j; const LAS float* s = scr + (8 * c) * 33 + n;
        u32x4 o; o.x = pk2(s[0 * 33], s[1 * 33]); o.y = pk2(s[2 * 33], s[3 * 33]); o.z = pk2(s[4 * 33], s[5 * 33]); o.w = pk2(s[6 * 33], s[7 * 33]);
        *(u32x4*)(dst + (size_t)n * dpitch + 8 * c) = o; }
    asm volatile("s_waitcnt lgkmcnt(0)" ::: "memory");
}
__device__ __forceinline__ int map_col(int n0) {
    if (n0 < 2048) return n0;
    if (n0 < 2080) return C_GL;
    if (n0 < 3104) return C_ZA + (n0 - 2080);
    if (n0 < 4128) return C_QB + (n0 - 3104);
    if (n0 < 4384) return C_KB + (n0 - 4128);
    if (n0 < 4640) return C_VB + (n0 - 4384);
    if (n0 < 5664) return C_ZB + (n0 - 4640);
    if (n0 < 6688) return C_MA + (n0 - 5664);
    return C_MB + (n0 - 6688);
}
constexpr int CV_IN = 16 * 241, CV_SQ = 16 * 32, CV_ITEMS = CV_IN + 3 * CV_SQ;
__device__ __forceinline__ void convert_item(const Args& args, int l, int r, bf16_t* WIN, bf16_t* WBR, bf16_t* WOUT, LAS float* scr, int lane) {
    if (r < CV_IN) { const int kb = r / 241, nb = r % 241, n0 = 32 * nb;
        tr_item(args.in[3] + (size_t)l * DM * IN_DIM, IN_DIM, 64 * kb, n0, WIN + (size_t)l * WIN_L + (size_t)map_col(n0) * DM + 64 * kb, DM, args.in[2] + l * DM, n0 < 512 ? 0.08838834764831845f : 1.f, scr, lane);
        return; }
    r -= CV_IN;
    const int which = r / CV_SQ; r %= CV_SQ; const int kb = r / 32, nb = r % 32;
    if (which == 0) tr_item(args.in[11] + (size_t)l * DM * DM, DM, 64 * kb, 32 * nb, WBR + (size_t)l * DM * 2048 + (size_t)(32 * nb) * 2048 + 64 * kb, 2048, nullptr, 1.f, scr, lane);
    else if (which == 1) tr_item(args.in[12] + (size_t)l * DM * DM, DM, 64 * kb, 32 * nb, WBR + (size_t)l * DM * 2048 + (size_t)(32 * nb) * 2048 + 1024 + 64 * kb, 2048, nullptr, 1.f, scr, lane);
    else tr_item(args.in[13] + (size_t)l * DM * DM, DM, 64 * kb, 32 * nb, WOUT + (size_t)l * DM * DM + (size_t)(32 * nb) * DM + 64 * kb, DM, nullptr, 1.f, scr, lane);
}

__device__ __forceinline__ void x_rows_to_bf16(const float* x, bf16_t* xb, float* ssp, int gw, int ngw, int lane) {
    for (int m = gw; m < NTOK; m += ngw) {
        const f32x4* xr = (const f32x4*)(x + (size_t)m * DM) + lane; f32x4 v[4]; float s = 0.f;
#pragma unroll
        for (int j = 0; j < 4; ++j) { v[j] = xr[64 * j]; s += (v[j].x * v[j].x + v[j].y * v[j].y) + (v[j].z * v[j].z + v[j].w * v[j].w); }
        s = wave_sum(s);
        u32x2* o8 = (u32x2*)(xb + (size_t)m * DM) + lane;
#pragma unroll
        for (int j = 0; j < 4; ++j) { u32x2 w; w.x = pk2(v[j].x, v[j].y); w.y = pk2(v[j].z, v[j].w); o8[64 * j] = w; }
        if (lane < 16) ssp[(size_t)m * 16 + lane] = (lane == 0) ? s : 0.f;
    }
}

constexpr int PL_GL = 0, PL_TOT = 8192, PL_QF = 12288, PL_KF = PL_QF + 17408, PL_QB = PL_KF + 17408, PL_KB = PL_QB + 17408, PL_VT = PL_KB + 17408, PL_A = PL_VT + 36864, PL_END = PL_A + 9216;
static_assert(PL_END <= RING_BYTES, "prep LDS");
struct PrepIn { u32x4 gl[2]; u32x4 v[4]; };
struct PrepW { u32x4 wfrag; float bf, bb; };
__device__ __forceinline__ void gla_prep_loadw(PrepW& w, const float* wgf, const float* bgf, const float* wgb, const float* bgb, int h) {
    int tid = threadIdx.x; asm volatile("" : "+v"(tid)); const int c = tid & 127, lane = tid & 63, wave = tid >> 6, l32 = lane & 31, hh = lane >> 5, dir = wave >> 2, cb = wave & 3;
    const float* wg = (dir ? wgb : wgf) + (size_t)(8 * hh) * 512 + h * 128 + 32 * cb + l32;
    float t[8];
#pragma unroll
    for (int j = 0; j < 8; ++j) t[j] = wg[j * 512];
    w.wfrag = (u32x4){pk2(t[0], t[1]), pk2(t[2], t[3]), pk2(t[4], t[5]), pk2(t[6], t[7])};
    w.bf = bgf[h * 128 + c]; w.bb = bgb[h * 128 + c];
}
__device__ __forceinline__ void gla_prep_load(PrepIn& in, const bf16_t* proj, int gc, int h) {
    int tid = threadIdx.x; asm volatile("" : "+v"(tid));
    const int row0 = gc * 64;
    { const int lane = tid & 63, l32 = lane & 31, hh = lane >> 5, dir = tid >> 8;
#pragma unroll
      for (int tb = 0; tb < 2; ++tb) in.gl[tb] = *(const u32x4*)(proj + (size_t)(row0 + 32 * tb + l32) * LDP + C_GL + 16 * dir + 8 * hh); }
#pragma unroll
    for (int i = 0; i < 4; ++i) { const int idx = tid + 512 * i, t = idx & 63, dv = (idx >> 6) * 8; in.v[i] = *(const u32x4*)(proj + (size_t)(row0 + t) * LDP + C_VA + h * 256 + dv); }
}
__device__ __forceinline__ void gla_prep_tile(LAS unsigned char* lds, const PrepIn& in, const PrepW& pw, int gc, int h, bf16_t* proj,
                                              float* ef, float* eb, bf16_t* kltf, bf16_t* kltb, bf16_t* vtg, bf16_t* pst, int rmask) {
    int tid = threadIdx.x; asm volatile("" : "+v"(tid));
    const int lane = tid & 63, wave = tid >> 6, c = tid & 127, s = tid >> 7, l32 = lane & 31, hh = lane >> 5;
    const int row0 = gc * 64;
    LAS float* TOT = (LAS float*)(lds + PL_TOT);
    LAS bf16_t* QFl = (LAS bf16_t*)(lds + PL_QF); LAS bf16_t* KFl = (LAS bf16_t*)(lds + PL_KF); LAS bf16_t* QBl = (LAS bf16_t*)(lds + PL_QB); LAS bf16_t* KBl = (LAS bf16_t*)(lds + PL_KB);
    LAS bf16_t* VTl = (LAS bf16_t*)(lds + PL_VT); LAS bf16_t* Al = (LAS bf16_t*)(lds + PL_A);
    { LAS float* ZL = (LAS float*)(lds + PL_QF);
      const int dir = wave >> 2, cb = wave & 3;
#pragma unroll
      for (int tb = 0; tb < 2; ++tb) { const f32x16 z = MFMA32(__builtin_bit_cast(bf16x8, in.gl[tb]), __builtin_bit_cast(bf16x8, pw.wfrag), f32x16{});
#pragma unroll
          for (int r = 0; r < 16; ++r) ZL[(dir * 64 + 32 * tb + crow(r, hh)) * 128 + 32 * cb + l32] = z[r]; } }
#pragma unroll
    for (int i = 0; i < 4; ++i) { const int idx = tid + 512 * i, t = idx & 63, dv = (idx >> 6) * 8;
        const u32x4 v = in.v[i];
        VTl[(dv + 0) * 72 + t] = (bf16_t)(v.x & 0xffffu); VTl[(dv + 1) * 72 + t] = (bf16_t)(v.x >> 16);
        VTl[(dv + 2) * 72 + t] = (bf16_t)(v.y & 0xffffu); VTl[(dv + 3) * 72 + t] = (bf16_t)(v.y >> 16);
        VTl[(dv + 4) * 72 + t] = (bf16_t)(v.z & 0xffffu); VTl[(dv + 5) * 72 + t] = (bf16_t)(v.z >> 16);
        VTl[(dv + 6) * 72 + t] = (bf16_t)(v.w & 0xffffu); VTl[(dv + 7) * 72 + t] = (bf16_t)(v.w >> 16); }
    const float bfv = pw.bf, bbv = pw.bb;
    bf16_t qraw[16], kraw[16];
#pragma unroll
    for (int j = 0; j < 16; ++j) { qraw[j] = proj[(size_t)(row0 + 16 * s + j) * LDP + C_QA + h * 128 + c]; kraw[j] = proj[(size_t)(row0 + 16 * s + j) * LDP + C_KA + h * 128 + c]; }
    LDS_BARRIER();
    float pf[16], sb[16];
#pragma unroll
    for (int j = 0; j < 16; ++j) { const int t = 16 * s + j; const LAS float* ZL = (const LAS float*)(lds + PL_QF);
        const float zf = bfv + ZL[t * 128 + c], zb = bbv + ZL[(64 + t) * 128 + c];
        pf[j] = logsig(zf) * (1.f / 16.f); sb[j] = logsig(zb) * (1.f / 16.f); }
#pragma unroll
    for (int j = 1; j < 16; ++j) pf[j] += pf[j - 1];
#pragma unroll
    for (int j = 14; j >= 0; --j) sb[j] += sb[j + 1];
    TOT[(0 * 4 + s) * 128 + c] = pf[15]; TOT[(1 * 4 + s) * 128 + c] = sb[0];
    LDS_BARRIER();
    float offf = 0.f, allf = 0.f, offb = 0.f, allb = 0.f;
#pragma unroll
    for (int s2 = 0; s2 < 4; ++s2) { const float a = TOT[(0 * 4 + s2) * 128 + c], b = TOT[(1 * 4 + s2) * 128 + c]; allf += a; allb += b; if (s2 < s) offf += a; if (s2 > s) offb += b; }
    const float etf = fexp(allf), etb = fexp(allb);
    if (s == 0) { ef[(size_t)(gc * 4 + h) * 128 + c] = etf; eb[(size_t)(gc * 4 + h) * 128 + c] = etb; }
    unsigned klf[8], klb[8];
#pragma unroll
    for (int j = 0; j < 16; j += 2) {
        float o_klf[2], o_klb[2];
#pragma unroll
        for (int e = 0; e < 2; ++e) { const int t = 16 * s + j + e;
            const float q = bf2f(qraw[j + e]), k = bf2f(kraw[j + e]);
            const float bfw = offf + pf[j + e], bbw = offb + sb[j + e];
            const float Ef = fexp(bfw), Eb = fexp(bbw), rEf = __builtin_amdgcn_rcpf(Ef), rEb = __builtin_amdgcn_rcpf(Eb);
            const bf16_t qsf = f2bf(q * Ef), ksf = f2bf(k * rEf), qsb = f2bf(q * Eb), ksb = f2bf(k * rEb);
            o_klf[e] = k * (rEf * etf); o_klb[e] = k * (rEb * etb);
            pst[(size_t)((row0 + t) & rmask) * LDP + C_QA + h * 128 + c] = qsf; pst[(size_t)((row0 + t) & rmask) * LDP + C_KA + h * 128 + c] = qsb;
            QFl[t * 136 + c] = qsf; KFl[t * 136 + c] = ksf; QBl[t * 136 + c] = qsb; KBl[t * 136 + c] = ksb; }
        klf[j >> 1] = pk2(o_klf[0], o_klf[1]); klb[j >> 1] = pk2(o_klb[0], o_klb[1]);
    }
    { u32x4* d = (u32x4*)(kltf + ((size_t)(gc * 4 + h) * 128 + c) * 64 + 16 * s); d[0] = (u32x4){klf[0], klf[1], klf[2], klf[3]}; d[1] = (u32x4){klf[4], klf[5], klf[6], klf[7]};
      u32x4* d2 = (u32x4*)(kltb + ((size_t)(gc * 4 + h) * 128 + c) * 64 + 16 * s); d2[0] = (u32x4){klb[0], klb[1], klb[2], klb[3]}; d2[1] = (u32x4){klb[4], klb[5], klb[6], klb[7]}; }
    LDS_BARRIER();
    { const int dir = wave >> 2, bi = (wave >> 1) & 1, bj = wave & 1;
      const LAS bf16_t* Qt = dir ? QBl : QFl; const LAS bf16_t* Kt = dir ? KBl : KFl;
      f32x16 acc = f32x16{};
#pragma unroll
      for (int ks = 0; ks < 8; ++ks) { const bf16x8 a = *(const LAS bf16x8*)(Qt + (32 * bi + l32) * 136 + 16 * ks + 8 * hh); const bf16x8 b = *(const LAS bf16x8*)(Kt + (32 * bj + l32) * 136 + 16 * ks + 8 * hh); acc = MFMA32(a, b, acc); }
      const int jj = 32 * bj + l32;
#pragma unroll
      for (int r = 0; r < 16; ++r) { const int ii = 32 * bi + crow(r, hh); const bool keep = dir ? (jj > ii) : (jj <= ii); if (keep) Al[ii * 72 + jj] = f2bf(acc[r]); } }
    LDS_BARRIER();
    {
#pragma unroll
      for (int tb = 0; tb < 2; ++tb) { f32x16 acc = f32x16{};
#pragma unroll
        for (int ks = 0; ks < 4; ++ks) { const bf16x8 a = *(const LAS bf16x8*)(VTl + (32 * wave + l32) * 72 + 16 * ks + 8 * hh); const bf16x8 b = *(const LAS bf16x8*)(Al + (32 * tb + l32) * 72 + 16 * ks + 8 * hh); acc = MFMA32(a, b, acc); }
        bf16_t* op = pst + (size_t)((row0 + 32 * tb + l32) & rmask) * LDP + C_VA + h * 256 + 32 * wave + 4 * hh;
#pragma unroll
        for (int g = 0; g < 4; ++g) { u32x2 w; w.x = pk2(acc[4 * g], acc[4 * g + 1]); w.y = pk2(acc[4 * g + 2], acc[4 * g + 3]); *(u32x2*)(op + 8 * g) = w; } }
#pragma unroll
      for (int i = 0; i < 4; ++i) { const int idx = tid + 512 * i, dv = idx >> 3, tg = idx & 7;
        *(u32x4*)(vtg + ((size_t)(gc * 4 + h) * 256 + dv) * 64 + 8 * tg) = *(const LAS u32x4*)(VTl + dv * 72 + 8 * tg); } }
    LDS_BARRIER();
}

template <int NB>
__device__ __forceinline__ void qk_norm_items(bf16_t* proj, int it0, int itstride, int nitems, int T, const float* qg, const float* kg, const float* tabc, const float* tabs, int lane, bf16_t* pst, int rmask) {
    const int li = lane & 15, d0 = 4 * li, half = li >> 3, within = li & 7; const bool first = within < 4;
    bf16_t* p[NB]; bf16_t* pw[NB]; u32x2 u[NB]; f32x4 c4[NB], s4[NB]; bool isq[NB], ok[NB];
#pragma unroll
    for (int i = 0; i < NB; ++i) { const int it = it0 + i * itstride; ok[i] = it < nitems; const int itc = ok[i] ? it : 0; const int row = itc, grp = 4; isq[i] = false;
        p[i] = proj + (size_t)row * LDP + (grp < 4 ? C_QB + 256 * grp : C_KB) + 4 * lane; pw[i] = pst + (size_t)(row & rmask) * LDP + (grp < 4 ? C_QB + 256 * grp : C_KB) + 4 * lane; u[i] = *(const u32x2*)p[i];
        const int t = row % T; const int pos = half ? (t & 63) : (t >> 6);
        c4[i] = *(const f32x4*)(tabc + pos * 16 + 4 * (within & 3)); s4[i] = *(const f32x4*)(tabs + pos * 16 + 4 * (within & 3)); }
    const f32x4 gq = *(const f32x4*)(qg + d0), gk = *(const f32x4*)(kg + d0);
#pragma unroll
    for (int i = 0; i < NB; ++i) {
        float x[4] = {bflo(u[i].x), bfhi(u[i].x), bflo(u[i].y), bfhi(u[i].y)};
        float ss = (x[0] * x[0] + x[1] * x[1]) + (x[2] * x[2] + x[3] * x[3]);
        ss += __shfl_xor(ss, 1); ss += __shfl_xor(ss, 2); ss += __shfl_xor(ss, 4); ss += __shfl_xor(ss, 8);
        const float rs = __builtin_amdgcn_rsqf(ss * (1.f / 64.f) + EPS);
        const f32x4 g4 = isq[i] ? gq : gk; const float sc = isq[i] ? C2 : 1.f;
        float o[4];
#pragma unroll
        for (int e = 0; e < 4; ++e) { const float xn = x[e] * rs * g4[e]; const float pr = __shfl_xor(xn, 4);
            o[e] = (first ? (xn * c4[i][e] - pr * s4[i][e]) : (xn * c4[i][e] + pr * s4[i][e])) * sc; }
        u32x2 w; w.x = pk2(o[0], o[1]); w.y = pk2(o[2], o[3]); if (ok[i]) *(u32x2*)pw[i] = w;
    }
}

constexpr int CH_CB = 36864, CH_OFFK = 17408, CH_OFFE = 17408 + 18432;
__device__ __forceinline__ void gla_chain(LAS unsigned char* lds, int ci, int nchunk, bf16_t* proj, const bf16_t* kltf, const bf16_t* kltb, const bf16_t* vtg, const float* ef, const float* eb, bf16_t* ob, bf16_t* of2, unsigned* done, bf16_t* dry = nullptr) {
    int tid = threadIdx.x; asm volatile("" : "+v"(tid));
    const int lane = tid & 63, wave = __builtin_amdgcn_readfirstlane(tid >> 6);
    const int dir = ci & 1, bh = ci >> 1, b = bh >> 2, h = bh & 3, l32 = lane & 31, hh = lane >> 5;
    const bf16_t* klt = dir ? kltb : kltf; const float* ee = dir ? eb : ef;
    const int qcol = (dir ? C_KA : C_QA) + h * 128;
    const int qt0 = tid >> 4, qc0 = tid & 15;
    const int kd0 = tid >> 3, kc0 = tid & 7;
    f32x16 S[4];
#pragma unroll
    for (int i = 0; i < 4; ++i) S[i] = f32x16{};
#define CH_GC(st) (b * nchunk + (dir ? (nchunk - 1 - (st)) : (st)))
#define CH_CLAMP(st) ((st) < nchunk ? (st) : nchunk - 1)
#define CH_LOAD_T(SET, st) do { const int gc_ = CH_GC(CH_CLAMP(st)); \
        q0##SET = *(const u32x4*)(proj + (size_t)(gc_ * 64 + qt0) * LDP + qcol + qc0 * 8); q1##SET = *(const u32x4*)(proj + (size_t)(gc_ * 64 + qt0 + 32) * LDP + qcol + qc0 * 8); \
        const bf16_t* kb_ = klt + (size_t)(gc_ * 4 + h) * 128 * 64; \
        k0##SET = *(const u32x4*)(kb_ + (size_t)kd0 * 64 + kc0 * 8); k1##SET = *(const u32x4*)(kb_ + (size_t)(kd0 + 64) * 64 + kc0 * 8); \
        if (tid < 32) en##SET = *(const f32x4*)(ee + (size_t)(gc_ * 4 + h) * 128 + tid * 4); } while (0)
#define CH_LOAD_V(SET, st) do { const int gc_ = CH_GC(CH_CLAMP(st)); _Pragma("unroll") for (int ks = 0; ks < 4; ++ks) vf##SET[ks] = *(const bf16x8*)(vtg + ((size_t)(gc_ * 4 + h) * 256 + 32 * wave + l32) * 64 + 16 * ks + 8 * hh); } while (0)
#define CH_STAGE(SET, buf) do { *(LAS u32x4*)((buf) + qt0 * 272 + qc0 * 16) = q0##SET; *(LAS u32x4*)((buf) + (qt0 + 32) * 272 + qc0 * 16) = q1##SET; \
        *(LAS u32x4*)((buf) + CH_OFFK + kd0 * 144 + kc0 * 16) = k0##SET; *(LAS u32x4*)((buf) + CH_OFFK + (kd0 + 64) * 144 + kc0 * 16) = k1##SET; \
        if (tid < 32) *(LAS f32x4*)((buf) + CH_OFFE + tid * 16) = en##SET; } while (0)
    u32x4 q0A, q1A, k0A, k1A, q0B, q1B, k0B, k1B; f32x4 enA = (f32x4){0.f, 0.f, 0.f, 0.f}, enB = enA; bf16x8 vfA[4], vfB[4];
    CH_LOAD_T(A, 0); CH_LOAD_V(A, 0);
    CH_STAGE(A, lds);
    CH_LOAD_T(B, 1); CH_LOAD_V(B, 1);
    __syncthreads();
#define CH_LDQ(bufi, blk_) do { _Pragma("unroll") for (int s_ = 0; s_ < 2; ++s_) _Pragma("unroll") for (int tb_ = 0; tb_ < 2; ++tb_) { \
        const LAS unsigned char* qp_ = cur + (32 * tb_ + l32) * 272 + (32 * (blk_) + 16 * s_ + 4 * hh) * 2; \
        const u32x2 lo_ = *(const LAS u32x2*)qp_, hi_ = *(const LAS u32x2*)(qp_ + 16); qv[bufi][s_][tb_] = (u32x4){lo_.x, lo_.y, hi_.x, hi_.y}; } } while (0)
#define CH_LDE(bufi, blk_) do { _Pragma("unroll") for (int g_ = 0; g_ < 4; ++g_) evv[bufi][g_] = *(const LAS f32x4*)(cur + CH_OFFE + (32 * (blk_) + 8 * g_ + 4 * hh) * 4); } while (0)
#define CH_LDK(bufi, blk_) do { _Pragma("unroll") for (int ks_ = 0; ks_ < 4; ++ks_) kfv[bufi][ks_] = *(const LAS bf16x8*)(cur + CH_OFFK + (32 * (blk_) + l32) * 144 + (16 * ks_ + 8 * hh) * 2); } while (0)
#define CH_STEP(st, CUR, NXT) do { \
        const int gc = CH_GC(st), row0 = gc * 64; \
        LAS unsigned char* cur = lds + ((st) & 1) * CH_CB; LAS unsigned char* nxt = lds + (((st) + 1) & 1) * CH_CB; \
        CH_LOAD_T(CUR, (st) + 2); \
        f32x16 ot[2]; ot[0] = f32x16{}; ot[1] = f32x16{}; \
        u32x4 qv[2][2][2]; bf16x8 kfv[2][4]; \
        CH_LDQ(0, 0); \
        _Pragma("unroll") for (int blk = 0; blk < 4; ++blk) { \
            if (blk < 3) { CH_LDQ((blk + 1) & 1, blk + 1); } else { CH_LDK(0, 0); } \
            __builtin_amdgcn_sched_barrier(0); \
            _Pragma("unroll") for (int s = 0; s < 2; ++s) { \
                u32x4 pa; pa.x = pk2(S[blk][8 * s + 0], S[blk][8 * s + 1]); pa.y = pk2(S[blk][8 * s + 2], S[blk][8 * s + 3]); pa.z = pk2(S[blk][8 * s + 4], S[blk][8 * s + 5]); pa.w = pk2(S[blk][8 * s + 6], S[blk][8 * s + 7]); \
                const bf16x8 sa = __builtin_bit_cast(bf16x8, pa); \
                _Pragma("unroll") for (int tb = 0; tb < 2; ++tb) ot[tb] = MFMA32(sa, __builtin_bit_cast(bf16x8, qv[blk & 1][s][tb]), ot[tb]); } \
            __builtin_amdgcn_sched_barrier(0); } \
        _Pragma("unroll") for (int blk = 0; blk < 4; ++blk) _Pragma("unroll") for (int g = 0; g < 4; ++g) { const f32x4 ev = *(const LAS f32x4*)(cur + CH_OFFE + (32 * blk + 8 * g + 4 * hh) * 4); \
            S[blk][4 * g] *= ev[0]; S[blk][4 * g + 1] *= ev[1]; S[blk][4 * g + 2] *= ev[2]; S[blk][4 * g + 3] *= ev[3]; } \
        __builtin_amdgcn_sched_barrier(0); \
        _Pragma("unroll") for (int blk = 0; blk < 4; ++blk) { \
            if (blk < 3) { CH_LDK((blk + 1) & 1, blk + 1); } \
            __builtin_amdgcn_sched_barrier(0); \
            _Pragma("unroll") for (int ks = 0; ks < 4; ++ks) S[blk] = MFMA32(kfv[blk & 1][ks], vf##CUR[ks], S[blk]); \
            __builtin_amdgcn_sched_barrier(0); } \
        CH_LOAD_V(CUR, (st) + 2); \
        { bf16_t* obase = dry ? dry : (dir ? ob : of2); const int rmk = dry ? 4095 : -1; \
          _Pragma("unroll") for (int tb = 0; tb < 2; ++tb) { bf16_t* op = obase + (size_t)((row0 + 32 * tb + l32) & rmk) * DM + h * 256 + 32 * wave + 4 * hh; \
            _Pragma("unroll") for (int g = 0; g < 4; ++g) { u32x2 w; w.x = pk2(ot[tb][4 * g], ot[tb][4 * g + 1]); w.y = pk2(ot[tb][4 * g + 2], ot[tb][4 * g + 3]); *(u32x2*)(op + 8 * g) = w; } } } \
        CH_STAGE(NXT, nxt); \
        LDS_BARRIER(); } while (0)
    for (int step = 0; step < nchunk; step += 2) {
        CH_STEP(step, A, B);
        CH_STEP(step + 1, B, A);
    }
    if (done) {
        asm volatile("s_waitcnt vmcnt(0)" ::: "memory");
        __syncthreads();
        if (tid == 0) { __builtin_amdgcn_fence(__ATOMIC_RELEASE, "agent"); asm volatile("s_waitcnt vmcnt(0)" ::: "memory"); (void)xb_add(done + 64 * b, 1u); }
    }
#undef CH_GC
#undef CH_CLAMP
#undef CH_LOAD_T
#undef CH_LOAD_V
#undef CH_STAGE
#undef CH_STEP
#undef CH_LDQ
#undef CH_LDE
#undef CH_LDK
}

template <int NB>
__device__ __forceinline__ void ua_items(bf16_t* proj, const bf16_t* ob, const bf16_t* of2, int it0, int itstride, const float* gn, int lane, bf16_t* pst, int rmask) {
    u32x2 a[NB], b[NB], f[NB], z[NB]; bf16_t* zp[NB]; bool ok[NB];
#pragma unroll
    for (int i = 0; i < NB; ++i) { const int itr = it0 + i * itstride; ok[i] = itr < NTOK * 4; const int it = ok[i] ? itr : 0, row = it >> 2, h = it & 3;
        a[i] = *(const u32x2*)(proj + (size_t)row * LDP + C_VA + h * 256 + 4 * lane); b[i] = *(const u32x2*)(ob + (size_t)row * DM + h * 256 + 4 * lane); f[i] = *(const u32x2*)(of2 + (size_t)row * DM + h * 256 + 4 * lane);
        zp[i] = pst + (size_t)(row & rmask) * LDP + C_ZA + h * 256 + 4 * lane; z[i] = *(const u32x2*)(proj + (size_t)row * LDP + C_ZA + h * 256 + 4 * lane); }
    const f32x4 g4 = *(const f32x4*)(gn + 4 * lane);
#pragma unroll
    for (int i = 0; i < NB; ++i) {
        float o[4] = {bflo(a[i].x) + bflo(b[i].x) + bflo(f[i].x), bfhi(a[i].x) + bfhi(b[i].x) + bfhi(f[i].x), bflo(a[i].y) + bflo(b[i].y) + bflo(f[i].y), bfhi(a[i].y) + bfhi(b[i].y) + bfhi(f[i].y)};
        const float ss = wave_sum((o[0] * o[0] + o[1] * o[1]) + (o[2] * o[2] + o[3] * o[3]));
        const float rs = __builtin_amdgcn_rsqf(ss * (1.f / 256.f) + EPS);
        u32x2 w; w.x = pk2(o[0] * rs * g4[0] * silu(bflo(z[i].x)), o[1] * rs * g4[1] * silu(bfhi(z[i].x))); w.y = pk2(o[2] * rs * g4[2] * silu(bflo(z[i].y)), o[3] * rs * g4[3] * silu(bfhi(z[i].y)));
        if (ok[i]) *(u32x2*)zp[i] = w;
    }
}

__global__ void __launch_bounds__(512, 2) hybrid_fwd(Args args) {
    extern __shared__ __attribute__((aligned(16))) unsigned char lds[];
    LAS unsigned char* L = (LAS unsigned char*)lds;
    volatile LAS int* MISC = (volatile LAS int*)(L + MISC_OFF);
    cg::grid_group grid = cg::this_grid();
    if (threadIdx.x < 32) MISC[threadIdx.x] = 0;
    __syncthreads();
    const XcdBarrier xbar = xcd_barrier_post((unsigned*)(args.ws + WS_CTL) + 4096, (volatile LAS unsigned*)(MISC + 8));
    for (int ph = args.ph_lo; ph < args.ph_hi; ++ph) {
        int tid = threadIdx.x; asm volatile("" : "+v"(tid));
        const int lane = tid & 63, wave = __builtin_amdgcn_readfirstlane(tid >> 6);
        int G = gridDim.x, bid = blockIdx.x; asm volatile("" : "+s"(G), "+s"(bid));
        const int gw = bid * 8 + wave, ngw = G * 8;
        size_t zoff = 0; asm volatile("" : "+s"(zoff));
        unsigned char* ws = args.ws + zoff;
#define AIN(i) (args.in[i])
        float* aout = args.out;
        unsigned* ctl = (unsigned*)(ws + WS_CTL);
        float* tabc = (float*)(ws + WS_TAB); float* tabs = tabc + 1024;
        bf16_t* WIN = (bf16_t*)(ws + WS_WIN); bf16_t* WBR = (bf16_t*)(ws + WS_WBR); bf16_t* WOUT = (bf16_t*)(ws + WS_WOUT);
        bf16_t* proj = (bf16_t*)(ws + WS_PROJ); bf16_t* xb = (bf16_t*)(ws + WS_XB); float* ssp = (float*)(ws + WS_SSP);
        float* ef = (float*)(ws + WS_EF); float* eb = (float*)(ws + WS_EB);
        bf16_t* kltf = (bf16_t*)(ws + WS_KLTF); bf16_t* kltb = (bf16_t*)(ws + WS_KLTB); bf16_t* vtg = (bf16_t*)(ws + WS_VT); bf16_t* of2 = (bf16_t*)(ws + WS_OF2);
        if (ph == 0) {
          {
            LAS float* scr = (LAS float*)(L + wave * 16384);
            for (int it = gw; it < CV_ITEMS; it += ngw) convert_item(args, 0, it, WIN, WBR, WOUT, scr, lane);
            for (int i = bid * 512 + tid; i < DEPTH * 224 * 128; i += G * 512) { const int l = i / (224 * 128), r = i % (224 * 128);
                *(u32x4*)(WIN + (size_t)l * WIN_L + (size_t)IN_DIM * DM + (size_t)r * 8) = (u32x4){0u, 0u, 0u, 0u}; }
            for (int i = bid * 512 + tid; i < 1024; i += G * 512) { const int pos = i >> 4, fi = i & 15;
                const float inv = __builtin_amdgcn_exp2f(-(float)fi * (13.287712379549449f / 16.f)); const float ang = (float)pos * inv;
                float rev = ang * 0.15915494309189535f; rev -= floorf(rev);
                tabc[i] = __builtin_amdgcn_cosf(rev); tabs[i] = __builtin_amdgcn_sinf(rev); }
            x_rows_to_bf16(AIN(0), xb, ssp, gw, ngw, lane);
          }
        } else if (ph == 25 || ph == 50) {
            const int grp = ph == 50; float* xo = aout + (size_t)grp * NTOK * DM; const float* gf = AIN(14);
            for (int m0 = gw; m0 < NTOK; m0 += 2 * ngw) { const int m1 = (m0 + ngw < NTOK) ? m0 + ngw : m0;
                f32x4* xr0 = (f32x4*)(xo + (size_t)m0 * DM) + lane; f32x4* xr1 = (f32x4*)(xo + (size_t)m1 * DM) + lane; f32x4 v0[4], v1[4]; float s0 = 0.f, s1 = 0.f;
#pragma unroll
                for (int j = 0; j < 4; ++j) { v0[j] = xr0[64 * j]; v1[j] = xr1[64 * j]; }
#pragma unroll
                for (int j = 0; j < 4; ++j) { s0 += (v0[j].x * v0[j].x + v0[j].y * v0[j].y) + (v0[j].z * v0[j].z + v0[j].w * v0[j].w); s1 += (v1[j].x * v1[j].x + v1[j].y * v1[j].y) + (v1[j].z * v1[j].z + v1[j].w * v1[j].w); }
                const float rs0 = __builtin_amdgcn_rsqf(wave_sum(s0) * (1.f / 1024.f) + EPS), rs1 = __builtin_amdgcn_rsqf(wave_sum(s1) * (1.f / 1024.f) + EPS);
#pragma unroll
                for (int j = 0; j < 4; ++j) { const f32x4 g4 = *((const f32x4*)gf + lane + 64 * j); xr0[64 * j] = v0[j] * rs0 * g4; if (m1 != m0) xr1[64 * j] = v1[j] * rs1 * g4; } }
            if (grp == 0) x_rows_to_bf16(AIN(1), xb, ssp, gw, ngw, lane);
        } else {
            const int q = (ph < 25) ? ph - 1 : ph - 26; const int grp = ph > 25, l = q / 6, sub = q % 6;
            const int T = grp ? 2048 : 4096, nB = grp ? 8 : 4, nchunk = T / 64;
            float* xres = aout + (size_t)grp * NTOK * DM;
            if (sub == 0) {
                pg8::Gemm g{xb, WIN + (size_t)l * WIN_L, DM, DM, DM, 0}; pg8::StaticOrder S; S.init(NTOK, LDP, G, bid);
                pg8::EpiProj E{proj, ssp, (LAS float*)(L + MISC_OFF + 1024)};
                pg8::gemm_phase<pg8::EpiProj>(L, g, S, E);
            } else if (sub == 1) {
                { PrepIn pin; gla_prep_load(pin, proj, bid >> 2, bid & 3); PrepW pw; int hcur = bid & 3; gla_prep_loadw(pw, AIN(4) + (size_t)l * 16 * 512, AIN(5) + l * 512, AIN(6) + (size_t)l * 16 * 512, AIN(7) + l * 512, hcur);
                  for (int tile = bid; tile < 1024; tile += G) { PrepIn pnx; const int tn = (tile + G < 1024) ? tile + G : tile; gla_prep_load(pnx, proj, tn >> 2, tn & 3);
                    if ((tile & 3) != hcur) { hcur = tile & 3; gla_prep_loadw(pw, AIN(4) + (size_t)l * 16 * 512, AIN(5) + l * 512, AIN(6) + (size_t)l * 16 * 512, AIN(7) + l * 512, hcur); }
                    gla_prep_tile(L, pin, pw, tile >> 2, tile & 3, proj, ef, eb, kltf, kltb, vtg, proj, -1);
                    pin = pnx; } }
                for (int it = gw; it < NTOK; it += 8 * ngw) qk_norm_items<8>(proj, it, ngw, NTOK, T, AIN(9) + l * 64, AIN(10) + l * 64, tabc, tabs, lane, proj, -1);
            } else if (sub == 2) {
                const int nchain = nB * 4 * 2, nqb = T / 256, natt = nB * 16 * nqb, nua = NTOK * 4 / 64, ncv = (grp == 0 && l < 3) ? (CV_ITEMS + 7) / 8 : 0, total = nchain + natt + nua + ncv;
                unsigned* done = ctl + 8192 + 64 * ((grp * 4 + l) * 8);
                if (tid == 0) MISC[2] = 0;
                unsigned* ctr = ctl + 64 * (grp * 4 + l);
                if (tid == 0) MISC[0] = (int)atomicAdd(ctr, 1u);
                for (;;) {
                    __syncthreads();
                    const int idx = MISC[0];
                    __syncthreads();
                    if (idx >= total) break;
                    int nxti = 0; if (tid == 0) nxti = (int)atomicAdd(ctr, 1u);
                    if (idx >= nchain + natt && idx < nchain + natt + nua) {
                        const int j = idx - nchain - natt, bq = (j * 16) / T;
                        if (tid == 0 && !((MISC[2] >> bq) & 1)) {
                            unsigned sp = 0; while (xb_ld(done + 64 * bq) < 8u) { __builtin_amdgcn_s_sleep(2); if (++sp > (1u << 24)) break; }
                            __builtin_amdgcn_fence(__ATOMIC_ACQUIRE, "agent"); asm volatile("s_waitcnt vmcnt(0)" ::: "memory");
                            MISC[2] = MISC[2] | (1 << bq); }
                        __syncthreads();
                        { int ln = threadIdx.x; asm volatile("" : "+v"(ln)); const int wv = __builtin_amdgcn_readfirstlane(ln >> 6); ln &= 63;
                          ua_items<8>(proj, xb, of2, 64 * j + wv, 8, AIN(8) + l * 256, ln, proj, -1); }
                        if (tid == 0) MISC[0] = nxti; continue; }
                    if (idx >= nchain + natt + nua) { int ln = threadIdx.x; asm volatile("" : "+v"(ln)); const int wv = __builtin_amdgcn_readfirstlane(ln >> 6); ln &= 63; const int r = (idx - nchain - natt - nua) * 8 + wv; if (r < CV_ITEMS) convert_item(args, l + 1, r, WIN, WBR, WOUT, (LAS float*)(L + wv * 16384), ln); if (tid == 0) MISC[0] = nxti; continue; }
                    if (idx < nchain) gla_chain(L, idx, nchunk, proj, kltf, kltb, vtg, ef, eb, xb, of2, done);
                    else
                    {
 const int u = idx - nchain; const int g4 = u & 3, qb = (u >> 2) % nqb, bk = (u >> 2) / nqb, kvh = bk & 3, b = bk >> 2, hq = kvh * 4 + g4;
                        const size_t rb = (size_t)b * T;
                        attn_body::attn_unit<8>((const attn_body::bf16*)(proj + (rb + (size_t)qb * 256) * LDP + C_QB + hq * 64), (const attn_body::bf16*)(proj + rb * LDP + C_KB + kvh * 64),
                                                (const attn_body::bf16*)(proj + rb * LDP + C_VB + kvh * 64), (attn_body::bf16*)(proj + (rb + (size_t)qb * 256) * LDP + C_ZB + hq * 64), T / 64, (char*)lds, AIN(9) + l * 64, tabc, tabs, qb * 256);
                    }
                    if (tid == 0) MISC[0] = nxti;
                }
            } else if (sub == 3) {
            } else if (sub == 4) {
                pg8::StaticOrder S; S.init(NTOK, DM, G, bid);
                { pg8::Gemm g{proj + C_ZA, WBR + (size_t)l * DM * 2048, LDP, 2048, DM, 2048}; pg8::PairOrder S2{S}; pg8::EpiBranchPair E{proj};
                  pg8::gemm_phase<pg8::EpiBranchPair, true, pg8::PairOrder>(L, g, S2, E); }
            } else {
                pg8::Gemm g{proj + C_MA, WOUT + (size_t)l * DM * DM, LDP, DM, DM, 0}; pg8::StaticOrder S; S.init(NTOK, DM, G, bid);
                pg8::EpiOut E{l == 0 ? AIN(grp) : xres, xres, xb, ssp, -1};
                pg8::gemm_phase<pg8::EpiOut>(L, g, S, E);
            }
        }
        { const int qq = (ph < 25) ? ph - 1 : ph - 26; const bool empty = ph != 0 && ph != 25 && ph != 50 && (qq % 6) == 3;
          if (ph + 1 < args.ph_hi && !empty) { if (args.ph_hi > NPHASE) grid.sync(); else xcd_barrier(xbar); } }
    }
}

extern "C" void kernel_launch(void* const* d_in, const int* in_sizes, int n_in, void* d_out, int out_size, void* d_ws, size_t ws_size, hipStream_t stream) {
    static int grid = 0;
    if (grid == 0) {
        if (n_in != 15 || ws_size < WS_END || out_size != 2 * NTOK * DM) { fprintf(stderr, "kernel_launch: unexpected shapes (n_in %d, ws %zu, out %d)\n", n_in, ws_size, out_size); grid = -1; return; }
        if (hipFuncSetAttribute((const void*)hybrid_fwd, hipFuncAttributeMaxDynamicSharedMemorySize, LDS_BYTES) != hipSuccess) { fprintf(stderr, "kernel_launch: hipFuncSetAttribute failed\n"); grid = -1; return; }
        int dev = 0, cus = 0, per_cu = 0;
        hipGetDevice(&dev); hipDeviceGetAttribute(&cus, hipDeviceAttributeMultiprocessorCount, dev);
        hipOccupancyMaxActiveBlocksPerMultiprocessor(&per_cu, (const void*)hybrid_fwd, 512, LDS_BYTES);
        if (per_cu < 1) { fprintf(stderr, "kernel_launch: occupancy query says %d blocks per CU\n", per_cu); (void)hipGetLastError(); }
        grid = cus;
    }
    if (grid < 0) return;
    (void)hipMemsetAsync((char*)d_ws + WS_CTL, 0, CTL_BYTES, stream);
    Args a{};
    for (int i = 0; i < 15; ++i) a.in[i] = (const float*)d_in[i];
    a.out = (float*)d_out; a.ws = (unsigned char*)d_ws; a.ph_lo = 0; a.ph_hi = NPHASE;
    void* kargs[] = {&a};
    hipError_t e = hipLaunchCooperativeKernel((const void*)hybrid_fwd, dim3(grid), dim3(512), kargs, LDS_BYTES, stream);
    if (e != hipSuccess) fprintf(stderr, "kernel_launch: cooperative launch failed: %s (grid %d)\n", hipGetErrorString(e), grid);
}
```

```cpp
#include <hip/hip_runtime.h>
#include <hip/hip_cooperative_groups.h>
#include <hip/hip_bf16.h>
#include <cstdio>
#include <cstdint>
#include <cmath>
namespace cg = cooperative_groups;

#define LAS __attribute__((address_space(3)))
#define GAS __attribute__((address_space(1)))
typedef unsigned short bf16_t;
typedef short bf16x8 __attribute__((ext_vector_type(8)));
typedef float f32x4 __attribute__((ext_vector_type(4)));
typedef float f32x2 __attribute__((ext_vector_type(2)));
typedef float f32x16 __attribute__((ext_vector_type(16)));
typedef unsigned u32x4 __attribute__((ext_vector_type(4)));
typedef unsigned u32x2 __attribute__((ext_vector_type(2)));
typedef __bf16 bf16x2_t __attribute__((ext_vector_type(2)));

constexpr int DM = 1024, NTOK = 16384, DEPTH = 4, IN_DIM = 7712, LDP = 7936;
constexpr int C_QA = 0, C_KA = 512, C_VA = 1024, C_QB = 2048, C_KB = 3072, C_VB = 3328, C_ZA = 3584, C_ZB = 4608, C_MA = 5632, C_MB = 6656, C_GL = 7680;
constexpr float EPS = 1e-6f;
constexpr float C2 = 0.125f * 1.4426950408889634f;
constexpr float LN2 = 0.6931471805599453f, LOG2E = 1.4426950408889634f;

constexpr size_t MiB = 1u << 20;
constexpr size_t WS_CTL = 0, CTL_BYTES = 65536;
constexpr size_t WS_TAB = 1 * MiB;
constexpr size_t WS_WIN = 2 * MiB;
constexpr size_t WIN_L = (size_t)LDP * 1024;
constexpr size_t WS_WBR = 64 * MiB;
constexpr size_t WS_WOUT = 80 * MiB;
constexpr size_t WS_PROJ = 88 * MiB;
constexpr size_t WS_XB = 336 * MiB;
constexpr size_t WS_SSP = 368 * MiB;
constexpr size_t WS_EF = 369 * MiB;
constexpr size_t WS_EB = WS_EF + 512 * 1024;
constexpr size_t WS_KLTF = 370 * MiB;
constexpr size_t WS_KLTB = 386 * MiB;
constexpr size_t WS_VT = 402 * MiB;
constexpr size_t WS_OF2 = 434 * MiB;
constexpr size_t WS_END = 466 * MiB;

constexpr int LDS_BYTES = 147456, RING_BYTES = 131072, MISC_OFF = 131072 + 512;
constexpr int NPHASE = 51;

__device__ __forceinline__ unsigned pk2(float lo, float hi) { f32x2 v = {lo, hi}; bf16x2_t b = __builtin_convertvector(v, bf16x2_t); return __builtin_bit_cast(unsigned, b); }
__device__ __forceinline__ float bflo(unsigned u) { return __builtin_bit_cast(float, u << 16); }
__device__ __forceinline__ float bfhi(unsigned u) { return __builtin_bit_cast(float, u & 0xffff0000u); }
__device__ __forceinline__ float bf2f(bf16_t v) { return __builtin_bit_cast(float, ((unsigned)v) << 16); }
__device__ __forceinline__ bf16_t f2bf(float f) { return (bf16_t)(pk2(f, 0.f) & 0xffffu); }
__device__ __forceinline__ float fexp(float x) { return __builtin_amdgcn_exp2f(x * LOG2E); }
__device__ __forceinline__ float sigm(float x) { return __builtin_amdgcn_rcpf(1.f + fexp(-x)); }
__device__ __forceinline__ float silu(float x) { return x * sigm(x); }
__device__ __forceinline__ float logsig(float z) { return fminf(z, 0.f) - LN2 * __builtin_amdgcn_logf(1.f + fexp(-fabsf(z))); }
__device__ __forceinline__ int crow(int r, int hi) { return (r & 3) + 8 * (r >> 2) + 4 * hi; }
#define LDS_BARRIER() do { asm volatile("s_waitcnt lgkmcnt(0)" ::: "memory"); __builtin_amdgcn_s_barrier(); } while (0)
#define MFMA32(a, b, c) __builtin_amdgcn_mfma_f32_32x32x16_bf16((a), (b), (c), 0, 0, 0)

namespace pg8 {
constexpr int BM = 256, BK = 64, HALF = 128, HTB = HALF * BK * 2, NXCD = 8, WGM = 8;
__host__ __device__ __forceinline__ int lds_byte(int r, int c) { const int st = (r >> 4) * 2 + (c >> 5), rr = r & 15, cc = c & 31, ob = rr * 64 + cc * 2; return st * 1024 + (ob ^ (((ob >> 9) & 1) << 5)); }
__host__ __device__ __forceinline__ void stage_rc(int b, int& R, int& C) { const int st = b / 1024, sb = b % 1024, swz = sb ^ (((sb >> 9) & 1) << 5); R = (st >> 1) * 16 + swz / 64; C = (st & 1) * 32 + (swz % 64) / 2; }
__host__ __device__ __forceinline__ int perm32(int rho) { const int n = rho >> 4, i = rho & 15; return 8 * (i >> 2) + 4 * n + (i & 3); }
struct Unit { int pm, pn, sel; };
struct Gemm { const bf16_t* A; const bf16_t* Bt; int lda, ldb, K; int selstep; };
struct StaticOrder {
    int nM, nN, nwg, G, c;
    __device__ void init(int M, int N, int G_, int c_) { nM = M / BM; nN = N / BM; nwg = nM * nN; G = G_; c = c_; }
    __device__ bool next(int i, Unit& u) const {
        const long L = (long)i * G + c; if (L >= nwg) return false;
        int wgid = (int)L; { const int q = nwg / NXCD, r = nwg % NXCD, xcd = wgid % NXCD, off = wgid / NXCD; wgid = (xcd < r ? xcd * (q + 1) : r * (q + 1) + (xcd - r) * q) + off; }
        const int nig = WGM * nN, gid = wgid / nig, fm = gid * WGM, gsz = (nM - fm) < WGM ? (nM - fm) : WGM;
        u.pm = fm + ((wgid % nig) % gsz); u.pn = (wgid % nig) / gsz; u.sel = 0; return true;
    }
};
struct PairOrder {
    StaticOrder b;
    __device__ bool next(int i, Unit& u) const { const bool ok = b.next(i >> 1, u); u.sel = i & 1; return ok; }
};
template <class Epi, bool ALIGN_EPI = true, class Sched = StaticOrder>
__device__ __forceinline__ void gemm_phase(LAS unsigned char* lds, const Gemm g, const Sched& S, const Epi& E) {
    int tid = threadIdx.x; asm volatile("" : "+v"(tid));
    const int wid = __builtin_amdgcn_readfirstlane(tid >> 6), lane = tid & 63, wr = wid >> 2, wc = wid & 3, fr = lane & 15, fq = lane >> 4;
    const int K = g.K, nt = K / BK;
    unsigned voffA[2], voffB[2];
#pragma unroll
    for (int i = 0; i < 2; ++i) { int R, C; stage_rc(tid * 16 + i * 8192, R, C); const int Rb = (R & ~31) + perm32(R & 31);
        voffA[i] = (unsigned)(R * g.lda + C) * 2u; voffB[i] = (unsigned)(Rb * g.ldb + C) * 2u; }
    const size_t kstep = (size_t)(BK * 2);
    const size_t hstepA = (size_t)HALF * g.lda * 2, hstepB = (size_t)HALF * g.ldb * 2;
    const size_t tstepA = 2 * hstepA, tstepB = 2 * hstepB;
    const unsigned ldsw = (unsigned)wid * 1024u;
    const int aoff = lds_byte(wr * 64 + fr, fq * 8), boff = lds_byte(wc * 32 + fr, fq * 8);
#define PG8_SA(b, h) (((b) * 2 + (h)) * HTB)
#define PG8_SB(b, h) ((4 + (b) * 2 + (h)) * HTB)
#define PG8_STAGE(bufoff, gbase, voff) do { _Pragma("unroll") for (int _i = 0; _i < 2; ++_i) \
        __builtin_amdgcn_global_load_lds((const unsigned*)((const char*)(gbase) + (voff)[_i]), (LAS unsigned*)(lds + (bufoff) + ldsw + _i * 8192), 16, 0, 0); } while (0)
#define PG8_LDA(dst, b, h) do { _Pragma("unroll") for (int m = 0; m < 4; ++m) _Pragma("unroll") for (int k = 0; k < 2; ++k) dst[m][k] = *(const LAS bf16x8*)(lds + PG8_SA(b, h) + aoff + m * 2048 + k * 1024); } while (0)
#define PG8_LDB(dst, b, h) do { _Pragma("unroll") for (int n = 0; n < 2; ++n) _Pragma("unroll") for (int k = 0; k < 2; ++k) dst[n][k] = *(const LAS bf16x8*)(lds + PG8_SB(b, h) + boff + n * 2048 + k * 1024); } while (0)
#define PG8_MMA(ai, bj, At, Bt) do { __builtin_amdgcn_s_setprio(1); _Pragma("unroll") for (int m = 0; m < 4; ++m) _Pragma("unroll") for (int n = 0; n < 2; ++n) _Pragma("unroll") for (int k = 0; k < 2; ++k) \
        acc[ai][bj][m][n] = __builtin_amdgcn_mfma_f32_16x16x32_bf16(Bt[n][k], At[m][k], acc[ai][bj][m][n], 0, 0, 0); __builtin_amdgcn_s_setprio(0); } while (0)
#define PG8_WAIT_V(n) asm volatile("s_waitcnt vmcnt(" #n ")" ::: "memory")
#define PG8_WAIT_L(n) asm volatile("s_waitcnt lgkmcnt(" #n ")" ::: "memory")
#define PG8_BAR __builtin_amdgcn_s_barrier()
#define PG8_SCHED __builtin_amdgcn_sched_barrier(0)
    Unit cur, nxt; int ui = 0;
    if (!S.next(0, cur)) return;
    f32x4 acc[2][2][4][2];
#pragma unroll
    for (int a = 0; a < 2; ++a)
#pragma unroll
        for (int b = 0; b < 2; ++b)
#pragma unroll
            for (int m = 0; m < 4; ++m)
#pragma unroll
                for (int n = 0; n < 2; ++n) acc[a][b][m][n] = (f32x4){0.f, 0.f, 0.f, 0.f};
    bf16x8 At[4][2], B0[2][2], B1[2][2];
    if constexpr (Epi::HAS_PRE) E.pre(cur, 0);
    const char* cA = (const char*)g.A + (size_t)cur.pm * tstepA + (size_t)cur.sel * g.selstep; const char* cB = (const char*)g.Bt + (size_t)cur.pn * tstepB + (size_t)cur.sel * g.selstep;
    PG8_STAGE(PG8_SB(0, 0), cB, voffB); PG8_STAGE(PG8_SB(0, 1), cB + hstepB, voffB); PG8_STAGE(PG8_SA(0, 0), cA, voffA); PG8_STAGE(PG8_SA(0, 1), cA + hstepA, voffA);
    if (wr == 1) PG8_BAR;
    PG8_WAIT_V(2); PG8_BAR;
    PG8_STAGE(PG8_SB(1, 0), cB + kstep, voffB); PG8_STAGE(PG8_SA(1, 0), cA + kstep, voffA); PG8_STAGE(PG8_SB(1, 1), cB + hstepB + kstep, voffB);
    PG8_WAIT_V(6); PG8_BAR;
    for (;;) {
        const bool has_next = S.next(ui + 1, nxt);
        const char* nA = has_next ? (const char*)g.A + (size_t)nxt.pm * tstepA + (size_t)nxt.sel * g.selstep : cA; const char* nB = has_next ? (const char*)g.Bt + (size_t)nxt.pn * tstepB + (size_t)nxt.sel * g.selstep : cB;
        for (int t = 0; t < nt; t += 2) {
            const bool last = (t == nt - 2);
            const char* a1 = cA + (size_t)(t + 1) * kstep;
            const char* a2 = last ? nA : cA + (size_t)(t + 2) * kstep; const char* b2 = last ? nB : cB + (size_t)(t + 2) * kstep;
            const char* a3 = a2 + kstep; const char* b3 = b2 + kstep;
            PG8_LDB(B0, 0, 0); PG8_LDB(B1, 0, 1); PG8_SCHED; PG8_LDA(At, 0, 0); PG8_STAGE(PG8_SA(1, 1), a1 + hstepA, voffA);
            PG8_WAIT_V(8); PG8_WAIT_L(0); PG8_BAR; PG8_MMA(0, 0, At, B0); PG8_MMA(0, 1, At, B1); PG8_BAR; PG8_SCHED;
            PG8_LDA(At, 0, 1); PG8_STAGE(PG8_SB(0, 0), b2, voffB); PG8_STAGE(PG8_SB(0, 1), b2 + hstepB, voffB); PG8_STAGE(PG8_SA(0, 0), a2, voffA);
            PG8_WAIT_V(8); PG8_WAIT_L(0); PG8_BAR; PG8_MMA(1, 0, At, B0); PG8_MMA(1, 1, At, B1); PG8_BAR; PG8_SCHED;
            PG8_LDB(B0, 1, 0); PG8_LDB(B1, 1, 1); PG8_SCHED; PG8_LDA(At, 1, 0); PG8_STAGE(PG8_SA(0, 1), a2 + hstepA, voffA);
            PG8_WAIT_V(8); PG8_WAIT_L(0); PG8_BAR; PG8_MMA(0, 0, At, B0); PG8_MMA(0, 1, At, B1); PG8_BAR; PG8_SCHED;
            PG8_LDA(At, 1, 1); PG8_STAGE(PG8_SB(1, 0), b3, voffB); PG8_STAGE(PG8_SB(1, 1), b3 + hstepB, voffB); PG8_STAGE(PG8_SA(1, 0), a3, voffA);
            PG8_WAIT_V(8); PG8_WAIT_L(0); PG8_BAR; PG8_MMA(1, 0, At, B0); PG8_MMA(1, 1, At, B1); PG8_BAR; PG8_SCHED;
        }
        if constexpr (Epi::HAS_PRE) { if (has_next) E.pre(nxt, (ui + 1) & 1); }
        if constexpr (ALIGN_EPI) { if (wr == 0) PG8_BAR; }
        if constexpr (Epi::HAS_PRE) E(acc, cur, wr, wc, fr, fq, ui & 1); else E(acc, cur, wr, wc, fr, fq);
        if (!has_next) break;
#pragma unroll
        for (int a = 0; a < 2; ++a)
#pragma unroll
            for (int b = 0; b < 2; ++b)
#pragma unroll
                for (int m = 0; m < 4; ++m)
#pragma unroll
                    for (int n = 0; n < 2; ++n) acc[a][b][m][n] = (f32x4){0.f, 0.f, 0.f, 0.f};
        cur = nxt; cA = nA; cB = nB; ++ui;
        if constexpr (ALIGN_EPI) { if (wr == 1) PG8_BAR; }
    }
    PG8_WAIT_V(0);
    if constexpr (!ALIGN_EPI) { if (wr == 0) PG8_BAR; }
    PG8_BAR;
#undef PG8_SA
#undef PG8_SB
#undef PG8_STAGE
#undef PG8_LDA
#undef PG8_LDB
#undef PG8_MMA
#undef PG8_WAIT_V
#undef PG8_WAIT_L
#undef PG8_BAR
#undef PG8_SCHED
}

struct EpiProj {
    static constexpr bool HAS_PRE = true;
    bf16_t* O; const float* ssp; LAS float* stash;
    __device__ __forceinline__ void pre(const Unit& u, int buf) const {
        int t = threadIdx.x; asm volatile("" : "+v"(t));
        if (t < 256) { const f32x4* sp = (const f32x4*)(ssp + (size_t)(u.pm * BM + t) * 16);
            const f32x4 s4 = (sp[0] + sp[1]) + (sp[2] + sp[3]);
            stash[buf * 256 + t] = __builtin_amdgcn_rsqf(((s4[0] + s4[1]) + (s4[2] + s4[3])) * (1.f / 1024.f) + EPS); }
    }
    __device__ __forceinline__ void operator()(const f32x4 (&acc)[2][2][4][2], const Unit& u, int wr, int wc, int fr, int fq, int buf) const {
        const int rl0 = wr * 64 + fr, col0 = u.pn * BM + wc * 32 + 8 * fq;
#pragma unroll
        for (int ai = 0; ai < 2; ++ai)
#pragma unroll
            for (int m = 0; m < 4; ++m) {
                const int rl = rl0 + ai * HALF + m * 16;
                const float rs = stash[buf * 256 + rl];
                bf16_t* rowp = O + (size_t)(u.pm * BM + rl) * LDP + col0;
#pragma unroll
                for (int bj = 0; bj < 2; ++bj) { const f32x4 v0 = acc[ai][bj][m][0] * rs, v1 = acc[ai][bj][m][1] * rs;
                    u32x4 w; w.x = pk2(v0[0], v0[1]); w.y = pk2(v0[2], v0[3]); w.z = pk2(v1[0], v1[1]); w.w = pk2(v1[2], v1[3]);
                    *(u32x4*)(rowp + bj * HALF) = w; }
            }
    }
};

template <int SECOND> struct EpiBranch {
    static constexpr bool HAS_PRE = false;
    bf16_t* P; bf16_t* W; int rmask;
    __device__ __forceinline__ void operator()(const f32x4 (&acc)[2][2][4][2], const Unit& u, int wr, int wc, int fr, int fq) const {
        const int row0 = u.pm * BM + wr * 64 + fr, col0 = u.pn * BM + wc * 32 + 8 * fq;
#pragma unroll
        for (int ai = 0; ai < 2; ++ai)
#pragma unroll
            for (int m = 0; m < 4; ++m) {
                bf16_t* rowp = P + (size_t)(row0 + ai * HALF + m * 16) * LDP + col0; bf16_t* roww = W + (size_t)((row0 + ai * HALF + m * 16) & rmask) * LDP + col0;
#pragma unroll
                for (int bj = 0; bj < 2; ++bj) {
                    const u32x4 a = *(const u32x4*)(rowp + C_MA + bj * HALF);
                    float ma[8] = {bflo(a.x), bfhi(a.x), bflo(a.y), bfhi(a.y), bflo(a.z), bfhi(a.z), bflo(a.w), bfhi(a.w)};
                    float o[8];
                    if (SECOND) {
                        const u32x4 b = *(const u32x4*)(rowp + C_MB + bj * HALF);
                        float mb[8] = {bflo(b.x), bfhi(b.x), bflo(b.y), bfhi(b.y), bflo(b.z), bfhi(b.z), bflo(b.w), bfhi(b.w)};
#pragma unroll
                        for (int e = 0; e < 8; ++e) o[e] = ma[e] + acc[ai][bj][m][e >> 2][e & 3] * sigm(mb[e]);
                    } else {
#pragma unroll
                        for (int e = 0; e < 8; ++e) o[e] = acc[ai][bj][m][e >> 2][e & 3] * sigm(ma[e]);
                    }
                    u32x4 w; w.x = pk2(o[0], o[1]); w.y = pk2(o[2], o[3]); w.z = pk2(o[4], o[5]); w.w = pk2(o[6], o[7]);
                    *(u32x4*)(roww + C_MA + bj * HALF) = w;
                }
            }
    }
};
struct EpiBranchPair {
    static constexpr bool HAS_PRE = false;
    bf16_t* P;
    __device__ __forceinline__ void operator()(const f32x4 (&acc)[2][2][4][2], const Unit& u, int wr, int wc, int fr, int fq) const {
        if (u.sel == 0) { EpiBranch<0> e{P, P, -1}; e(acc, u, wr, wc, fr, fq); } else { EpiBranch<1> e{P, P, -1}; e(acc, u, wr, wc, fr, fq); }
    }
};
struct EpiOut {
    static constexpr bool HAS_PRE = false;
    const float* xold; float* xnew; bf16_t* xb; float* ssp; int rmask;
    __device__ __forceinline__ void operator()(const f32x4 (&acc)[2][2][4][2], const Unit& u, int wr, int wc, int fr, int fq) const {
        const int row0 = u.pm * BM + wr * 64 + fr, col0 = u.pn * BM + wc * 32 + 8 * fq;
#pragma unroll
        for (int ai = 0; ai < 2; ++ai)
#pragma unroll
            for (int m = 0; m < 4; ++m) {
                const int row = row0 + ai * HALF + m * 16;
                float ss = 0.f;
#pragma unroll
                for (int bj = 0; bj < 2; ++bj) {
                    const size_t off = (size_t)row * DM + col0 + bj * HALF, offw = (size_t)(row & rmask) * DM + col0 + bj * HALF;
                    const f32x4 x0 = *(const f32x4*)(xold + off), x1 = *(const f32x4*)(xold + off + 4);
                    const f32x4 v0 = x0 + acc[ai][bj][m][0], v1 = x1 + acc[ai][bj][m][1];
                    *(f32x4*)(xnew + offw) = v0; *(f32x4*)(xnew + offw + 4) = v1;
                    u32x4 w; w.x = pk2(v0[0], v0[1]); w.y = pk2(v0[2], v0[3]); w.z = pk2(v1[0], v1[1]); w.w = pk2(v1[2], v1[3]);
                    *(u32x4*)(xb + offw) = w;
                    ss += (v0[0] * v0[0] + v0[1] * v0[1]) + (v0[2] * v0[2] + v0[3] * v0[3]) + (v1[0] * v1[0] + v1[1] * v1[1]) + (v1[2] * v1[2] + v1[3] * v1[3]);
                }
                ss += __shfl_xor(ss, 16); ss += __shfl_xor(ss, 32);
                if (fq == 0) ssp[(size_t)(row & rmask) * 16 + u.pn * 4 + wc] = ss;
            }
    }
};
}

namespace attn_body {
using bf16 = __hip_bfloat16;
using s16x4 = __attribute__((ext_vector_type(4))) short;
constexpr int D = 64, P = LDP;
constexpr int NW = 8, QBLK = 32, QB = QBLK * NW, KVBLK = 64;
#define SBAR() __builtin_amdgcn_sched_barrier(0)
constexpr int NSLOT = 3, SLOTB = 8192;
constexpr int LDS_K = 0, LDS_V = NSLOT * SLOTB, LDS_WS = 2 * NSLOT * SLOTB, LDS_OST = LDS_WS + NW * 64 * 4, ATT_LDS_BYTES = LDS_OST + NW * 4096;
__device__ __forceinline__ void glds16(const void* gsrc, unsigned lds_dst) { unsigned keep;
  asm volatile("s_mov_b32 %0, m0\n\ts_mov_b32 m0, %2\n\ts_nop 0\n\tglobal_load_lds_dwordx4 %1, off\n\ts_mov_b32 m0, %0" : "=&s"(keep) : "v"(gsrc), "s"(lds_dst) : "memory"); }
__device__ __forceinline__ float max3f(float a, float b, float c) { float r; asm("v_max3_f32 %0, %1, %2, %3" : "=v"(r) : "v"(a), "v"(b), "v"(c)); return r; }
__device__ __forceinline__ float max2f(float a, float b) { float r; asm("v_max_f32_e32 %0, %1, %2" : "=v"(r) : "v"(a), "v"(b)); return r; }
__device__ __forceinline__ float fadd_s(float a, float b) { float r; asm("v_add_f32_e32 %0, %1, %2" : "=v"(r) : "v"(a), "v"(b)); return r; }
__device__ __forceinline__ float fsub_s(float a, float b) { float r; asm("v_sub_f32_e32 %0, %1, %2" : "=v"(r) : "v"(a), "v"(b)); return r; }
__device__ __forceinline__ unsigned cvtpk_s(float lo, float hi) { return pk2(lo, hi); }
#define WAIT_BAR(N) asm volatile("s_waitcnt vmcnt(" #N ") lgkmcnt(0)\n\ts_barrier" ::: "memory")
__device__ __forceinline__ void qkt(f32x16& p0, f32x16& p1, const char* Kslot, const bf16x8* qr, const f32x16& negm, int r32, int hi) {
  const char* kb = Kslot + hi * 1024 + r32 * 16;
  #pragma unroll
  for (int d0 = 0; d0 < 4; ++d0) {
    const bf16x8 b0 = *reinterpret_cast<const bf16x8*>(kb + d0 * 2048);
    const bf16x8 b1 = *reinterpret_cast<const bf16x8*>(kb + d0 * 2048 + 512);
    if (d0 == 0) { p0 = MFMA32(b0, qr[0], negm); p1 = MFMA32(b1, qr[0], negm); }
    else { p0 = MFMA32(b0, qr[d0], p0); p1 = MFMA32(b1, qr[d0], p1); } }
}
typedef __attribute__((address_space(3))) const char* lds_cptr;
typedef short v4i16_t __attribute__((ext_vector_type(4)));
__device__ __forceinline__ void kload8(bf16x8* kf, lds_cptr kp) {
  kf[0] = *(const LAS bf16x8*)(kp);        kf[1] = *(const LAS bf16x8*)(kp + 512);
  kf[2] = *(const LAS bf16x8*)(kp + 2048); kf[3] = *(const LAS bf16x8*)(kp + 2560);
  kf[4] = *(const LAS bf16x8*)(kp + 4096); kf[5] = *(const LAS bf16x8*)(kp + 4608);
  kf[6] = *(const LAS bf16x8*)(kp + 6144); kf[7] = *(const LAS bf16x8*)(kp + 6656);
}
__device__ __forceinline__ void kload2(bf16x8* kf, lds_cptr kp, int j) { kf[2 * j] = *(const LAS bf16x8*)(kp + j * 2048); kf[2 * j + 1] = *(const LAS bf16x8*)(kp + j * 2048 + 512); }
__device__ __forceinline__ s16x4 vtr(lds_cptr p) { return __builtin_bit_cast(s16x4, __builtin_amdgcn_ds_read_tr16_b64_v4i16((LAS v4i16_t*)p)); }
__device__ __forceinline__ float rowmax(const f32x16& p0, const f32x16& p1) {
  float a = max3f(p0[0], p0[1], p1[0]), b = max3f(p0[2], p0[3], p1[1]); a = max3f(a, p1[2], p1[3]);
  #pragma unroll
  for (int r = 4; r < 16; r += 4) { a = max3f(a, p0[r], p0[r + 1]); b = max3f(b, p0[r + 2], p0[r + 3]); a = max3f(a, p1[r], p1[r + 1]); b = max3f(b, p1[r + 2], p1[r + 3]); }
  const float m = max2f(a, b);
  auto rr = __builtin_amdgcn_permlane32_swap(__float_as_uint(m), __float_as_uint(m), false, false);
  return max2f(__uint_as_float(rr[0]), __uint_as_float(rr[1]));
}
__device__ __forceinline__ void pv(f32x16* o, int vb, bf16x8 pa0, bf16x8 pa1, bf16x8 pa2, bf16x8 pa3) {
  #pragma unroll
  for (int d0 = 0; d0 < 2; ++d0) { s16x4 lo[4], hi[4];
    #pragma unroll
    for (int ks = 0; ks < 4; ++ks) {
      asm volatile("ds_read_b64_tr_b16 %0,%1 offset:%c2" : "=&v"(lo[ks]) : "v"(vb), "i"(d0 * 4096 + ks * 1024) : "memory");
      asm volatile("ds_read_b64_tr_b16 %0,%1 offset:%c2" : "=&v"(hi[ks]) : "v"(vb), "i"(d0 * 4096 + ks * 1024 + 512) : "memory"); }
    asm volatile("s_waitcnt lgkmcnt(0)" ::: "memory"); SBAR();
    #define PK(k) (bf16x8){lo[k][0], lo[k][1], lo[k][2], lo[k][3], hi[k][0], hi[k][1], hi[k][2], hi[k][3]}
    o[d0] = MFMA32(pa0, PK(0), o[d0]);
    o[d0] = MFMA32(pa1, PK(1), o[d0]);
    o[d0] = MFMA32(pa2, PK(2), o[d0]);
    o[d0] = MFMA32(pa3, PK(3), o[d0]);
    #undef PK
  }
}
template <int THRL> __device__ __forceinline__ void attn_unit(const bf16* Qu, const bf16* __restrict__ Kh, const bf16* __restrict__ Vh, bf16* Zu, int NT, char* shm, const float* qg, const float* tabc, const float* tabs, int t0) {
  int tid = threadIdx.x; asm volatile("" : "+v"(tid));
  const int lane = tid & 63, r32 = lane & 31, hi = lane >> 5; const int wid = __builtin_amdgcn_readfirstlane(tid >> 6);
  const bf16* Qw = Qu + (long)(wid * QBLK) * P;
  const unsigned lds0 = (unsigned)(uintptr_t)shm;
  float* wsf = (float*)(shm + LDS_WS) + wid * 64;
  const bf16* ksrc = Kh + (long)lane * P + wid * 8;
  const bf16* vsrc = Vh + (long)(16 * (wid & 3) + (lane >> 2)) * P + (wid >> 2) * 32 + (lane & 3) * 8;
  const unsigned kdst = lds0 + LDS_K + wid * 1024, vdst = lds0 + LDS_V + wid * 1024;
  #define DMA_K(t, slot) glds16(ksrc + (long)(t) * KVBLK * P, (unsigned)__builtin_amdgcn_readfirstlane(kdst + (slot)))
  #define DMA_V(t, slot) glds16(vsrc + (long)(t) * KVBLK * P, (unsigned)__builtin_amdgcn_readfirstlane(vdst + (slot)))
  const int vb0 = (int)(lds0 + LDS_V) + ((lane >> 4) & 1) * 32 + (lane & 3) * 8 + (4 * hi + ((lane & 15) >> 2)) * 64;
  const char* Kbase = shm + LDS_K; bf16x8 kf[8];
  const lds_cptr shm3 = (lds_cptr)shm; const lds_cptr kp0 = shm3 + LDS_K + hi * 1024 + r32 * 16; const lds_cptr vp0 = shm3 + LDS_V + ((lane >> 4) & 1) * 32 + (lane & 3) * 8 + (4 * hi + ((lane & 15) >> 2)) * 64;
  DMA_K(0, 0); DMA_V(0, 0); DMA_K(1, SLOTB);
  bf16x8 qr[4];
  #pragma unroll
  for (int d0 = 0; d0 < 4; ++d0) qr[d0] = *reinterpret_cast<const bf16x8*>(&Qw[(long)r32 * P + d0 * 16 + hi * 8]);
  {
    float x[4][8]; float ss = 0.f;
    #pragma unroll
    for (int d0 = 0; d0 < 4; ++d0) { const u32x4 u = __builtin_bit_cast(u32x4, qr[d0]);
      x[d0][0] = bflo(u.x); x[d0][1] = bfhi(u.x); x[d0][2] = bflo(u.y); x[d0][3] = bfhi(u.y); x[d0][4] = bflo(u.z); x[d0][5] = bfhi(u.z); x[d0][6] = bflo(u.w); x[d0][7] = bfhi(u.w);
      #pragma unroll
      for (int j = 0; j < 8; ++j) ss += x[d0][j] * x[d0][j]; }
    { auto rr = __builtin_amdgcn_permlane32_swap(__float_as_uint(ss), __float_as_uint(ss), false, false); ss = __uint_as_float(rr[0]) + __uint_as_float(rr[1]); }
    const float rs = __builtin_amdgcn_rsqf(ss * (1.f / 64.f) + EPS) * C2;
    const int tq = t0 + wid * QBLK + r32, pr = tq >> 6, pc = tq & 63;
    #pragma unroll
    for (int d0 = 0; d0 < 4; ++d0) { const f32x4 g0 = *(const f32x4*)(qg + 16 * d0 + 8 * hi), g1 = *(const f32x4*)(qg + 16 * d0 + 8 * hi + 4);
      #pragma unroll
      for (int j = 0; j < 4; ++j) { x[d0][j] *= rs * g0[j]; x[d0][4 + j] *= rs * g1[j]; } }
    #pragma unroll
    for (int ax = 0; ax < 2; ++ax) { const int pos = ax ? pc : pr;
      const f32x4 c0 = *(const f32x4*)(tabc + pos * 16 + 8 * hi), c1 = *(const f32x4*)(tabc + pos * 16 + 8 * hi + 4), s0 = *(const f32x4*)(tabs + pos * 16 + 8 * hi), s1 = *(const f32x4*)(tabs + pos * 16 + 8 * hi + 4);
      #pragma unroll
      for (int j = 0; j < 8; ++j) { const float cc = j < 4 ? c0[j & 3] : c1[j & 3], sn = j < 4 ? s0[j & 3] : s1[j & 3];
        const float a = x[2 * ax][j], b = x[2 * ax + 1][j]; x[2 * ax][j] = a * cc - b * sn; x[2 * ax + 1][j] = b * cc + a * sn; } }
    #pragma unroll
    for (int d0 = 0; d0 < 4; ++d0) { u32x4 u; u.x = pk2(x[d0][0], x[d0][1]); u.y = pk2(x[d0][2], x[d0][3]); u.z = pk2(x[d0][4], x[d0][5]); u.w = pk2(x[d0][6], x[d0][7]); qr[d0] = __builtin_bit_cast(bf16x8, u); }
  }
  float mhat = 0.f, l_reg = 0.f; f32x16 o[2]; o[0] = f32x16{}; o[1] = f32x16{}; f32x16 negm = f32x16{}; asm volatile("" : "+v"(negm));
  bool resc = false;
  #define START(P0, P1) do { const float rm = rowmax(P0, P1); resc = false; \
    { const float dl = rm; mhat = fadd_s(mhat, dl); \
      _Pragma("unroll") for (int r = 0; r < 16; ++r) { P0[r] = fsub_s(P0[r], dl); P1[r] = fsub_s(P1[r], dl); } \
      _Pragma("unroll") for (int r = 0; r < 16; ++r) negm[r] = -mhat; asm volatile("" : "+v"(negm)); } \
    _Pragma("unroll") for (int r = 0; r < 16; ++r) P0[r] = __builtin_amdgcn_exp2f(P0[r]); } while (0)
  #define RESC() do { if (resc) { asm volatile("s_waitcnt lgkmcnt(0)" ::: "memory"); \
      _Pragma("unroll") for (int d_ = 0; d_ < 2; ++d_) _Pragma("unroll") for (int r = 0; r < 16; ++r) o[d_][r] *= wsf[crow(r, hi)]; } } while (0)
  f32x16 pA0, pA1, pB0, pB1;
  int sl_prev = 0, sl_cur = 0, sl_next = SLOTB;
  #define ROT() do { sl_prev = sl_cur; sl_cur = sl_next; sl_next = (sl_next == (NSLOT - 1) * SLOTB) ? 0 : sl_next + SLOTB; } while (0)
  DMA_K(2, 2 * SLOTB);
  WAIT_BAR(3);
  qkt(pA0, pA1, Kbase, qr, negm, r32, hi); asm volatile("s_nop 15\n\ts_nop 7" : "+v"(pA0), "+v"(pA1));
  START(pA0, pA1);
  _Pragma("unroll") for (int r = 0; r < 16; ++r) pA1[r] = __builtin_amdgcn_exp2f(pA1[r]);
  WAIT_BAR(0);
  DMA_K(3, 0); DMA_V(1, SLOTB);
  ROT();
  kload8(kf, kp0 + sl_cur);
  WAIT_BAR(2);
  s16x4 vlo[8], vhi[8]; u32x4 pw0, pw1, pw2, pw3;
  #define PKW(Pq, B) cvtpk_s(Pq[B], Pq[B + 1])
  #define PAF(k) __builtin_bit_cast(bf16x8, pw##k)
  #define VFR(i) (bf16x8){vlo[i][0], vlo[i][1], vlo[i][2], vlo[i][3], vhi[i][0], vhi[i][1], vhi[i][2], vhi[i][3]}
  #define PIN(x) asm volatile("" : "+v"(x))
  #define MX3(a, b, c) __builtin_fmaxf(__builtin_fmaxf((a), (b)), (c))
  #define GAPA(MF, A0, A1, A2, A3, W0, W1, PW) do { MF; sacc += A0; sacc += A1; sacc += A2; sacc += A3; PIN(sacc); W0; W1; PIN(PW); SBAR(); } while (0)
  #define EX(v) __builtin_amdgcn_exp2f(v)
  #define GAPB(MF, X, B) do { MF; X[B] = EX(X[B]); X[B + 1] = EX(X[B + 1]); X[B + 2] = EX(X[B + 2]); X[B + 3] = EX(X[B + 3]); PIN(X); SBAR(); } while (0)
  #define VRD(i) do { vlo[i] = vtr(vp_ + (((i) >> 2) * 4096 + ((i) & 3) * 1024)); vhi[i] = vtr(vp_ + (((i) >> 2) * 4096 + ((i) & 3) * 1024 + 512)); } while (0)
  #define KRD(G, j) do { if (G) { kload2(kf, kp0 + sl_next, j); SBAR(); } } while (0)
  #define STEP(C0, C1, P0, P1, t, GK, GV, GL) do { SBAR(); \
    const lds_cptr vp_ = vp0 + sl_prev; \
    VRD(0); SBAR(); float sacc = (P0[0] + P0[1]); \
    GAPA(C0 = MFMA32(kf[0], qr[0], negm), P0[2], P0[3], P0[4], P0[5],     pw0[0] = PKW(P0, 0), pw0[1] = PKW(P0, 2), pw0); \
    VRD(4); SBAR(); GAPA(C1 = MFMA32(kf[1], qr[0], negm), P0[6], P0[7], P0[8], P0[9],     pw0[2] = PKW(P0, 4), pw0[3] = PKW(P0, 6), pw0); \
    VRD(1); SBAR(); GAPA(C0 = MFMA32(kf[2], qr[1], C0),   P0[10], P0[11], P0[12], P0[13], pw1[0] = PKW(P0, 8), pw1[1] = PKW(P0, 10), pw1); \
    VRD(5); SBAR(); GAPA(C1 = MFMA32(kf[3], qr[1], C1),   P0[14], P0[15], P1[0], P1[1],   pw1[2] = PKW(P0, 12), pw1[3] = PKW(P0, 14), pw1); \
    VRD(2); SBAR(); GAPA(C0 = MFMA32(kf[4], qr[2], C0),   P1[2], P1[3], P1[4], P1[5],     pw2[0] = PKW(P1, 0), pw2[1] = PKW(P1, 2), pw2); \
    VRD(6); SBAR(); GAPA(C1 = MFMA32(kf[5], qr[2], C1),   P1[6], P1[7], P1[8], P1[9],     pw2[2] = PKW(P1, 4), pw2[3] = PKW(P1, 6), pw2); \
    VRD(3); SBAR(); GAPA(C0 = MFMA32(kf[6], qr[3], C0),   P1[10], P1[11], P1[12], P1[13], pw3[0] = PKW(P1, 8), pw3[1] = PKW(P1, 10), pw3); \
    VRD(7); SBAR(); GAPA(C1 = MFMA32(kf[7], qr[3], C1),   P1[14], P1[15], 0.f, 0.f,       pw3[2] = PKW(P1, 12), pw3[3] = PKW(P1, 14), pw3); \
    l_reg += sacc; \
    if (GK) { DMA_K((t) + 3, sl_cur); } if (GV) { DMA_V((t) + 1, sl_next); } \
    { float a = MX3(C0[0], C0[1], C1[0]), b = MX3(C0[2], C0[3], C1[1]); a = MX3(a, C1[2], C1[3]); \
      _Pragma("unroll") for (int r = 4; r < 16; r += 4) { a = MX3(a, C0[r], C0[r + 1]); b = MX3(b, C0[r + 2], C0[r + 3]); a = MX3(a, C1[r], C1[r + 1]); b = MX3(b, C1[r + 2], C1[r + 3]); } \
      float rm = __builtin_fmaxf(a, b); { auto rr = __builtin_amdgcn_permlane32_swap(__float_as_uint(rm), __float_as_uint(rm), false, false); rm = __builtin_fmaxf(__uint_as_float(rr[0]), __uint_as_float(rr[1])); } \
      resc = false; \
      if (__builtin_expect(__any(rm > (float)THRL), 0)) { const float dl = __builtin_fmaxf(rm, 0.f); mhat += dl; \
        _Pragma("unroll") for (int r = 0; r < 16; ++r) { C0[r] -= dl; C1[r] -= dl; } \
        _Pragma("unroll") for (int r = 0; r < 16; ++r) negm[r] = -mhat; asm volatile("" : "+v"(negm)); \
        const float f = __builtin_amdgcn_exp2f(-dl); l_reg *= f; if (hi == 0) wsf[r32] = f; resc = true; } } \
    SBAR(); \
    GAPB(o[0] = MFMA32(PAF(0), VFR(0), o[0]), C0, 0); \
    GAPB(o[1] = MFMA32(PAF(0), VFR(4), o[1]), C0, 4); \
    KRD(GL, 0); GAPB(o[0] = MFMA32(PAF(1), VFR(1), o[0]), C0, 8); \
    KRD(GL, 1); GAPB(o[1] = MFMA32(PAF(1), VFR(5), o[1]), C0, 12); \
    KRD(GL, 2); GAPB(o[0] = MFMA32(PAF(2), VFR(2), o[0]), C1, 0); \
    KRD(GL, 3); GAPB(o[1] = MFMA32(PAF(2), VFR(6), o[1]), C1, 4); \
    GAPB(o[0] = MFMA32(PAF(3), VFR(3), o[0]), C1, 8); \
    GAPB(o[1] = MFMA32(PAF(3), VFR(7), o[1]), C1, 12); \
    } while (0)
  int t = 1;
  for (; t + 5 < NT; t += 2) {
    STEP(pB0, pB1, pA0, pA1, t, true, true, true);     WAIT_BAR(2); RESC(); ROT();
    STEP(pA0, pA1, pB0, pB1, t + 1, true, true, true); WAIT_BAR(2); RESC(); ROT();
  }
  #define ENDW(tt) do { if ((tt) + 3 < NT) { WAIT_BAR(2); } else if ((tt) + 2 < NT) { WAIT_BAR(1); } else { WAIT_BAR(0); } } while (0)
  for (; t + 1 < NT; t += 2) {
    STEP(pB0, pB1, pA0, pA1, t, (t + 3 < NT), (t + 1 < NT), (t + 1 < NT));       ENDW(t);     RESC(); ROT();
    STEP(pA0, pA1, pB0, pB1, t + 1, (t + 4 < NT), (t + 2 < NT), (t + 2 < NT));   ENDW(t + 1); RESC(); ROT();
  }
  STEP(pB0, pB1, pA0, pA1, NT - 1, false, false, false); RESC();
  { float sacc = pB0[0] + pB0[1]; _Pragma("unroll") for (int r = 2; r < 16; ++r) sacc += pB0[r]; _Pragma("unroll") for (int r = 0; r < 16; ++r) sacc += pB1[r]; l_reg += sacc;
    pw0 = (u32x4){PKW(pB0, 0), PKW(pB0, 2), PKW(pB0, 4), PKW(pB0, 6)}; pw1 = (u32x4){PKW(pB0, 8), PKW(pB0, 10), PKW(pB0, 12), PKW(pB0, 14)}; pw2 = (u32x4){PKW(pB1, 0), PKW(pB1, 2), PKW(pB1, 4), PKW(pB1, 6)}; pw3 = (u32x4){PKW(pB1, 8), PKW(pB1, 10), PKW(pB1, 12), PKW(pB1, 14)};
    SBAR(); pv(o, vb0 + sl_cur, PAF(0), PAF(1), PAF(2), PAF(3)); }
  #undef PKW
  #undef PAF
  #undef VFR
  #undef PIN
  #undef MX3
  #undef GAPA
  #undef GAPB
  #undef EX
  #undef VRD
  #undef KRD
  #undef STEP
  #undef ENDW
  { auto rr = __builtin_amdgcn_permlane32_swap(__float_as_uint(l_reg), __float_as_uint(l_reg), false, false); l_reg = __uint_as_float(rr[0]) + __uint_as_float(rr[1]); }
  if (hi == 0) wsf[32 + r32] = l_reg; asm volatile("s_waitcnt lgkmcnt(0)" ::: "memory");
  float rli[16];
  #pragma unroll
  for (int r = 0; r < 16; ++r) rli[r] = __builtin_amdgcn_rcpf(wsf[32 + crow(r, hi)]);
  bf16* Zw = Zu + (long)(wid * QBLK) * P;
  { bf16* stg = (bf16*)(shm + LDS_OST) + wid * 2048;
    #pragma unroll
    for (int r = 0; r < 16; ++r) { const int orow = crow(r, hi);
      #pragma unroll
      for (int d0 = 0; d0 < 2; ++d0) stg[orow * 64 + d0 * 32 + r32] = __float2bfloat16(o[d0][r] * rli[r]); }
    asm volatile("s_waitcnt lgkmcnt(0)" ::: "memory");
    #pragma unroll
    for (int i = 0; i < 4; ++i) { const int row = i * 8 + (lane >> 3), ch = lane & 7; const u32x4 v = *(const u32x4*)(stg + row * 64 + ch * 8);
      u32x4* zp = (u32x4*)(Zw + (long)row * P + ch * 8); const u32x4 z = *zp; u32x4 w;
      w.x = pk2(bflo(v.x) * silu(bflo(z.x)), bfhi(v.x) * silu(bfhi(z.x))); w.y = pk2(bflo(v.y) * silu(bflo(z.y)), bfhi(v.y) * silu(bfhi(z.y)));
      w.z = pk2(bflo(v.z) * silu(bflo(z.z)), bfhi(v.z) * silu(bfhi(z.z))); w.w = pk2(bflo(v.w) * silu(bflo(z.w)), bfhi(v.w) * silu(bfhi(z.w)));
      *zp = w; } }
  asm volatile("s_waitcnt vmcnt(0) lgkmcnt(0)\n\ts_barrier" ::: "memory");
  #undef DMA_K
  #undef DMA_V
  #undef START
  #undef RESC
  #undef ROT
}
#undef SBAR
#undef WAIT_BAR
}

#define XB_TMO      128
#define XB_XCNT(j)  (256  + 64 * (j))
#define XB_XSUB(j)  (1280 + 64 * (j))
#define XB_XGEN(j)  (2304 + 64 * (j))
#define XB_TOP      3328
#define XB_TOPGEN   3392
#define XCD_BAR_WORDS 3456
#define XB_SPIN_CAP (1u << 20)
__device__ __forceinline__ unsigned xb_ld(unsigned* p)              { return __hip_atomic_load(p, __ATOMIC_RELAXED, __HIP_MEMORY_SCOPE_AGENT); }
__device__ __forceinline__ unsigned xb_add(unsigned* p, unsigned v) { return __hip_atomic_fetch_add(p, v, __ATOMIC_RELAXED, __HIP_MEMORY_SCOPE_AGENT); }
__device__ __forceinline__ unsigned xb_xcc_id() { return (unsigned)__builtin_amdgcn_s_getreg((3 << 11) | 20) & 0xFu; }
#define XB_SPIN(cond, bar) do { unsigned _sp = 0; while (cond) { __builtin_amdgcn_s_sleep(1); \
    if ((++_sp & 255u) == 0u) { if (xb_ld(&(bar)[XB_TMO])) break; if (_sp > XB_SPIN_CAP) { atomicAdd(&(bar)[XB_TMO], 1u); break; } } } } while (0)
struct XcdBarrier { unsigned* bar; unsigned x; volatile LAS unsigned* st; };
__device__ __forceinline__ XcdBarrier xcd_barrier_post(unsigned* bar, volatile LAS unsigned* st) {
    XcdBarrier b; b.bar = bar; b.x = xb_xcc_id(); b.st = st;
    if (threadIdx.x == 0) (void)xb_add(&bar[XB_XCNT(b.x)], 1u);
    return b;
}
__device__ __forceinline__ void xcd_barrier_complete(unsigned* bar, unsigned x, unsigned& nloc, unsigned& nx) {
    const unsigned G = gridDim.x * gridDim.y * gridDim.z;
    unsigned sum, cnt, mine, sp = 0u;
    for (;;) {
        sum = 0u; cnt = 0u; mine = 0u;
#pragma unroll 1
        for (unsigned j = 0; j < 16; ++j) { const unsigned c = xb_ld(&bar[XB_XCNT(j)]); sum += c; cnt += (c > 0u) ? 1u : 0u; mine = (j == x) ? c : mine; }
        if (sum == G) break;
        __builtin_amdgcn_s_sleep(1);
        if ((++sp & 255u) == 0u) { if (xb_ld(&bar[XB_TMO])) break; if (sp > XB_SPIN_CAP) { atomicAdd(&bar[XB_TMO], 1u); break; } }
    }
    nloc = mine > 0u ? mine : 1u; nx = cnt > 0u ? cnt : 1u;
}
__device__ __forceinline__ void xcd_barrier(const XcdBarrier& b) {
    asm volatile("s_waitcnt vmcnt(0)" ::: "memory");
    __syncthreads();
    int t0 = threadIdx.x; asm volatile("" : "+v"(t0));
    if (t0 == 0) {
        unsigned* bar = b.bar;
        __builtin_amdgcn_s_waitcnt(0);
        unsigned nloc = b.st[0], nx = b.st[1];
        if (nloc == 0u) { xcd_barrier_complete(bar, b.x, nloc, nx); b.st[0] = nloc; b.st[1] = nx; }
        const unsigned old = xb_add(&bar[XB_XSUB(b.x)], 1u);
        const unsigned gen = old / nloc;
        if (old + 1u == (gen + 1u) * nloc) {
            __builtin_amdgcn_fence(__ATOMIC_RELEASE, "agent");
            asm volatile("s_waitcnt vmcnt(0)" ::: "memory");
            const unsigned og = xb_add(&bar[XB_TOP], 1u);
            const unsigned tg = og / nx;
            if (og + 1u == (tg + 1u) * nx) xb_add(&bar[XB_TOPGEN], 1u);
            else XB_SPIN(xb_ld(&bar[XB_TOPGEN]) == tg, bar);
            __builtin_amdgcn_fence(__ATOMIC_ACQUIRE, "agent");
            xb_add(&bar[XB_XGEN(b.x)], 1u);
            asm volatile("s_waitcnt vmcnt(0)" ::: "memory");
        } else {
            XB_SPIN(xb_ld(&bar[XB_XGEN(b.x)]) == gen, bar);
            __builtin_amdgcn_fence(__ATOMIC_ACQUIRE, "agent");
            asm volatile("s_waitcnt vmcnt(0)" ::: "memory");
        }
    }
    __syncthreads();
}

struct Args { const float* in[15]; float* out; unsigned char* ws; int ph_lo, ph_hi; };

__device__ __forceinline__ float wave_sum(float v) {
#pragma unroll
    for (int o = 1; o < 64; o <<= 1) v += __shfl_xor(v, o);
    return v;
}

__device__ __forceinline__ void tr_item(const float* W, int ldw, int k0, int n0, bf16_t* dst, int dpitch, const float* gk, float sc, LAS float* scr, int lane) {
    { const int kr = lane >> 3, n4 = (lane & 7) * 4; f32x4 v[8];
#pragma unroll
      for (int i = 0; i < 8; ++i) v[i] = *(const f32x4*)(W + (size_t)(k0 + 8 * i + kr) * ldw + n0 + n4);
#pragma unroll
      for (int i = 0; i < 8; ++i) { const int kk = 8 * i + kr; const float g = (gk ? gk[k0 + kk] : 1.f) * sc;
          scr[kk * 33 + n4] = v[i][0] * g; scr[kk * 33 + n4 + 1] = v[i][1] * g; scr[kk * 33 + n4 + 2] = v[i][2] * g; scr[kk * 33 + n4 + 3] = v[i][3] * g; } }
    asm volatile("s_waitcnt lgkmcnt(0)" ::: "memory");
    const int c = lane & 7;
#pragma unroll
    for (int j = 0; j < 4; ++j) { const int n = (lane >> 3) + 8 * j; const LAS float* s = scr + (8 * c) * 33 + n;
        u32x4 o; o.x = pk2(s[0 * 33], s[1 * 33]); o.y = pk2(s[2 * 33], s[3 * 33]); o.z = pk2(s[4 * 33], s[5 * 33]); o.w = pk2(s[6 * 33], s[7 * 33]);
        *(u32x4*)(dst + (size_t)n * dpitch + 8 * c) = o; }
    asm volatile("s_waitcnt lgkmcnt(0)" ::: "memory");
}
__device__ __forceinline__ int map_col(int n0) {
    if (n0 < 2048) return n0;
    if (n0 < 2080) return C_GL;
    if (n0 < 3104) return C_ZA + (n0 - 2080);
    if (n0 < 4128) return C_QB + (n0 - 3104);
    if (n0 < 4384) return C_KB + (n0 - 4128);
    if (n0 < 4640) return C_VB + (n0 - 4384);
    if (n0 < 5664) return C_ZB + (n0 - 4640);
    if (n0 < 6688) return C_MA + (n0 - 5664);
    return C_MB + (n0 - 6688);
}
constexpr int CV_IN = 16 * 241, CV_SQ = 16 * 32, CV_ITEMS = CV_IN + 3 * CV_SQ;
__device__ __forceinline__ void convert_item(const Args& args, int l, int r, bf16_t* WIN, bf16_t* WBR, bf16_t* WOUT, LAS float* scr, int lane) {
    if (r < CV_IN) { const int kb = r / 241, nb = r % 241, n0 = 32 * nb;
        tr_item(args.in[3] + (size_t)l * DM * IN_DIM, IN_DIM, 64 * kb, n0, WIN + (size_t)l * WIN_L + (size_t)map_col(n0) * DM + 64 * kb, DM, args.in[2] + l * DM, n0 < 512 ? 0.08838834764831845f : 1.f, scr, lane);
        return; }
    r -= CV_IN;
    const int which = r / CV_SQ; r %= CV_SQ; const int kb = r / 32, nb = r % 32;
    if (which == 0) tr_item(args.in[11] + (size_t)l * DM * DM, DM, 64 * kb, 32 * nb, WBR + (size_t)l * DM * 2048 + (size_t)(32 * nb) * 2048 + 64 * kb, 2048, nullptr, 1.f, scr, lane);
    else if (which == 1) tr_item(args.in[12] + (size_t)l * DM * DM, DM, 64 * kb, 32 * nb, WBR + (size_t)l * DM * 2048 + (size_t)(32 * nb) * 2048 + 1024 + 64 * kb, 2048, nullptr, 1.f, scr, lane);
    else tr_item(args.in[13] + (size_t)l * DM * DM, DM, 64 * kb, 32 * nb, WOUT + (size_t)l * DM * DM + (size_t)(32 * nb) * DM + 64 * kb, DM, nullptr, 1.f, scr, lane);
}

__device__ __forceinline__ void x_rows_to_bf16(const float* x, bf16_t* xb, float* ssp, int gw, int ngw, int lane) {
    for (int m = gw; m < NTOK; m += ngw) {
        const f32x4* xr = (const f32x4*)(x + (size_t)m * DM) + lane; f32x4 v[4]; float s = 0.f;
#pragma unroll
        for (int j = 0; j < 4; ++j) { v[j] = xr[64 * j]; s += (v[j].x * v[j].x + v[j].y * v[j].y) + (v[j].z * v[j].z + v[j].w * v[j].w); }
        s = wave_sum(s);
        u32x2* o8 = (u32x2*)(xb + (size_t)m * DM) + lane;
#pragma unroll
        for (int j = 0; j < 4; ++j) { u32x2 w; w.x = pk2(v[j].x, v[j].y); w.y = pk2(v[j].z, v[j].w); o8[64 * j] = w; }
        if (lane < 16) ssp[(size_t)m * 16 + lane] = (lane == 0) ? s : 0.f;
    }
}

constexpr int PL_GL = 0, PL_TOT = 8192, PL_QF = 12288, PL_KF = PL_QF + 17408, PL_QB = PL_KF + 17408, PL_KB = PL_QB + 17408, PL_VT = PL_KB + 17408, PL_A = PL_VT + 36864, PL_END = PL_A + 9216;
static_assert(PL_END <= RING_BYTES, "prep LDS");
struct PrepIn { u32x4 gl[2]; u32x4 v[4]; };
struct PrepW { u32x4 wfrag; float bf, bb; };
__device__ __forceinline__ void gla_prep_loadw(PrepW& w, const float* wgf, const float* bgf, const float* wgb, const float* bgb, int h) {
    int tid = threadIdx.x; asm volatile("" : "+v"(tid)); const int c = tid & 127, lane = tid & 63, wave = tid >> 6, l32 = lane & 31, hh = lane >> 5, dir = wave >> 2, cb = wave & 3;
    const float* wg = (dir ? wgb : wgf) + (size_t)(8 * hh) * 512 + h * 128 + 32 * cb + l32;
    float t[8];
#pragma unroll
    for (int j = 0; j < 8; ++j) t[j] = wg[j * 512];
    w.wfrag = (u32x4){pk2(t[0], t[1]), pk2(t[2], t[3]), pk2(t[4], t[5]), pk2(t[6], t[7])};
    w.bf = bgf[h * 128 + c]; w.bb = bgb[h * 128 + c];
}
__device__ __forceinline__ void gla_prep_load(PrepIn& in, const bf16_t* proj, int gc, int h) {
    int tid = threadIdx.x; asm volatile("" : "+v"(tid));
    const int row0 = gc * 64;
    { const int lane = tid & 63, l32 = lane & 31, hh = lane >> 5, dir = tid >> 8;
#pragma unroll
      for (int tb = 0; tb < 2; ++tb) in.gl[tb] = *(const u32x4*)(proj + (size_t)(row0 + 32 * tb + l32) * LDP + C_GL + 16 * dir + 8 * hh); }
#pragma unroll
    for (int i = 0; i < 4; ++i) { const int idx = tid + 512 * i, t = idx & 63, dv = (idx >> 6) * 8; in.v[i] = *(const u32x4*)(proj + (size_t)(row0 + t) * LDP + C_VA + h * 256 + dv); }
}
__device__ __forceinline__ void gla_prep_tile(LAS unsigned char* lds, const PrepIn& in, const PrepW& pw, int gc, int h, bf16_t* proj,
                                              float* ef, float* eb, bf16_t* kltf, bf16_t* kltb, bf16_t* vtg, bf16_t* pst, int rmask) {
    int tid = threadIdx.x; asm volatile("" : "+v"(tid));
    const int lane = tid & 63, wave = tid >> 6, c = tid & 127, s = tid >> 7, l32 = lane & 31, hh = lane >> 5;
    const int row0 = gc * 64;
    LAS float* TOT = (LAS float*)(lds + PL_TOT);
    LAS bf16_t* QFl = (LAS bf16_t*)(lds + PL_QF); LAS bf16_t* KFl = (LAS bf16_t*)(lds + PL_KF); LAS bf16_t* QBl = (LAS bf16_t*)(lds + PL_QB); LAS bf16_t* KBl = (LAS bf16_t*)(lds + PL_KB);
    LAS bf16_t* VTl = (LAS bf16_t*)(lds + PL_VT); LAS bf16_t* Al = (LAS bf16_t*)(lds + PL_A);
    { LAS float* ZL = (LAS float*)(lds + PL_QF);
      const int dir = wave >> 2, cb = wave & 3;
#pragma unroll
      for (int tb = 0; tb < 2; ++tb) { const f32x16 z = MFMA32(__builtin_bit_cast(bf16x8, in.gl[tb]), __builtin_bit_cast(bf16x8, pw.wfrag), f32x16{});
#pragma unroll
          for (int r = 0; r < 16; ++r) ZL[(dir * 64 + 32 * tb + crow(r, hh)) * 128 + 32 * cb + l32] = z[r]; } }
#pragma unroll
    for (int i = 0; i < 4; ++i) { const int idx = tid + 512 * i, t = idx & 63, dv = (idx >> 6) * 8;
        const u32x4 v = in.v[i];
        VTl[(dv + 0) * 72 + t] = (bf16_t)(v.x & 0xffffu); VTl[(dv + 1) * 72 + t] = (bf16_t)(v.x >> 16);
        VTl[(dv + 2) * 72 + t] = (bf16_t)(v.y & 0xffffu); VTl[(dv + 3) * 72 + t] = (bf16_t)(v.y >> 16);
        VTl[(dv + 4) * 72 + t] = (bf16_t)(v.z & 0xffffu); VTl[(dv + 5) * 72 + t] = (bf16_t)(v.z >> 16);
        VTl[(dv + 6) * 72 + t] = (bf16_t)(v.w & 0xffffu); VTl[(dv + 7) * 72 + t] = (bf16_t)(v.w >> 16); }
    const float bfv = pw.bf, bbv = pw.bb;
    bf16_t qraw[16], kraw[16];
#pragma unroll
    for (int j = 0; j < 16; ++j) { qraw[j] = proj[(size_t)(row0 + 16 * s + j) * LDP + C_QA + h * 128 + c]; kraw[j] = proj[(size_t)(row0 + 16 * s + j) * LDP + C_KA + h * 128 + c]; }
    LDS_BARRIER();
    float pf[16], sb[16];
#pragma unroll
    for (int j = 0; j < 16; ++j) { const int t = 16 * s + j; const LAS float* ZL = (const LAS float*)(lds + PL_QF);
        const float zf = bfv + ZL[t * 128 + c], zb = bbv + ZL[(64 + t) * 128 + c];
        pf[j] = logsig(zf) * (1.f / 16.f); sb[j] = logsig(zb) * (1.f / 16.f); }
#pragma unroll
    for (int j = 1; j < 16; ++j) pf[j] += pf[j - 1];
#pragma unroll
    for (int j = 14; j >= 0; --j) sb[j] += sb[j + 1];
    TOT[(0 * 4 + s) * 128 + c] = pf[15]; TOT[(1 * 4 + s) * 128 + c] = sb[0];
    LDS_BARRIER();
    float offf = 0.f, allf = 0.f, offb = 0.f, allb = 0.f;
#pragma unroll
    for (int s2 = 0; s2 < 4; ++s2) { const float a = TOT[(0 * 4 + s2) * 128 + c], b = TOT[(1 * 4 + s2) * 128 + c]; allf += a; allb += b; if (s2 < s) offf += a; if (s2 > s) offb += b; }
    const float etf = fexp(allf), etb = fexp(allb);
    if (s == 0) { ef[(size_t)(gc * 4 + h) * 128 + c] = etf; eb[(size_t)(gc * 4 + h) * 128 + c] = etb; }
    unsigned klf[8], klb[8];
#pragma unroll
    for (int j = 0; j < 16; j += 2) {
        float o_klf[2], o_klb[2];
#pragma unroll
        for (int e = 0; e < 2; ++e) { const int t = 16 * s + j + e;
            const float q = bf2f(qraw[j + e]), k = bf2f(kraw[j + e]);
            const float bfw = offf + pf[j + e], bbw = offb + sb[j + e];
            const float Ef = fexp(bfw), Eb = fexp(bbw), rEf = __builtin_amdgcn_rcpf(Ef), rEb = __builtin_amdgcn_rcpf(Eb);
            const bf16_t qsf = f2bf(q * Ef), ksf = f2bf(k * rEf), qsb = f2bf(q * Eb), ksb = f2bf(k * rEb);
            o_klf[e] = k * (rEf * etf); o_klb[e] = k * (rEb * etb);
            pst[(size_t)((row0 + t) & rmask) * LDP + C_QA + h * 128 + c] = qsf; pst[(size_t)((row0 + t) & rmask) * LDP + C_KA + h * 128 + c] = qsb;
            QFl[t * 136 + c] = qsf; KFl[t * 136 + c] = ksf; QBl[t * 136 + c] = qsb; KBl[t * 136 + c] = ksb; }
        klf[j >> 1] = pk2(o_klf[0], o_klf[1]); klb[j >> 1] = pk2(o_klb[0], o_klb[1]);
    }
    { u32x4* d = (u32x4*)(kltf + ((size_t)(gc * 4 + h) * 128 + c) * 64 + 16 * s); d[0] = (u32x4){klf[0], klf[1], klf[2], klf[3]}; d[1] = (u32x4){klf[4], klf[5], klf[6], klf[7]};
      u32x4* d2 = (u32x4*)(kltb + ((size_t)(gc * 4 + h) * 128 + c) * 64 + 16 * s); d2[0] = (u32x4){klb[0], klb[1], klb[2], klb[3]}; d2[1] = (u32x4){klb[4], klb[5], klb[6], klb[7]}; }
    LDS_BARRIER();
    { const int dir = wave >> 2, bi = (wave >> 1) & 1, bj = wave & 1;
      const LAS bf16_t* Qt = dir ? QBl : QFl; const LAS bf16_t* Kt = dir ? KBl : KFl;
      f32x16 acc = f32x16{};
#pragma unroll
      for (int ks = 0; ks < 8; ++ks) { const bf16x8 a = *(const LAS bf16x8*)(Qt + (32 * bi + l32) * 136 + 16 * ks + 8 * hh); const bf16x8 b = *(const LAS bf16x8*)(Kt + (32 * bj + l32) * 136 + 16 * ks + 8 * hh); acc = MFMA32(a, b, acc); }
      const int jj = 32 * bj + l32;
#pragma unroll
      for (int r = 0; r < 16; ++r) { const int ii = 32 * bi + crow(r, hh); const bool keep = dir ? (jj > ii) : (jj <= ii); if (keep) Al[ii * 72 + jj] = f2bf(acc[r]); } }
    LDS_BARRIER();
    {
#pragma unroll
      for (int tb = 0; tb < 2; ++tb) { f32x16 acc = f32x16{};
#pragma unroll
        for (int ks = 0; ks < 4; ++ks) { const bf16x8 a = *(const LAS bf16x8*)(VTl + (32 * wave + l32) * 72 + 16 * ks + 8 * hh); const bf16x8 b = *(const LAS bf16x8*)(Al + (32 * tb + l32) * 72 + 16 * ks + 8 * hh); acc = MFMA32(a, b, acc); }
        bf16_t* op = pst + (size_t)((row0 + 32 * tb + l32) & rmask) * LDP + C_VA + h * 256 + 32 * wave + 4 * hh;
#pragma unroll
        for (int g = 0; g < 4; ++g) { u32x2 w; w.x = pk2(acc[4 * g], acc[4 * g + 1]); w.y = pk2(acc[4 * g + 2], acc[4 * g + 3]); *(u32x2*)(op + 8 * g) = w; } }
#pragma unroll
      for (int i = 0; i < 4; ++i) { const int idx = tid + 512 * i, dv = idx >> 3, tg = idx & 7;
        *(u32x4*)(vtg + ((size_t)(gc * 4 + h) * 256 + dv) * 64 + 8 * tg) = *(const LAS u32x4*)(VTl + dv * 72 + 8 * tg); } }
    LDS_BARRIER();
}

template <int NB>
__device__ __forceinline__ void qk_norm_items(bf16_t* proj, int it0, int itstride, int nitems, int T, const float* qg, const float* kg, const float* tabc, const float* tabs, int lane, bf16_t* pst, int rmask) {
    const int li = lane & 15, d0 = 4 * li, half = li >> 3, within = li & 7; const bool first = within < 4;
    bf16_t* p[NB]; bf16_t* pw[NB]; u32x2 u[NB]; f32x4 c4[NB], s4[NB]; bool isq[NB], ok[NB];
#pragma unroll
    for (int i = 0; i < NB; ++i) { const int it = it0 + i * itstride; ok[i] = it < nitems; const int itc = ok[i] ? it : 0; const int row = itc, grp = 4; isq[i] = false;
        p[i] = proj + (size_t)row * LDP + (grp < 4 ? C_QB + 256 * grp : C_KB) + 4 * lane; pw[i] = pst + (size_t)(row & rmask) * LDP + (grp < 4 ? C_QB + 256 * grp : C_KB) + 4 * lane; u[i] = *(const u32x2*)p[i];
        const int t = row % T; const int pos = half ? (t & 63) : (t >> 6);
        c4[i] = *(const f32x4*)(tabc + pos * 16 + 4 * (within & 3)); s4[i] = *(const f32x4*)(tabs + pos * 16 + 4 * (within & 3)); }
    const f32x4 gq = *(const f32x4*)(qg + d0), gk = *(const f32x4*)(kg + d0);
#pragma unroll
    for (int i = 0; i < NB; ++i) {
        float x[4] = {bflo(u[i].x), bfhi(u[i].x), bflo(u[i].y), bfhi(u[i].y)};
        float ss = (x[0] * x[0] + x[1] * x[1]) + (x[2] * x[2] + x[3] * x[3]);
        ss += __shfl_xor(ss, 1); ss += __shfl_xor(ss, 2); ss += __shfl_xor(ss, 4); ss += __shfl_xor(ss, 8);
        const float rs = __builtin_amdgcn_rsqf(ss * (1.f / 64.f) + EPS);
        const f32x4 g4 = isq[i] ? gq : gk; const float sc = isq[i] ? C2 : 1.f;
        float o[4];
#pragma unroll
        for (int e = 0; e < 4; ++e) { const float xn = x[e] * rs * g4[e]; const float pr = __shfl_xor(xn, 4);
            o[e] = (first ? (xn * c4[i][e] - pr * s4[i][e]) : (xn * c4[i][e] + pr * s4[i][e])) * sc; }
        u32x2 w; w.x = pk2(o[0], o[1]); w.y = pk2(o[2], o[3]); if (ok[i]) *(u32x2*)pw[i] = w;
    }
}

constexpr int CH_CB = 36864, CH_OFFK = 17408, CH_OFFE = 17408 + 18432;
__device__ __forceinline__ void gla_chain(LAS unsigned char* lds, int ci, int nchunk, bf16_t* proj, const bf16_t* kltf, const bf16_t* kltb, const bf16_t* vtg, const float* ef, const float* eb, bf16_t* ob, bf16_t* of2, unsigned* done, bf16_t* dry = nullptr) {
    int tid = threadIdx.x; asm volatile("" : "+v"(tid));
    const int lane = tid & 63, wave = __builtin_amdgcn_readfirstlane(tid >> 6);
    const int dir = ci & 1, bh = ci >> 1, b = bh >> 2, h = bh & 3, l32 = lane & 31, hh = lane >> 5;
    const bf16_t* klt = dir ? kltb : kltf; const float* ee = dir ? eb : ef;
    const int qcol = (dir ? C_KA : C_QA) + h * 128;
    const int qt0 = tid >> 4, qc0 = tid & 15;
    const int kd0 = tid >> 3, kc0 = tid & 7;
    f32x16 S[4];
#pragma unroll
    for (int i = 0; i < 4; ++i) S[i] = f32x16{};
#define CH_GC(st) (b * nchunk + (dir ? (nchunk - 1 - (st)) : (st)))
#define CH_CLAMP(st) ((st) < nchunk ? (st) : nchunk - 1)
#define CH_LOAD_T(SET, st) do { const int gc_ = CH_GC(CH_CLAMP(st)); \
        q0##SET = *(const u32x4*)(proj + (size_t)(gc_ * 64 + qt0) * LDP + qcol + qc0 * 8); q1##SET = *(const u32x4*)(proj + (size_t)(gc_ * 64 + qt0 + 32) * LDP + qcol + qc0 * 8); \
        const bf16_t* kb_ = klt + (size_t)(gc_ * 4 + h) * 128 * 64; \
        k0##SET = *(const u32x4*)(kb_ + (size_t)kd0 * 64 + kc0 * 8); k1##SET = *(const u32x4*)(kb_ + (size_t)(kd0 + 64) * 64 + kc0 * 8); \
        if (tid < 32) en##SET = *(const f32x4*)(ee + (size_t)(gc_ * 4 + h) * 128 + tid * 4); } while (0)
#define CH_LOAD_V(SET, st) do { const int gc_ = CH_GC(CH_CLAMP(st)); _Pragma("unroll") for (int ks = 0; ks < 4; ++ks) vf##SET[ks] = *(const bf16x8*)(vtg + ((size_t)(gc_ * 4 + h) * 256 + 32 * wave + l32) * 64 + 16 * ks + 8 * hh); } while (0)
#define CH_STAGE(SET, buf) do { *(LAS u32x4*)((buf) + qt0 * 272 + qc0 * 16) = q0##SET; *(LAS u32x4*)((buf) + (qt0 + 32) * 272 + qc0 * 16) = q1##SET; \
        *(LAS u32x4*)((buf) + CH_OFFK + kd0 * 144 + kc0 * 16) = k0##SET; *(LAS u32x4*)((buf) + CH_OFFK + (kd0 + 64) * 144 + kc0 * 16) = k1##SET; \
        if (tid < 32) *(LAS f32x4*)((buf) + CH_OFFE + tid * 16) = en##SET; } while (0)
    u32x4 q0A, q1A, k0A, k1A, q0B, q1B, k0B, k1B; f32x4 enA = (f32x4){0.f, 0.f, 0.f, 0.f}, enB = enA; bf16x8 vfA[4], vfB[4];
    CH_LOAD_T(A, 0); CH_LOAD_V(A, 0);
    CH_STAGE(A, lds);
    CH_LOAD_T(B, 1); CH_LOAD_V(B, 1);
    __syncthreads();
#define CH_LDQ(bufi, blk_) do { _Pragma("unroll") for (int s_ = 0; s_ < 2; ++s_) _Pragma("unroll") for (int tb_ = 0; tb_ < 2; ++tb_) { \
        const LAS unsigned char* qp_ = cur + (32 * tb_ + l32) * 272 + (32 * (blk_) + 16 * s_ + 4 * hh) * 2; \
        const u32x2 lo_ = *(const LAS u32x2*)qp_, hi_ = *(const LAS u32x2*)(qp_ + 16); qv[bufi][s_][tb_] = (u32x4){lo_.x, lo_.y, hi_.x, hi_.y}; } } while (0)
#define CH_LDE(bufi, blk_) do { _Pragma("unroll") for (int g_ = 0; g_ < 4; ++g_) evv[bufi][g_] = *(const LAS f32x4*)(cur + CH_OFFE + (32 * (blk_) + 8 * g_ + 4 * hh) * 4); } while (0)
#define CH_LDK(bufi, blk_) do { _Pragma("unroll") for (int ks_ = 0; ks_ < 4; ++ks_) kfv[bufi][ks_] = *(const LAS bf16x8*)(cur + CH_OFFK + (32 * (blk_) + l32) * 144 + (16 * ks_ + 8 * hh) * 2); } while (0)
#define CH_STEP(st, CUR, NXT) do { \
        const int gc = CH_GC(st), row0 = gc * 64; \
        LAS unsigned char* cur = lds + ((st) & 1) * CH_CB; LAS unsigned char* nxt = lds + (((st) + 1) & 1) * CH_CB; \
        CH_LOAD_T(CUR, (st) + 2); \
        f32x16 ot[2]; ot[0] = f32x16{}; ot[1] = f32x16{}; \
        u32x4 qv[2][2][2]; bf16x8 kfv[2][4]; \
        CH_LDQ(0, 0); \
        _Pragma("unroll") for (int blk = 0; blk < 4; ++blk) { \
            if (blk < 3) { CH_LDQ((blk + 1) & 1, blk + 1); } else { CH_LDK(0, 0); } \
            __builtin_amdgcn_sched_barrier(0); \
            _Pragma("unroll") for (int s = 0; s < 2; ++s) { \
                u32x4 pa; pa.x = pk2(S[blk][8 * s + 0], S[blk][8 * s + 1]); pa.y = pk2(S[blk][8 * s + 2], S[blk][8 * s + 3]); pa.z = pk2(S[blk][8 * s + 4], S[blk][8 * s + 5]); pa.w = pk2(S[blk][8 * s + 6], S[blk][8 * s + 7]); \
                const bf16x8 sa = __builtin_bit_cast(bf16x8, pa); \
                _Pragma("unroll") for (int tb = 0; tb < 2; ++tb) ot[tb] = MFMA32(sa, __builtin_bit_cast(bf16x8, qv[blk & 1][s][tb]), ot[tb]); } \
            __builtin_amdgcn_sched_barrier(0); } \
        _Pragma("unroll") for (int blk = 0; blk < 4; ++blk) _Pragma("unroll") for (int g = 0; g < 4; ++g) { const f32x4 ev = *(const LAS f32x4*)(cur + CH_OFFE + (32 * blk + 8 * g + 4 * hh) * 4); \
            S[blk][4 * g] *= ev[0]; S[blk][4 * g + 1] *= ev[1]; S[blk][4 * g + 2] *= ev[2]; S[blk][4 * g + 3] *= ev[3]; } \
        __builtin_amdgcn_sched_barrier(0); \
        _Pragma("unroll") for (int blk = 0; blk < 4; ++blk) { \
            if (blk < 3) { CH_LDK((blk + 1) & 1, blk + 1); } \
            __builtin_amdgcn_sched_barrier(0); \
            _Pragma("unroll") for (int ks = 0; ks < 4; ++ks) S[blk] = MFMA32(kfv[blk & 1][ks], vf##CUR[ks], S[blk]); \
            __builtin_amdgcn_sched_barrier(0); } \
        CH_LOAD_V(CUR, (st) + 2); \
        { bf16_t* obase = dry ? dry : (dir ? ob : of2); const int rmk = dry ? 4095 : -1; \
          _Pragma("unroll") for (int tb = 0; tb < 2; ++tb) { bf16_t* op = obase + (size_t)((row0 + 32 * tb + l32) & rmk) * DM + h * 256 + 32 * wave + 4 * hh; \
            _Pragma("unroll") for (int g = 0; g < 4; ++g) { u32x2 w; w.x = pk2(ot[tb][4 * g], ot[tb][4 * g + 1]); w.y = pk2(ot[tb][4 * g + 2], ot[tb][4 * g + 3]); *(u32x2*)(op + 8 * g) = w; } } } \
        CH_STAGE(NXT, nxt); \
        LDS_BARRIER(); } while (0)
    for (int step = 0; step < nchunk; step += 2) {
        CH_STEP(step, A, B);
        CH_STEP(step + 1, B, A);
    }
    if (done) {
        asm volatile("s_waitcnt vmcnt(0)" ::: "memory");
        __syncthreads();
        if (tid == 0) { __builtin_amdgcn_fence(__ATOMIC_RELEASE, "agent"); asm volatile("s_waitcnt vmcnt(0)" ::: "memory"); (void)xb_add(done + 64 * b, 1u); }
    }
#undef CH_GC
#undef CH_CLAMP
#undef CH_LOAD_T
#undef CH_LOAD_V
#undef CH_STAGE
#undef CH_STEP
#undef CH_LDQ
#undef CH_LDE
#undef CH_LDK
}

template <int NB>
__device__ __forceinline__ void ua_items(bf16_t* proj, const bf16_t* ob, const bf16_t* of2, int it0, int itstride, const float* gn, int lane, bf16_t* pst, int rmask) {
    u32x2 a[NB], b[NB], f[NB], z[NB]; bf16_t* zp[NB]; bool ok[NB];
#pragma unroll
    for (int i = 0; i < NB; ++i) { const int itr = it0 + i * itstride; ok[i] = itr < NTOK * 4; const int it = ok[i] ? itr : 0, row = it >> 2, h = it & 3;
        a[i] = *(const u32x2*)(proj + (size_t)row * LDP + C_VA + h * 256 + 4 * lane); b[i] = *(const u32x2*)(ob + (size_t)row * DM + h * 256 + 4 * lane); f[i] = *(const u32x2*)(of2 + (size_t)row * DM + h * 256 + 4 * lane);
        zp[i] = pst + (size_t)(row & rmask) * LDP + C_ZA + h * 256 + 4 * lane; z[i] = *(const u32x2*)(proj + (size_t)row * LDP + C_ZA + h * 256 + 4 * lane); }
    const f32x4 g4 = *(const f32x4*)(gn + 4 * lane);
#pragma unroll
    for (int i = 0; i < NB; ++i) {
        float o[4] = {bflo(a[i].x) + bflo(b[i].x) + bflo(f[i].x), bfhi(a[i].x) + bfhi(b[i].x) + bfhi(f[i].x), bflo(a[i].y) + bflo(b[i].y) + bflo(f[i].y), bfhi(a[i].y) + bfhi(b[i].y) + bfhi(f[i].y)};
        const float ss = wave_sum((o[0] * o[0] + o[1] * o[1]) + (o[2] * o[2] + o[3] * o[3]));
        const float rs = __builtin_amdgcn_rsqf(ss * (1.f / 256.f) + EPS);
        u32x2 w; w.x = pk2(o[0] * rs * g4[0] * silu(bflo(z[i].x)), o[1] * rs * g4[1] * silu(bfhi(z[i].x))); w.y = pk2(o[2] * rs * g4[2] * silu(bflo(z[i].y)), o[3] * rs * g4[3] * silu(bfhi(z[i].y)));
        if (ok[i]) *(u32x2*)zp[i] = w;
    }
}

__global__ void __launch_bounds__(512, 2) hybrid_fwd(Args args) {
    extern __shared__ __attribute__((aligned(16))) unsigned char lds[];
    LAS unsigned char* L = (LAS unsigned char*)lds;
    volatile LAS int* MISC = (volatile LAS int*)(L + MISC_OFF);
    cg::grid_group grid = cg::this_grid();
    if (threadIdx.x < 32) MISC[threadIdx.x] = 0;
    __syncthreads();
    const XcdBarrier xbar = xcd_barrier_post((unsigned*)(args.ws + WS_CTL) + 4096, (volatile LAS unsigned*)(MISC + 8));
    for (int ph = args.ph_lo; ph < args.ph_hi; ++ph) {
        int tid = threadIdx.x; asm volatile("" : "+v"(tid));
        const int lane = tid & 63, wave = __builtin_amdgcn_readfirstlane(tid >> 6);
        int G = gridDim.x, bid = blockIdx.x; asm volatile("" : "+s"(G), "+s"(bid));
        const int gw = bid * 8 + wave, ngw = G * 8;
        size_t zoff = 0; asm volatile("" : "+s"(zoff));
        unsigned char* ws = args.ws + zoff;
#define AIN(i) (args.in[i])
        float* aout = args.out;
        unsigned* ctl = (unsigned*)(ws + WS_CTL);
        float* tabc = (float*)(ws + WS_TAB); float* tabs = tabc + 1024;
        bf16_t* WIN = (bf16_t*)(ws + WS_WIN); bf16_t* WBR = (bf16_t*)(ws + WS_WBR); bf16_t* WOUT = (bf16_t*)(ws + WS_WOUT);
        bf16_t* proj = (bf16_t*)(ws + WS_PROJ); bf16_t* xb = (bf16_t*)(ws + WS_XB); float* ssp = (float*)(ws + WS_SSP);
        float* ef = (float*)(ws + WS_EF); float* eb = (float*)(ws + WS_EB);
        bf16_t* kltf = (bf16_t*)(ws + WS_KLTF); bf16_t* kltb = (bf16_t*)(ws + WS_KLTB); bf16_t* vtg = (bf16_t*)(ws + WS_VT); bf16_t* of2 = (bf16_t*)(ws + WS_OF2);
        if (ph == 0) {
          {
            LAS float* scr = (LAS float*)(L + wave * 16384);
            for (int it = gw; it < CV_ITEMS; it += ngw) convert_item(args, 0, it, WIN, WBR, WOUT, scr, lane);
            for (int i = bid * 512 + tid; i < DEPTH * 224 * 128; i += G * 512) { const int l = i / (224 * 128), r = i % (224 * 128);
                *(u32x4*)(WIN + (size_t)l * WIN_L + (size_t)IN_DIM * DM + (size_t)r * 8) = (u32x4){0u, 0u, 0u, 0u}; }
            for (int i = bid * 512 + tid; i < 1024; i += G * 512) { const int pos = i >> 4, fi = i & 15;
                const float inv = __builtin_amdgcn_exp2f(-(float)fi * (13.287712379549449f / 16.f)); const float ang = (float)pos * inv;
                float rev = ang * 0.15915494309189535f; rev -= floorf(rev);
                tabc[i] = __builtin_amdgcn_cosf(rev); tabs[i] = __builtin_amdgcn_sinf(rev); }
            x_rows_to_bf16(AIN(0), xb, ssp, gw, ngw, lane);
          }
        } else if (ph == 25 || ph == 50) {
            const int grp = ph == 50; float* xo = aout + (size_t)grp * NTOK * DM; const float* gf = AIN(14);
            for (int m0 = gw; m0 < NTOK; m0 += 2 * ngw) { const int m1 = (m0 + ngw < NTOK) ? m0 + ngw : m0;
                f32x4* xr0 = (f32x4*)(xo + (size_t)m0 * DM) + lane; f32x4* xr1 = (f32x4*)(xo + (size_t)m1 * DM) + lane; f32x4 v0[4], v1[4]; float s0 = 0.f, s1 = 0.f;
#pragma unroll
                for (int j = 0; j < 4; ++j) { v0[j] = xr0[64 * j]; v1[j] = xr1[64 * j]; }
#pragma unroll
                for (int j = 0; j < 4; ++j) { s0 += (v0[j].x * v0[j].x + v0[j].y * v0[j].y) + (v0[j].z * v0[j].z + v0[j].w * v0[j].w); s1 += (v1[j].x * v1[j].x + v1[j].y * v1[j].y) + (v1[j].z * v1[j].z + v1[j].w * v1[j].w); }
                const float rs0 = __builtin_amdgcn_rsqf(wave_sum(s0) * (1.f / 1024.f) + EPS), rs1 = __builtin_amdgcn_rsqf(wave_sum(s1) * (1.f / 1024.f) + EPS);
#pragma unroll
                for (int j = 0; j < 4; ++j) { const f32x4 g4 = *((const f32x4*)gf + lane + 64 * j); xr0[64 * j] = v0[j] * rs0 * g4; if (m1 != m0) xr1[64 * j] = v1[j] * rs1 * g4; } }
            if (grp == 0) x_rows_to_bf16(AIN(1), xb, ssp, gw, ngw, lane);
        } else {
            const int q = (ph < 25) ? ph - 1 : ph - 26; const int grp = ph > 25, l = q / 6, sub = q % 6;
            const int T = grp ? 2048 : 4096, nB = grp ? 8 : 4, nchunk = T / 64;
            float* xres = aout + (size_t)grp * NTOK * DM;
            if (sub == 0) {
                pg8::Gemm g{xb, WIN + (size_t)l * WIN_L, DM, DM, DM, 0}; pg8::StaticOrder S; S.init(NTOK, LDP, G, bid);
                pg8::EpiProj E{proj, ssp, (LAS float*)(L + MISC_OFF + 1024)};
                pg8::gemm_phase<pg8::EpiProj>(L, g, S, E);
            } else if (sub == 1) {
                { PrepIn pin; gla_prep_load(pin, proj, bid >> 2, bid & 3); PrepW pw; int hcur = bid & 3; gla_prep_loadw(pw, AIN(4) + (size_t)l * 16 * 512, AIN(5) + l * 512, AIN(6) + (size_t)l * 16 * 512, AIN(7) + l * 512, hcur);
                  for (int tile = bid; tile < 1024; tile += G) { PrepIn pnx; const int tn = (tile + G < 1024) ? tile + G : tile; gla_prep_load(pnx, proj, tn >> 2, tn & 3);
                    if ((tile & 3) != hcur) { hcur = tile & 3; gla_prep_loadw(pw, AIN(4) + (size_t)l * 16 * 512, AIN(5) + l * 512, AIN(6) + (size_t)l * 16 * 512, AIN(7) + l * 512, hcur); }
                    gla_prep_tile(L, pin, pw, tile >> 2, tile & 3, proj, ef, eb, kltf, kltb, vtg, proj, -1);
                    pin = pnx; } }
                for (int it = gw; it < NTOK; it += 8 * ngw) qk_norm_items<8>(proj, it, ngw, NTOK, T, AIN(9) + l * 64, AIN(10) + l * 64, tabc, tabs, lane, proj, -1);
            } else if (sub == 2) {
                const int nchain = nB * 4 * 2, nqb = T / 256, natt = nB * 16 * nqb, nua = NTOK * 4 / 64, ncv = (grp == 0 && l < 3) ? (CV_ITEMS + 7) / 8 : 0, total = nchain + natt + nua + ncv;
                unsigned* done = ctl + 8192 + 64 * ((grp * 4 + l) * 8);
                if (tid == 0) MISC[2] = 0;
                unsigned* ctr = ctl + 64 * (grp * 4 + l);
                if (tid == 0) MISC[0] = (int)atomicAdd(ctr, 1u);
                for (;;) {
                    __syncthreads();
                    const int idx = MISC[0];
                    __syncthreads();
                    if (idx >= total) break;
                    int nxti = 0; if (tid == 0) nxti = (int)atomicAdd(ctr, 1u);
                    if (idx >= nchain + natt && idx < nchain + natt + nua) {
                        const int j = idx - nchain - natt, bq = (j * 16) / T;
                        if (tid == 0 && !((MISC[2] >> bq) & 1)) {
                            unsigned sp = 0; while (xb_ld(done + 64 * bq) < 8u) { __builtin_amdgcn_s_sleep(2); if (++sp > (1u << 24)) break; }
                            __builtin_amdgcn_fence(__ATOMIC_ACQUIRE, "agent"); asm volatile("s_waitcnt vmcnt(0)" ::: "memory");
                            MISC[2] = MISC[2] | (1 << bq); }
                        __syncthreads();
                        { int ln = threadIdx.x; asm volatile("" : "+v"(ln)); const int wv = __builtin_amdgcn_readfirstlane(ln >> 6); ln &= 63;
                          ua_items<8>(proj, xb, of2, 64 * j + wv, 8, AIN(8) + l * 256, ln, proj, -1); }
                        if (tid == 0) MISC[0] = nxti; continue; }
                    if (idx >= nchain + natt + nua) { int ln = threadIdx.x; asm volatile("" : "+v"(ln)); const int wv = __builtin_amdgcn_readfirstlane(ln >> 6); ln &= 63; const int r = (idx - nchain - natt - nua) * 8 + wv; if (r < CV_ITEMS) convert_item(args, l + 1, r, WIN, WBR, WOUT, (LAS float*)(L + wv * 16384), ln); if (tid == 0) MISC[0] = nxti; continue; }
                    if (idx < nchain) gla_chain(L, idx, nchunk, proj, kltf, kltb, vtg, ef, eb, xb, of2, done);
                    else
                    {
 const int u = idx - nchain; const int g4 = u & 3, qb = (u >> 2) % nqb, bk = (u >> 2) / nqb, kvh = bk & 3, b = bk >> 2, hq = kvh * 4 + g4;
                        const size_t rb = (size_t)b * T;
                        attn_body::attn_unit<8>((const attn_body::bf16*)(proj + (rb + (size_t)qb * 256) * LDP + C_QB + hq * 64), (const attn_body::bf16*)(proj + rb * LDP + C_KB + kvh * 64),
                                                (const attn_body::bf16*)(proj + rb * LDP + C_VB + kvh * 64), (attn_body::bf16*)(proj + (rb + (size_t)qb * 256) * LDP + C_ZB + hq * 64), T / 64, (char*)lds, AIN(9) + l * 64, tabc, tabs, qb * 256);
                    }
                    if (tid == 0) MISC[0] = nxti;
                }
            } else if (sub == 3) {
            } else if (sub == 4) {
                pg8::StaticOrder S; S.init(NTOK, DM, G, bid);
                { pg8::Gemm g{proj + C_ZA, WBR + (size_t)l * DM * 2048, LDP, 2048, DM, 2048}; pg8::PairOrder S2{S}; pg8::EpiBranchPair E{proj};
                  pg8::gemm_phase<pg8::EpiBranchPair, true, pg8::PairOrder>(L, g, S2, E); }
            } else {
                pg8::Gemm g{proj + C_MA, WOUT + (size_t)l * DM * DM, LDP, DM, DM, 0}; pg8::StaticOrder S; S.init(NTOK, DM, G, bid);
                pg8::EpiOut E{l == 0 ? AIN(grp) : xres, xres, xb, ssp, -1};
                pg8::gemm_phase<pg8::EpiOut>(L, g, S, E);
            }
        }
        { const int qq = (ph < 25) ? ph - 1 : ph - 26; const bool empty = ph != 0 && ph != 25 && ph != 50 && (qq % 6) == 3;
          if (ph + 1 < args.ph_hi && !empty) { if (args.ph_hi > NPHASE) grid.sync(); else xcd_barrier(xbar); } }
    }
}

extern "C" void kernel_launch(void* const* d_in, const int* in_sizes, int n_in, void* d_out, int out_size, void* d_ws, size_t ws_size, hipStream_t stream) {
    static int grid = 0;
    if (grid == 0) {
        if (n_in != 15 || ws_size < WS_END || out_size != 2 * NTOK * DM) { fprintf(stderr, "kernel_launch: unexpected shapes (n_in %d, ws %zu, out %d)\n", n_in, ws_size, out_size); grid = -1; return; }
        if (hipFuncSetAttribute((const void*)hybrid_fwd, hipFuncAttributeMaxDynamicSharedMemorySize, LDS_BYTES) != hipSuccess) { fprintf(stderr, "kernel_launch: hipFuncSetAttribute failed\n"); grid = -1; return; }
        int dev = 0, cus = 0, per_cu = 0;
        hipGetDevice(&dev); hipDeviceGetAttribute(&cus, hipDeviceAttributeMultiprocessorCount, dev);
        hipOccupancyMaxActiveBlocksPerMultiprocessor(&per_cu, (const void*)hybrid_fwd, 512, LDS_BYTES);
        if (per_cu < 1) { fprintf(stderr, "kernel_launch: occupancy query says %d blocks per CU\n", per_cu); (void)hipGetLastError(); }
        grid = cus;
    }
    if (grid < 0) return;
    (void)hipMemsetAsync((char*)d_ws + WS_CTL, 0, CTL_BYTES, stream);
    Args a{};
    for (int i = 0; i < 15; ++i) a.in[i] = (const float*)d_in[i];
    a.out = (float*)d_out; a.ws = (unsigned char*)d_ws; a.ph_lo = 0; a.ph_hi = NPHASE;
    void* kargs[] = {&a};
    hipError_t e = hipLaunchCooperativeKernel((const void*)hybrid_fwd, dim3(grid), dim3(512), kargs, LDS_BYTES, stream);
    if (e != hipSuccess) fprintf(stderr, "kernel_launch: cooperative launch failed: %s (grid %d)\n", hipGetErrorString(e), grid);
}
```
